# Optimizing an MI355X kernel written in HIP

```python
import jax, jax.numpy as jnp
from jax import lax
import numpy as np

D_MODEL = 1024
BATCH = 1
SEQ = 16384
DEPTH = 2

GRID_W = 64
CTX_LEN = 256
HEAD_DIM = 64
A_HEADS = 8
A_KV_HEADS = 2
C_HEADS = 8
C_KV_HEADS = 2
WINDOW = 128
BLOCK = 128
BRANCH_WIDTH = A_HEADS * HEAD_DIM
B_WIDTH = BRANCH_WIDTH
CONV_W = 3
N_BRANCH = 3
N_MOD = 6
ROPE_THETA = 10000.0
PEER_HEADS = 8
N_KEYS = 128
N_EXPERTS = N_KEYS * N_KEYS
PEER_TOPK = 16
PEER_QDIM = 256
PEER_BLOCK = 128
IN_COLS = (A_HEADS + 2 * A_KV_HEADS + C_HEADS + 2 * C_KV_HEADS) * HEAD_DIM + 3 * B_WIDTH + N_BRANCH * D_MODEL
DEEPNORM_ALPHA = (2 * DEPTH) ** 0.25
DEEPNORM_BETA = (8 * DEPTH) ** -0.25
LN_EPS = 1e-6
RMS_EPS = 1e-6
NEG_INF = -1e30
ATTN_SCALE = HEAD_DIM ** -0.5

kernel_name = 'hybrid_dit_gqa_conv_swa_peer'


def _in_splits():
    sizes = (A_HEADS * HEAD_DIM, A_KV_HEADS * HEAD_DIM, A_KV_HEADS * HEAD_DIM,
             C_HEADS * HEAD_DIM, C_KV_HEADS * HEAD_DIM, C_KV_HEADS * HEAD_DIM,
             B_WIDTH, B_WIDTH, B_WIDTH, N_BRANCH * D_MODEL)
    return [int(v) for v in np.cumsum(sizes)[:-1]]


def layer_norm(x, g, b):
    xf = x.astype(jnp.float32)
    mu = jnp.mean(xf, axis=-1, keepdims=True)
    xc = xf - mu
    var = jnp.mean(xc * xc, axis=-1, keepdims=True)
    return (xc * lax.rsqrt(var + LN_EPS) * g + b).astype(x.dtype)


def rms_norm(x, g):
    xf = x.astype(jnp.float32)
    return (xf * lax.rsqrt(jnp.mean(xf * xf, axis=-1, keepdims=True) + RMS_EPS) * g).astype(x.dtype)


def modulate(x, shift, scale):
    return x * (1 + scale) + shift


def axial_rope(n_tok):
    rows = n_tok // GRID_W
    row = jnp.repeat(jnp.arange(rows, dtype=jnp.int32), GRID_W)
    col = jnp.tile(jnp.arange(GRID_W, dtype=jnp.int32), rows)
    quarter = HEAD_DIM // 4
    inv_freq = ROPE_THETA ** (-jnp.arange(quarter, dtype=jnp.float32) / quarter)
    ang = jnp.stack([row, col], axis=-1).astype(jnp.float32)[..., None] * inv_freq
    return jnp.cos(ang), jnp.sin(ang)


def apply_rope(x, cos, sin):
    xr = x.astype(jnp.float32).reshape(*x.shape[:-1], 2, 2, HEAD_DIM // 4)
    x1, x2 = xr[..., 0, :], xr[..., 1, :]
    c = cos[None, :, None]
    s = sin[None, :, None]
    out = jnp.stack([x1 * c - x2 * s, x2 * c + x1 * s], axis=-2)
    return out.reshape(x.shape).astype(x.dtype)


def to_blocks(x):
    b, l = x.shape[:2]
    return jnp.moveaxis(x.reshape(b, l // BLOCK, BLOCK, *x.shape[2:]), 1, 0)


def from_blocks(x):
    nb, b = x.shape[:2]
    return jnp.moveaxis(x, 0, 1).reshape(b, nb * BLOCK, *x.shape[3:])


def dense_gqa(q, k, v, sink_g=None):
    s = jnp.einsum('bqkgd,bskd->bkgqs', q, k).astype(jnp.float32) * ATTN_SCALE
    if sink_g is not None:
        s_sink = jnp.broadcast_to(sink_g.astype(jnp.float32)[None, :, :, None, None], s.shape[:-1] + (1,))
        p = jax.nn.softmax(jnp.concatenate([s, s_sink], axis=-1), axis=-1)[..., :-1]
    else:
        p = jax.nn.softmax(s, axis=-1)
    return jnp.einsum('bkgqs,bskd->bqkgd', p.astype(v.dtype), v)


def banded_attention(q, k, v, k_ctx, v_ctx, sink_g):
    s_len = q.shape[1]
    pad = ((0, 0), (BLOCK, BLOCK), (0, 0), (0, 0))

    def band(t):
        tb = to_blocks(jnp.pad(t, pad))
        return jnp.concatenate([tb[:-2], tb[1:-1], tb[2:]], axis=2)

    valid = jnp.pad(jnp.ones((s_len,), jnp.bool_), (BLOCK, BLOCK)).reshape(-1, BLOCK)
    valid = jnp.concatenate([valid[:-2], valid[1:-1], valid[2:]], axis=1)
    rel = jnp.arange(3 * BLOCK)[None, :] - BLOCK - jnp.arange(BLOCK)[:, None]
    in_win = jnp.abs(rel) <= WINDOW
    n_loc = 3 * BLOCK
    n_ctx = k_ctx.shape[1]

    def blk(args):
        qb, kb, vb, vmask = args
        s_loc = jnp.einsum('bqkgd,bskd->bkgqs', qb, kb).astype(jnp.float32) * ATTN_SCALE
        s_loc = jnp.where(in_win & vmask[None, :], s_loc, NEG_INF)
        s_ctx = jnp.einsum('bqkgd,bskd->bkgqs', qb, k_ctx).astype(jnp.float32) * ATTN_SCALE
        s_sink = jnp.broadcast_to(sink_g.astype(jnp.float32)[None, :, :, None, None], s_ctx.shape[:-1] + (1,))
        p = jax.nn.softmax(jnp.concatenate([s_loc, s_ctx, s_sink], axis=-1), axis=-1).astype(vb.dtype)
        return (jnp.einsum('bkgqs,bskd->bqkgd', p[..., :n_loc], vb)
                + jnp.einsum('bkgqs,bskd->bqkgd', p[..., n_loc:n_loc + n_ctx], v_ctx))

    out = lax.map(blk, (to_blocks(q), band(k), band(v), valid))
    return from_blocks(out)


def short_conv(xb, gb, gc, w):
    z = gc * xb
    half = CONV_W // 2
    zp = jnp.pad(z, ((0, 0), (half, half), (0, 0)))
    n = z.shape[1]
    y = sum(w[i] * zp[:, i:i + n] for i in range(CONV_W))
    return gb * y


def merge_branches(ya, yb, yc, gate_logits, w_branch, w_out):
    gates = jax.nn.sigmoid(gate_logits).reshape(*gate_logits.shape[:-1], N_BRANCH, D_MODEL)
    m = sum(gates[..., i, :] * (y @ w_branch[i]) for i, y in enumerate((ya, yb, yc)))
    return m @ w_out


def token_mixer(h_lat, h_ctx, w_in, q_g, k_g, conv_w, sink, w_branch, w_out, cos, sin, need_ctx):
    bsz, s_len, _ = h_lat.shape
    c_len = h_ctx.shape[1]
    g_a = A_HEADS // A_KV_HEADS
    g_c = C_HEADS // C_KV_HEADS
    splits = _in_splits()

    def heads(t, n):
        return t.reshape(*t.shape[:-1], n, HEAD_DIM)

    qa, ka, va, qc, kc, vc, xb, gb, gc, glog = jnp.split(h_lat @ w_in, splits, axis=-1)
    qa_x, ka_x, va_x, qc_x, kc_x, vc_x, xb_x, gb_x, gc_x, glog_x = jnp.split(h_ctx @ w_in, splits, axis=-1)

    qa = apply_rope(rms_norm(heads(qa, A_HEADS), q_g), cos, sin).reshape(bsz, s_len, A_KV_HEADS, g_a, HEAD_DIM)
    ka = apply_rope(rms_norm(heads(ka, A_KV_HEADS), k_g), cos, sin)
    va = heads(va, A_KV_HEADS)
    ka_x = rms_norm(heads(ka_x, A_KV_HEADS), k_g)
    va_x = heads(va_x, A_KV_HEADS)
    k_all = jnp.concatenate([ka_x, ka], axis=1)
    v_all = jnp.concatenate([va_x, va], axis=1)
    ya = from_blocks(lax.map(lambda qb: dense_gqa(qb, k_all, v_all), to_blocks(qa)))
    ya = ya.reshape(bsz, s_len, A_HEADS * HEAD_DIM)

    sink_g = sink.reshape(C_KV_HEADS, g_c)
    qc = apply_rope(heads(qc, C_HEADS), cos, sin).reshape(bsz, s_len, C_KV_HEADS, g_c, HEAD_DIM)
    kc = apply_rope(heads(kc, C_KV_HEADS), cos, sin)
    vc = heads(vc, C_KV_HEADS)
    kc_x = heads(kc_x, C_KV_HEADS)
    vc_x = heads(vc_x, C_KV_HEADS)
    yc = banded_attention(qc, kc, vc, kc_x, vc_x, sink_g).reshape(bsz, s_len, C_HEADS * HEAD_DIM)

    yb = short_conv(xb, gb, gc, conv_w)

    y_lat = merge_branches(ya, yb, yc, glog, w_branch, w_out)

    if need_ctx:
        qa_x = rms_norm(heads(qa_x, A_HEADS), q_g).reshape(bsz, c_len, A_KV_HEADS, g_a, HEAD_DIM)
        ya_x = dense_gqa(qa_x, ka_x, va_x).reshape(bsz, c_len, A_HEADS * HEAD_DIM)
        qc_x = heads(qc_x, C_HEADS).reshape(bsz, c_len, C_KV_HEADS, g_c, HEAD_DIM)
        yc_x = dense_gqa(qc_x, kc_x, vc_x, sink_g).reshape(bsz, c_len, C_HEADS * HEAD_DIM)
        yb_x = short_conv(xb_x, gb_x, gc_x, conv_w)
        y_ctx = merge_branches(ya_x, yb_x, yc_x, glog_x, w_branch, w_out)
    else:
        y_ctx = None
    return y_lat, y_ctx


def peer(h, w_pq, sub_keys, u_tab, v_tab):
    shape = h.shape
    blocks = h.reshape(-1, PEER_BLOCK, D_MODEL)
    half = PEER_QDIM // 2

    def blk(xb):
        q = (xb @ w_pq).reshape(PEER_BLOCK, PEER_HEADS, 2, half)
        s = jnp.einsum('thpd,hpnd->thpn', q, sub_keys).astype(jnp.float32)
        s1, i1 = lax.top_k(s[:, :, 0], PEER_TOPK)
        s2, i2 = lax.top_k(s[:, :, 1], PEER_TOPK)
        cand = (s1[..., :, None] + s2[..., None, :]).reshape(PEER_BLOCK, PEER_HEADS, PEER_TOPK * PEER_TOPK)
        cand_idx = (i1[..., :, None] * N_KEYS + i2[..., None, :]).reshape(PEER_BLOCK, PEER_HEADS, PEER_TOPK * PEER_TOPK)
        top, pos = lax.top_k(cand, PEER_TOPK)
        expert = jnp.take_along_axis(cand_idx, pos, axis=-1)
        g = jax.nn.softmax(top, axis=-1).astype(xb.dtype)
        u = jnp.take(u_tab, expert, axis=0)
        v = jnp.take(v_tab, expert, axis=0)
        a = jax.nn.gelu(jnp.einsum('td,thkd->thk', xb, u), approximate=False) * g
        return jnp.einsum('thk,thkd->td', a, v)

    return lax.map(blk, blocks).reshape(shape)


def setup_inputs(seed: int = 0) -> dict:
    key = jax.random.key(seed)
    ks = jax.random.split(key, 21)
    L = DEPTH
    D = D_MODEL

    def nrm(k, shape, scale):
        return jax.random.normal(k, shape, jnp.float32) * scale

    return {
        'x': nrm(ks[0], (BATCH, SEQ, D), 1.0),
        'c': nrm(ks[1], (BATCH, D), 1.0),
        'ctx': nrm(ks[2], (BATCH, CTX_LEN, D), 1.0),
        'c_ctx': nrm(ks[3], (D,), 1.0),
        'w_mod': nrm(ks[4], (L, D, N_MOD * D), 0.5 * D ** -0.5),
        'b_mod': nrm(ks[5], (L, N_MOD * D), 0.02),
        'w_in': nrm(ks[6], (L, D, IN_COLS), D ** -0.5),
        'q_norm': 1.0 + nrm(ks[7], (L, HEAD_DIM), 0.02),
        'k_norm': 1.0 + nrm(ks[8], (L, HEAD_DIM), 0.02),
        'conv_w': nrm(ks[9], (L, CONV_W, B_WIDTH), CONV_W ** -0.5),
        'sink': nrm(ks[10], (L, C_HEADS), 0.5),
        'w_branch': nrm(ks[11], (L, N_BRANCH, BRANCH_WIDTH, D), DEEPNORM_BETA * BRANCH_WIDTH ** -0.5),
        'w_out': nrm(ks[12], (L, D, D), DEEPNORM_BETA * D ** -0.5),
        'ln1_g': 1.0 + nrm(ks[13], (L, D), 0.02),
        'ln1_b': nrm(ks[14], (L, D), 0.02),
        'w_pq': nrm(ks[15], (L, D, PEER_HEADS * PEER_QDIM), D ** -0.5),
        'sub_keys': nrm(ks[16], (L, PEER_HEADS, 2, N_KEYS, PEER_QDIM // 2), (PEER_QDIM // 2) ** -0.5),
        'u_tab': nrm(ks[17], (L, N_EXPERTS, D), D ** -0.5),
        'v_tab': nrm(ks[18], (L, N_EXPERTS, D), DEEPNORM_BETA * PEER_HEADS ** -0.5),
        'ln2_g': 1.0 + nrm(ks[19], (L, D), 0.02),
        'ln2_b': nrm(ks[20], (L, D), 0.02),
    }


def reference(x, c, ctx, c_ctx, w_mod, b_mod, w_in, q_norm, k_norm, conv_w, sink, w_branch, w_out,
              ln1_g, ln1_b, w_pq, sub_keys, u_tab, v_tab, ln2_g, ln2_b):
    s_len = x.shape[1]
    cos, sin = axial_rope(s_len)
    alpha = DEEPNORM_ALPHA
    for layer in range(DEPTH):
        need_ctx = layer < DEPTH - 1
        mod = (jax.nn.silu(c) @ w_mod[layer] + b_mod[layer])[:, None, :]
        mod_x = jax.nn.silu(c_ctx) @ w_mod[layer] + b_mod[layer]
        sh1, sc1, g1, sh2, sc2, g2 = jnp.split(mod, N_MOD, axis=-1)
        xsh1, xsc1, xg1, xsh2, xsc2, xg2 = jnp.split(mod_x, N_MOD, axis=-1)

        y, y_x = token_mixer(modulate(x, sh1, sc1), modulate(ctx, xsh1, xsc1), w_in[layer],
                             q_norm[layer], k_norm[layer], conv_w[layer], sink[layer],
                             w_branch[layer], w_out[layer], cos, sin, need_ctx)
        x = layer_norm(alpha * x + g1 * y, ln1_g[layer], ln1_b[layer])
        f = peer(modulate(x, sh2, sc2), w_pq[layer], sub_keys[layer], u_tab[layer], v_tab[layer])
        x = layer_norm(alpha * x + g2 * f, ln2_g[layer], ln2_b[layer])

        if need_ctx:
            ctx = layer_norm(alpha * ctx + xg1 * y_x, ln1_g[layer], ln1_b[layer])
            f_x = peer(modulate(ctx, xsh2, xsc2), w_pq[layer], sub_keys[layer], u_tab[layer], v_tab[layer])
            ctx = layer_norm(alpha * ctx + xg2 * f_x, ln2_g[layer], ln2_b[layer])
    return x
```

```cpp
#include <hip/hip_runtime.h>
#include <hip/hip_bf16.h>
#include <hip/hip_cooperative_groups.h>
#include <cstdio>
#include <cstdint>
#include <cmath>
__device__ __forceinline__ int opq_tid() { int t = threadIdx.x; asm volatile("" : "+v"(t)); return t; }
namespace pg8 {
#define PG8_LAS __attribute__((address_space(3)))
typedef unsigned short bf16_t;
typedef short bf16x8 __attribute__((ext_vector_type(8)));
typedef float f32x4 __attribute__((ext_vector_type(4)));
typedef unsigned u32x4 __attribute__((ext_vector_type(4)));
constexpr int BM = 256, BK = 64, HALF = 128, HTB = HALF * BK * 2  , STAGE_BYTES = 8 * HTB, NXCD = 8, WGM = 8;

__host__ __device__ __forceinline__ int lds_byte(int r, int c) { const int st = (r >> 4) * 2 + (c >> 5), rr = r & 15, cc = c & 31, ob = rr * 64 + cc * 2; return st * 1024 + (ob ^ (((ob >> 9) & 1) << 5)); }
__host__ __device__ __forceinline__ void stage_rc(int b, int& R, int& C) { const int st = b / 1024, sb = b % 1024, swz = sb ^ (((sb >> 9) & 1) << 5); R = (st >> 1) * 16 + swz / 64; C = (st & 1) * 32 + (swz % 64) / 2; }
__host__ __device__ __forceinline__ int perm32(int rho) { const int n = rho >> 4, i = rho & 15; return 8 * (i >> 2) + 4 * n + (i & 3); }

struct Unit { int pm, pn; };
struct Gemm { const bf16_t* A; const bf16_t* Bt; int M, N, K; };

struct StaticOrder {
    int nM, nN, nwg, G, c;
    __host__ __device__ void init(int M, int N, int G_, int c_) { nM = M / BM; nN = N / BM; nwg = nM * nN; G = G_; c = c_; }
    __host__ __device__ bool next(int i, Unit& u) const {
        const long L = (long)i * G + c; if (L >= nwg) return false;
        int wgid = (int)L; { const int q = nwg / NXCD, r = nwg % NXCD, xcd = wgid % NXCD, off = wgid / NXCD; wgid = (xcd < r ? xcd * (q + 1) : r * (q + 1) + (xcd - r) * q) + off; }
        const int nig = WGM * nN, gid = wgid / nig, fm = gid * WGM, gsz = (nM - fm) < WGM ? (nM - fm) : WGM;
        u.pm = fm + ((wgid % nig) % gsz); u.pn = (wgid % nig) / gsz; return true;
    }
    __device__ __forceinline__ void a_ready(const Unit&) const {}
    __device__ __forceinline__ void done(const Unit&) const {}
};

__device__ __forceinline__ unsigned cvt_pk_bf16(float lo, float hi) { unsigned r; asm volatile("v_cvt_pk_bf16_f32 %0, %1, %2" : "=v"(r) : "v"(lo), "v"(hi)); return r; }
typedef float f32x2 __attribute__((ext_vector_type(2)));
__device__ __forceinline__ f32x2 gelu_pk(f32x2 v) {
    const f32x2 av = __builtin_elementwise_abs(v), d = av * 0.2316418882f + 1.0f;
    f32x2 t; t.x = __builtin_amdgcn_rcpf(d.x); t.y = __builtin_amdgcn_rcpf(d.y);
    f32x2 q = t * 0.5307027145f + (-0.7265760135f); q = q * t + 0.7107068705f; q = q * t + (-0.142248368f); q = q * t + 0.127414796f; q = q * t;
    const f32x2 s = (v * v) * (-0.72134752044f);
    f32x2 e; e.x = __builtin_amdgcn_exp2f(s.x); e.y = __builtin_amdgcn_exp2f(s.y);
    const f32x2 m = v * (q * e), r = v - m;
    f32x2 o; o.x = v.x < 0.f ? m.x : r.x; o.y = v.y < 0.f ? m.y : r.y; return o;
}

template <int ACT  > struct EpiBf16 {
    static constexpr bool PERM = true, AFTER_DRAIN = false; static_assert(ACT == 0 || ACT == 1, "EpiBf16: ACT is 0 (none) or 1 (gelu_pk)");
    bf16_t* O; int ldc; const float* bias; int split_cols; size_t split_stride; float scale0;
    __device__ __forceinline__ void operator()(const f32x4 (&acc)[2][2][4][2], const Unit& u, int wr, int wc, int fr, int fq) const {
        const int row0 = u.pm * BM + wr * 64 + fr; int colt = u.pn * BM; bf16_t* base = O;
        float sc = 1.f; if (split_cols) { const int t = colt / split_cols; base += (size_t)t * split_stride; colt -= t * split_cols; if (t == 0) sc = scale0; }
        const int col0 = colt + wc * 32 + 8 * fq, bcol0 = u.pn * BM + wc * 32 + 8 * fq;
        f32x4 bv[2][2];
#pragma unroll
        for (int bj = 0; bj < 2; ++bj)
#pragma unroll
            for (int n = 0; n < 2; ++n) bv[bj][n] = bias ? *(const f32x4*)(bias + bcol0 + bj * HALF + 4 * n) : (f32x4){0.f, 0.f, 0.f, 0.f};
#pragma unroll
        for (int ai = 0; ai < 2; ++ai)
#pragma unroll
            for (int m = 0; m < 4; ++m) { bf16_t* rowp = base + (size_t)(row0 + ai * HALF + m * 16) * ldc + col0;
#pragma unroll
                for (int bj = 0; bj < 2; ++bj) { f32x4 v0 = acc[ai][bj][m][0] + bv[bj][0], v1 = acc[ai][bj][m][1] + bv[bj][1];
                    if (ACT == 1) { f32x2 a = gelu_pk((f32x2){v0[0], v0[1]}), b = gelu_pk((f32x2){v0[2], v0[3]}), c = gelu_pk((f32x2){v1[0], v1[1]}), d = gelu_pk((f32x2){v1[2], v1[3]});
                        v0 = (f32x4){a.x, a.y, b.x, b.y}; v1 = (f32x4){c.x, c.y, d.x, d.y}; }
                    v0 = v0 * sc; v1 = v1 * sc; u32x4 w; w.x = cvt_pk_bf16(v0[0], v0[1]); w.y = cvt_pk_bf16(v0[2], v0[3]); w.z = cvt_pk_bf16(v1[0], v1[1]); w.w = cvt_pk_bf16(v1[2], v1[3]);
                    *(u32x4*)(rowp + bj * HALF) = w; } }
    }
};

struct PanelStats {
    unsigned* xbuf;
    unsigned* cnt;
    unsigned* tmo;
    int ntn; float eps;
    unsigned code;
    __device__ __forceinline__ bool run(const f32x4 (&v)[2][2][4][2], const Unit& u, int wr, int wc, int fr, int fq, PG8_LAS unsigned char* lds, int wid, int lane) const {
        typedef float f32x2v __attribute__((ext_vector_type(2)));
        PG8_LAS f32x2v* P = (PG8_LAS f32x2v*)lds;
        PG8_LAS f32x2v* S = (PG8_LAS f32x2v*)(lds + 8192);
        PG8_LAS unsigned* flag = (PG8_LAS unsigned*)(lds + 8192 + 2048);
#pragma unroll
        for (int ai = 0; ai < 2; ++ai)
#pragma unroll
            for (int m = 0; m < 4; ++m) {
                float s = 0.f;
#pragma unroll
                for (int bj = 0; bj < 2; ++bj)
#pragma unroll
                    for (int n = 0; n < 2; ++n) { const f32x4 x = v[ai][bj][m][n]; s += (x[0] + x[1]) + (x[2] + x[3]); }
                s += __shfl_xor(s, 16); s += __shfl_xor(s, 32);
                const float mw = s * (1.0f / 64.0f); float q = 0.f;
#pragma unroll
                for (int bj = 0; bj < 2; ++bj)
#pragma unroll
                    for (int n = 0; n < 2; ++n) { const f32x4 d = v[ai][bj][m][n] - mw; q += (d[0] * d[0] + d[1] * d[1]) + (d[2] * d[2] + d[3] * d[3]); }
                q += __shfl_xor(q, 16); q += __shfl_xor(q, 32);
                if (fq == 0) P[(ai * HALF + wr * 64 + m * 16 + fr) * 4 + wc] = (f32x2v){mw, q};
            }
        asm volatile("s_waitcnt lgkmcnt(0)" ::: "memory"); __builtin_amdgcn_s_barrier(); asm volatile("" ::: "memory");
#if defined(BROKEN_EXCHANGE_NO_WAIT)
#warning BROKEN CONTROL BUILD: the row-statistics exchange does not wait; results are wrong by design
        if (blockIdx.x >= 64) { const long long t0_ = clock64(); while (clock64() - t0_ < 60000) __builtin_amdgcn_s_sleep(8); }
#endif
        const int row = wid * 32 + (lane & 31);
        if (lane < 32) {
            const f32x2v a = P[row * 4 + 0], b = P[row * 4 + 1], c = P[row * 4 + 2], d = P[row * 4 + 3];
            const float mt = (a.x + b.x + c.x + d.x) * 0.25f;
            const float da = a.x - mt, db = b.x - mt, dc = c.x - mt, dd = d.x - mt;
            const float m2 = (a.y + b.y) + (c.y + d.y) + 64.0f * ((da * da + db * db) + (dc * dc + dd * dd));
            unsigned long long* slot = (unsigned long long*)xbuf + ((size_t)(u.pm * BM + row) * 4 + u.pn);
            __hip_atomic_store(slot, ((unsigned long long)__float_as_uint(m2) << 32) | __float_as_uint(mt), __ATOMIC_RELAXED, __HIP_MEMORY_SCOPE_AGENT);
        }
        asm volatile("s_waitcnt vmcnt(0)" ::: "memory");
        if (lane == 0) __hip_atomic_fetch_add(cnt + 64 * u.pm, 1u, __ATOMIC_RELAXED, __HIP_MEMORY_SCOPE_AGENT);
        if (wid == 0) {
            bool dead = false; const unsigned long long t0 = __builtin_amdgcn_s_memrealtime(); const unsigned want = 8u * (unsigned)ntn;
            for (;;) {
#if defined(BROKEN_EXCHANGE_NO_WAIT)
                break;
#endif
                if ((unsigned)__builtin_amdgcn_readfirstlane(__hip_atomic_load(cnt + 64 * u.pm, __ATOMIC_RELAXED, __HIP_MEMORY_SCOPE_AGENT)) >= want) break;
                if (__builtin_amdgcn_s_memrealtime() - t0 > 2000000ull) {
                    if (lane == 0) { unsigned expect = 0u; __hip_atomic_compare_exchange_strong(tmo + 1, &expect, code | (unsigned)(u.pm & 0xff), __ATOMIC_RELAXED, __ATOMIC_RELAXED, __HIP_MEMORY_SCOPE_AGENT);
                                     __hip_atomic_store(tmo, 1u, __ATOMIC_RELAXED, __HIP_MEMORY_SCOPE_AGENT); }
                    dead = true; break; }
                __builtin_amdgcn_s_sleep(2);
            }
            __builtin_amdgcn_fence(__ATOMIC_ACQUIRE, "agent");
            if (lane == 0) flag[0] = dead ? 1u : 0u;
        }
        asm volatile("s_waitcnt vmcnt(0) lgkmcnt(0)" ::: "memory"); __builtin_amdgcn_s_barrier(); asm volatile("" ::: "memory");
        const bool bad = flag[0] != 0u;
        if (lane < 32) {
            const unsigned long long* slot = (const unsigned long long*)xbuf + (size_t)(u.pm * BM + row) * 4; float mt[4], m2[4]; float ms = 0.f;
#pragma unroll
            for (int t = 0; t < 4; ++t) { if (t < ntn) { const unsigned long long w = __hip_atomic_load(slot + t, __ATOMIC_RELAXED, __HIP_MEMORY_SCOPE_AGENT); mt[t] = __uint_as_float((unsigned)w); m2[t] = __uint_as_float((unsigned)(w >> 32)); } else { mt[t] = 0.f; m2[t] = 0.f; } ms += mt[t]; }
            const float mean = ms / (float)ntn; float q = 0.f;
#pragma unroll
            for (int t = 0; t < 4; ++t) if (t < ntn) { const float dm = mt[t] - mean; q += m2[t] + 256.0f * dm * dm; }
            S[row] = (f32x2v){mean, 1.0f / sqrtf(q / (256.0f * (float)ntn) + eps)};
        }
        asm volatile("s_waitcnt lgkmcnt(0)" ::: "memory"); __builtin_amdgcn_s_barrier(); asm volatile("" ::: "memory");
        return bad;
    }
};
struct EpiLnRes {
    static constexpr bool PERM = false, AFTER_DRAIN = true;
    const float* base; float* out; int ldc; const float* bias; PanelStats st; unsigned poison;
    __device__ __forceinline__ void fused(f32x4 (&acc)[2][2][4][2], const Unit& u, int wr, int wc, int fr, int fq, PG8_LAS unsigned char* lds, int wid, int lane) const {
        typedef float f32x2v __attribute__((ext_vector_type(2)));
        const PG8_LAS f32x2v* S = (const PG8_LAS f32x2v*)(lds + 8192);
        const int col0 = u.pn * BM + wc * 32 + 4 * fq;
#pragma unroll
        for (int bj = 0; bj < 2; ++bj)
#pragma unroll
            for (int n = 0; n < 2; ++n) { const f32x4 bv = bias ? *(const f32x4*)(bias + col0 + bj * HALF + n * 16) : (f32x4){0.f, 0.f, 0.f, 0.f};
#pragma unroll
                for (int ai = 0; ai < 2; ++ai)
#pragma unroll
                    for (int m = 0; m < 4; ++m) acc[ai][bj][m][n] += bv; }
        f32x4 pre[4][2][2];
#pragma unroll
        for (int m = 0; m < 4; ++m) { const size_t off = (size_t)(u.pm * BM + wr * 64 + m * 16 + fr) * ldc + col0;
#pragma unroll
            for (int bj = 0; bj < 2; ++bj)
#pragma unroll
                for (int n = 0; n < 2; ++n) pre[m][bj][n] = *(const f32x4*)(base + off + bj * HALF + n * 16); }
        const bool bad = st.run(acc, u, wr, wc, fr, fq, lds, wid, lane) || poison != 0u;
        const float qnan = __builtin_nanf("");
#pragma unroll
        for (int ai = 0; ai < 2; ++ai)
#pragma unroll
            for (int m = 0; m < 4; ++m) { const int r = ai * HALF + wr * 64 + m * 16 + fr; const f32x2v sr = S[r]; const size_t off = (size_t)(u.pm * BM + r) * ldc + col0;
#pragma unroll
                for (int bj = 0; bj < 2; ++bj)
#pragma unroll
                    for (int n = 0; n < 2; ++n) { const f32x4 bs = ai == 0 ? pre[m][bj][n] : *(const f32x4*)(base + off + bj * HALF + n * 16); f32x4 o = bs + (acc[ai][bj][m][n] - sr.x) * sr.y;
                        if (bad) o = (f32x4){qnan, qnan, qnan, qnan}; *(f32x4*)(out + off + bj * HALF + n * 16) = o; }
                if (m & 1) asm volatile("" ::: "memory"); }
    }
};
struct EpiLnResLn {
    static constexpr bool PERM = false, AFTER_DRAIN = true;
    const float* base; float* out; bf16_t* xn; int ldc; const float* bias; PanelStats st1, st2; unsigned poison;
    __device__ __forceinline__ void fused(f32x4 (&acc)[2][2][4][2], const Unit& u, int wr, int wc, int fr, int fq, PG8_LAS unsigned char* lds, int wid, int lane) const {
        typedef float f32x2v __attribute__((ext_vector_type(2))); typedef unsigned u32x2v __attribute__((ext_vector_type(2)));
        const PG8_LAS f32x2v* S = (const PG8_LAS f32x2v*)(lds + 8192);
        const int col0 = u.pn * BM + wc * 32 + 4 * fq;
#pragma unroll
        for (int bj = 0; bj < 2; ++bj)
#pragma unroll
            for (int n = 0; n < 2; ++n) { const f32x4 bv = bias ? *(const f32x4*)(bias + col0 + bj * HALF + n * 16) : (f32x4){0.f, 0.f, 0.f, 0.f};
#pragma unroll
                for (int ai = 0; ai < 2; ++ai)
#pragma unroll
                    for (int m = 0; m < 4; ++m) acc[ai][bj][m][n] += bv; }
        bool bad = st1.run(acc, u, wr, wc, fr, fq, lds, wid, lane) || poison != 0u;
        const float qnan = __builtin_nanf("");
#pragma unroll
        for (int ai = 0; ai < 2; ++ai)
#pragma unroll
            for (int m = 0; m < 4; ++m) { const int r = ai * HALF + wr * 64 + m * 16 + fr; const f32x2v sr = S[r]; const size_t off = (size_t)(u.pm * BM + r) * ldc + col0;
#pragma unroll
                for (int bj = 0; bj < 2; ++bj)
#pragma unroll
                    for (int n = 0; n < 2; ++n) { const f32x4 bs = *(const f32x4*)(base + off + bj * HALF + n * 16); acc[ai][bj][m][n] = bs + (acc[ai][bj][m][n] - sr.x) * sr.y; }
                asm volatile("" : "+v"(acc[ai][0][m][0]), "+v"(acc[ai][0][m][1]), "+v"(acc[ai][1][m][0]), "+v"(acc[ai][1][m][1]));
                if (m & 1) asm volatile("" ::: "memory"); }
        const bool bad1 = bad;
        bad = st2.run(acc, u, wr, wc, fr, fq, lds, wid, lane) || bad;
#pragma unroll
        for (int ai = 0; ai < 2; ++ai)
#pragma unroll
            for (int m = 0; m < 4; ++m) { const int r = ai * HALF + wr * 64 + m * 16 + fr; const f32x2v sr = S[r]; const size_t off = (size_t)(u.pm * BM + r) * ldc + col0;
#pragma unroll
                for (int bj = 0; bj < 2; ++bj)
#pragma unroll
                    for (int n = 0; n < 2; ++n) { const f32x4 x1 = acc[ai][bj][m][n]; *(f32x4*)(out + off + bj * HALF + n * 16) = bad1 ? (f32x4){qnan, qnan, qnan, qnan} : x1;
                        const f32x4 o = (x1 - sr.x) * sr.y; u32x2v w; w.x = cvt_pk_bf16(o[0], o[1]); w.y = cvt_pk_bf16(o[2], o[3]);
                        if (bad) { w.x = 0x7fc07fc0u; w.y = 0x7fc07fc0u; } *(u32x2v*)(xn + off + bj * HALF + n * 16) = w; }
                asm volatile("" ::: "memory"); }
    }
};

template <class Epi, class Sched, bool ALIGN_EPI = false, bool SP2 = false>
__device__ __forceinline__ void gemm_phase(PG8_LAS unsigned char* lds, const Gemm g, const Sched& S, const Epi& E) {
    const int tid = opq_tid(), wid = __builtin_amdgcn_readfirstlane(tid >> 6), lane = tid & 63, wr = wid >> 2, wc = wid & 3, fr = lane & 15, fq = lane >> 4;
    const int K = g.K, nt = K / BK;
    unsigned voffA[2], voffB[2];
#pragma unroll
    for (int i = 0; i < 2; ++i) { int R, C; stage_rc(tid * 16 + i * 8192, R, C); const int Rb = Epi::PERM ? ((R & ~31) + perm32(R & 31)) : R;
        voffA[i] = (unsigned)(R * K + C) * 2u; voffB[i] = (unsigned)(Rb * K + C) * 2u; }
    const size_t kstep = (size_t)(BK * 2);
    const size_t hstep = (size_t)HALF * K * 2;
    const size_t tstep = 2 * hstep;
    const unsigned ldsw = (unsigned)wid * 1024u;
    const int aoff = lds_byte(wr * 64 + fr, fq * 8), boff = lds_byte(wc * 32 + fr, fq * 8);
#define PG8_SA(b, h) (((b) * 2 + (h)) * HTB)
#define PG8_SB(b, h) ((4 + (b) * 2 + (h)) * HTB)
#define PG8_STAGE(bufoff, gbase, voff) do { _Pragma("unroll") for (int _i = 0; _i < 2; ++_i) \
        __builtin_amdgcn_global_load_lds((const unsigned*)((const char*)(gbase) + (voff)[_i]), (PG8_LAS unsigned*)(lds + (bufoff) + ldsw + _i * 8192), 16, 0, 0); } while (0)
#define PG8_LDA(dst, b, h) do { _Pragma("unroll") for (int m = 0; m < 4; ++m) _Pragma("unroll") for (int k = 0; k < 2; ++k) dst[m][k] = *(const PG8_LAS bf16x8*)(lds + PG8_SA(b, h) + aoff + m * 2048 + k * 1024); } while (0)
#define PG8_LDB(dst, b, h) do { _Pragma("unroll") for (int n = 0; n < 2; ++n) _Pragma("unroll") for (int k = 0; k < 2; ++k) dst[n][k] = *(const PG8_LAS bf16x8*)(lds + PG8_SB(b, h) + boff + n * 2048 + k * 1024); } while (0)
#define PG8_MMA(ai, bj, At, Bt) do { __builtin_amdgcn_s_setprio(1); _Pragma("unroll") for (int m = 0; m < 4; ++m) _Pragma("unroll") for (int n = 0; n < 2; ++n) _Pragma("unroll") for (int k = 0; k < 2; ++k) \
        acc[ai][bj][m][n] = __builtin_amdgcn_mfma_f32_16x16x32_bf16(Bt[n][k], At[m][k], acc[ai][bj][m][n], 0, 0, 0); __builtin_amdgcn_s_setprio(0); } while (0)
#define PG8_WAIT_V(n) asm volatile("s_waitcnt vmcnt(" #n ")" ::: "memory")
#define PG8_WAIT_L(n) asm volatile("s_waitcnt lgkmcnt(" #n ")" ::: "memory")
#define PG8_BAR __builtin_amdgcn_s_barrier()
#define PG8_SCHED __builtin_amdgcn_sched_barrier(0)
    Unit cur, nxt; int ui = 0;
    if (!S.next(0, cur)) return;
    f32x4 acc[2][2][4][2];
#pragma unroll
    for (int a = 0; a < 2; ++a)
#pragma unroll
        for (int b = 0; b < 2; ++b)
#pragma unroll
            for (int m = 0; m < 4; ++m)
#pragma unroll
                for (int n = 0; n < 2; ++n) acc[a][b][m][n] = (f32x4){0.f, 0.f, 0.f, 0.f};
    bf16x8 At[4][2], B0[2][2], B1[2][2];
    const char* cA = (const char*)g.A + (size_t)cur.pm * tstep; const char* cB = (const char*)g.Bt + (size_t)cur.pn * tstep;
    S.a_ready(cur);
    if constexpr (SP2) {
        PG8_STAGE(PG8_SB(0, 0), cB, voffB); PG8_STAGE(PG8_SB(0, 1), cB + hstep, voffB); PG8_STAGE(PG8_SA(0, 0), cA, voffA); PG8_STAGE(PG8_SA(0, 1), cA + hstep, voffA);
        if (wr == 1) PG8_BAR;
        PG8_WAIT_V(2); PG8_BAR;
        PG8_STAGE(PG8_SB(1, 0), cB + kstep, voffB); PG8_STAGE(PG8_SA(1, 0), cA + kstep, voffA); PG8_STAGE(PG8_SB(1, 1), cB + hstep + kstep, voffB);
        PG8_WAIT_V(6); PG8_BAR;
    } else {
        PG8_STAGE(PG8_SB(0, 0), cB, voffB); PG8_STAGE(PG8_SA(0, 0), cA, voffA); PG8_STAGE(PG8_SB(0, 1), cB + hstep, voffB); PG8_STAGE(PG8_SA(0, 1), cA + hstep, voffA);
        if (wr == 1) PG8_BAR;
        PG8_WAIT_V(4); PG8_BAR;
        PG8_STAGE(PG8_SB(1, 0), cB + kstep, voffB); PG8_STAGE(PG8_SA(1, 0), cA + kstep, voffA); PG8_STAGE(PG8_SB(1, 1), cB + hstep + kstep, voffB);
        PG8_WAIT_V(6); PG8_BAR;
    }
    for (;;) {
        const bool has_next = S.next(ui + 1, nxt);
        const char* nA = has_next ? (const char*)g.A + (size_t)nxt.pm * tstep : cA; const char* nB = has_next ? (const char*)g.Bt + (size_t)nxt.pn * tstep : cB;
        for (int t = 0; t < nt; t += 2) {
            const bool last = (t == nt - 2);
            const char* a1 = cA + (size_t)(t + 1) * kstep;
            const char* a2 = last ? nA : cA + (size_t)(t + 2) * kstep; const char* b2 = last ? nB : cB + (size_t)(t + 2) * kstep;
            const char* a3 = a2 + kstep; const char* b3 = b2 + kstep;
            if (last && has_next) S.a_ready(nxt);
            if constexpr (SP2) {
            PG8_LDB(B0, 0, 0); PG8_LDB(B1, 0, 1); PG8_SCHED; PG8_LDA(At, 0, 0); PG8_STAGE(PG8_SA(1, 1), a1 + hstep, voffA);
            PG8_WAIT_V(8); PG8_WAIT_L(0); PG8_BAR; PG8_MMA(0, 0, At, B0); PG8_MMA(0, 1, At, B1); PG8_BAR; PG8_SCHED;
            PG8_LDA(At, 0, 1); PG8_STAGE(PG8_SB(0, 0), b2, voffB); PG8_STAGE(PG8_SB(0, 1), b2 + hstep, voffB); PG8_STAGE(PG8_SA(0, 0), a2, voffA);
            PG8_WAIT_V(8); PG8_WAIT_L(0); PG8_BAR; PG8_MMA(1, 0, At, B0); PG8_MMA(1, 1, At, B1); PG8_BAR; PG8_SCHED;
            PG8_LDB(B0, 1, 0); PG8_LDB(B1, 1, 1); PG8_SCHED; PG8_LDA(At, 1, 0); PG8_STAGE(PG8_SA(0, 1), a2 + hstep, voffA);
            PG8_WAIT_V(8); PG8_WAIT_L(0); PG8_BAR; PG8_MMA(0, 0, At, B0); PG8_MMA(0, 1, At, B1); PG8_BAR; PG8_SCHED;
            PG8_LDA(At, 1, 1); PG8_STAGE(PG8_SB(1, 0), b3, voffB); PG8_STAGE(PG8_SB(1, 1), b3 + hstep, voffB); PG8_STAGE(PG8_SA(1, 0), a3, voffA);
            PG8_WAIT_V(8); PG8_WAIT_L(0); PG8_BAR; PG8_MMA(1, 0, At, B0); PG8_MMA(1, 1, At, B1); PG8_BAR; PG8_SCHED;
            } else {
            PG8_LDB(B0, 0, 0); PG8_SCHED; PG8_LDA(At, 0, 0); PG8_STAGE(PG8_SA(1, 1), a1 + hstep, voffA);
            PG8_WAIT_L(8); PG8_BAR; PG8_WAIT_L(0); PG8_MMA(0, 0, At, B0); PG8_BAR; PG8_SCHED;
            PG8_LDB(B1, 0, 1); PG8_STAGE(PG8_SB(0, 0), b2, voffB);
            PG8_BAR; PG8_WAIT_L(0); PG8_MMA(0, 1, At, B1); PG8_BAR;
            PG8_LDA(At, 0, 1); PG8_STAGE(PG8_SA(0, 0), a2, voffA);
            PG8_BAR; PG8_WAIT_L(0); PG8_MMA(1, 0, At, B0); PG8_BAR; PG8_SCHED;
            PG8_STAGE(PG8_SB(0, 1), b2 + hstep, voffB);
            PG8_WAIT_V(6); PG8_BAR; PG8_MMA(1, 1, At, B1); PG8_BAR;
            PG8_LDB(B0, 1, 0); PG8_SCHED; PG8_LDA(At, 1, 0); PG8_STAGE(PG8_SA(0, 1), a2 + hstep, voffA);
            PG8_WAIT_L(8); PG8_BAR; PG8_WAIT_L(0); PG8_MMA(0, 0, At, B0); PG8_BAR; PG8_SCHED;
            PG8_LDB(B1, 1, 1); PG8_STAGE(PG8_SB(1, 0), b3, voffB);
            PG8_BAR; PG8_WAIT_L(0); PG8_MMA(0, 1, At, B1); PG8_BAR;
            PG8_LDA(At, 1, 1); PG8_STAGE(PG8_SA(1, 0), a3, voffA);
            PG8_BAR; PG8_WAIT_L(0); PG8_MMA(1, 0, At, B0); PG8_BAR; PG8_SCHED;
            PG8_STAGE(PG8_SB(1, 1), b3 + hstep, voffB);
            PG8_WAIT_V(6); PG8_BAR; PG8_MMA(1, 1, At, B1); PG8_BAR;
            }
        }
        if constexpr (ALIGN_EPI) { if (wr == 0) PG8_BAR; }
        if constexpr (!Epi::AFTER_DRAIN) { E(acc, cur, wr, wc, fr, fq); S.done(cur); }
        if (!has_next) break;
#pragma unroll
        for (int a = 0; a < 2; ++a)
#pragma unroll
            for (int b = 0; b < 2; ++b)
#pragma unroll
                for (int m = 0; m < 4; ++m)
#pragma unroll
                    for (int n = 0; n < 2; ++n) acc[a][b][m][n] = (f32x4){0.f, 0.f, 0.f, 0.f};
        cur = nxt; cA = nA; cB = nB; ++ui;
        if constexpr (ALIGN_EPI) { if (wr == 1) PG8_BAR; }
    }
    PG8_WAIT_V(0);
    if constexpr (!ALIGN_EPI) { if (wr == 0) PG8_BAR; }
    PG8_BAR;
    if constexpr (Epi::AFTER_DRAIN) { E.fused(acc, cur, wr, wc, fr, fq, lds, wid, lane); S.done(cur); }
#undef PG8_SA
#undef PG8_SB
#undef PG8_STAGE
#undef PG8_LDA
#undef PG8_LDB
#undef PG8_MMA
#undef PG8_WAIT_V
#undef PG8_WAIT_L
#undef PG8_BAR
#undef PG8_SCHED
}
}
namespace pg8 {
struct EpiF32 {
    static constexpr bool PERM = false, AFTER_DRAIN = false;
    float* C; int ldc;
    __device__ __forceinline__ void operator()(const f32x4 (&acc)[2][2][4][2], const Unit& u, int wr, int wc, int fr, int fq) const {
        const int row0 = u.pm * BM + wr * 64 + fr, col0 = u.pn * BM + wc * 32 + 4 * fq;
#pragma unroll
        for (int ai = 0; ai < 2; ++ai)
#pragma unroll
            for (int m = 0; m < 4; ++m) { float* rowp = C + (size_t)(row0 + ai * HALF + m * 16) * ldc + col0;
#pragma unroll
                for (int bj = 0; bj < 2; ++bj)
#pragma unroll
                    for (int n = 0; n < 2; ++n) *(f32x4*)(rowp + bj * HALF + n * 16) = acc[ai][bj][m][n]; }
    }
};
__device__ __forceinline__ float bf_lo(unsigned w) { return __uint_as_float(w << 16); }
__device__ __forceinline__ float bf_hi(unsigned w) { return __uint_as_float(w & 0xffff0000u); }
__device__ __forceinline__ float sigmoidf_(float x) { return 1.0f / (1.0f + __expf(-x)); }
struct EpiMerge {
    static constexpr bool PERM = true, AFTER_DRAIN = false;
    bf16_t* Mg; const bf16_t* glog; int ldg; int SP;
    __device__ __forceinline__ void operator()(const f32x4 (&acc)[2][2][4][2], const Unit& u, int wr, int wc, int fr, int fq) const {
        const int b = u.pn >> 2, pn = u.pn & 3, pm = u.pm - b * SP;
        const int row0 = pm * BM + wr * 64 + fr, col0 = pn * BM + wc * 32 + 8 * fq;
#pragma unroll
        for (int ai = 0; ai < 2; ++ai)
#pragma unroll
            for (int m = 0; m < 4; ++m) { const size_t row = (size_t)(row0 + ai * HALF + m * 16);
#pragma unroll
                for (int bj = 0; bj < 2; ++bj) { const int col = col0 + bj * HALF;
                    const u32x4 g = *(const u32x4*)(glog + row * ldg + b * 1024 + col);
                    f32x4 v0 = acc[ai][bj][m][0], v1 = acc[ai][bj][m][1];
                    v0[0] *= sigmoidf_(bf_lo(g.x)); v0[1] *= sigmoidf_(bf_hi(g.x)); v0[2] *= sigmoidf_(bf_lo(g.y)); v0[3] *= sigmoidf_(bf_hi(g.y));
                    v1[0] *= sigmoidf_(bf_lo(g.z)); v1[1] *= sigmoidf_(bf_hi(g.z)); v1[2] *= sigmoidf_(bf_lo(g.w)); v1[3] *= sigmoidf_(bf_hi(g.w));
                    u32x4* dst = (u32x4*)(Mg + row * 1024 + col);
                    if (b != 0) { const u32x4 o = *dst;
                        v0[0] += bf_lo(o.x); v0[1] += bf_hi(o.x); v0[2] += bf_lo(o.y); v0[3] += bf_hi(o.y);
                        v1[0] += bf_lo(o.z); v1[1] += bf_hi(o.z); v1[2] += bf_lo(o.w); v1[3] += bf_hi(o.w); }
                    u32x4 w; w.x = cvt_pk_bf16(v0[0], v0[1]); w.y = cvt_pk_bf16(v0[2], v0[3]); w.z = cvt_pk_bf16(v1[0], v1[1]); w.w = cvt_pk_bf16(v1[2], v1[3]);
                    *dst = w; } }
    }
};
struct MergeOrder {
    int NP, SP, nwg, G, c;
    __host__ __device__ void init(int NP_, int SP_, int G_, int c_) { NP = NP_; SP = SP_; nwg = NP_ * 4; G = G_; c = c_; }
    __host__ __device__ bool next(int i, Unit& u) const {
        const int ti = i / 3, b = i - 3 * ti;
        const long L = (long)ti * G + c; if (L >= nwg) return false;
        int wgid = (int)L; { const int q = nwg / NXCD, r = nwg % NXCD, xcd = wgid % NXCD, off = wgid / NXCD; wgid = (xcd < r ? xcd * (q + 1) : r * (q + 1) + (xcd - r) * q) + off; }
        const int nN = 4, nig = WGM * nN, gid = wgid / nig, fm = gid * WGM, gsz = (NP - fm) < WGM ? (NP - fm) : WGM;
        const int pm = fm + ((wgid % nig) % gsz), pn = (wgid % nig) / gsz;
        u.pm = b * SP + pm; u.pn = b * 4 + pn; return true;
    }
    __device__ __forceinline__ void a_ready(const Unit&) const {}
    __device__ __forceinline__ void done(const Unit&) const {}
};
}
#include <hip/hip_bf16.h>
#include <cmath>
namespace attn_body {
using bf16=__hip_bfloat16;
using bf16x8=__attribute__((ext_vector_type(8)))short;
using s16x4=__attribute__((ext_vector_type(4)))short;
using f32x16=__attribute__((ext_vector_type(16)))float;
using u32x4=__attribute__((ext_vector_type(4)))unsigned;
constexpr int D=64;
constexpr int NW=8,QBLK=32,QB=QBLK*NW,KVBLK=64;
constexpr int ATTN_UNIT_ROWS=QB;
__device__ __forceinline__ int crow(int r,int hi){return (r&3)+8*(r>>2)+4*hi;}
#define SBAR() __builtin_amdgcn_sched_barrier(0)
constexpr int WIN=128;
__device__ __forceinline__ void wmask(f32x16&p0,f32x16&p1,int kd){
  const float NEG=-INFINITY;
  #pragma unroll
  for(int r=0;r<16;++r){const int d0=kd+(r&3)+8*(r>>2); if(d0>WIN||d0<-WIN)p0[r]=NEG; const int d1=d0+32; if(d1>WIN||d1<-WIN)p1[r]=NEG;}
}
struct AttnJob {
  const bf16* Q; const bf16* K; const bf16* V; bf16* O;
  int qp, kp, op;
  int nt, nt0, row1;
  int qpos0, kpos1;
  float sink2;
};
constexpr int NSLOT=3, SLOTB=8192;
constexpr int LDS_K=0, LDS_V=NSLOT*SLOTB, LDS_WS=2*NSLOT*SLOTB, LDS_OST=LDS_WS+NW*64*4, LDS_BYTES=LDS_OST+NW*4096;
constexpr float C2=0.125f*1.4426950408889634f;
__device__ __forceinline__ void glds16(const void*gsrc,unsigned lds_dst){unsigned keep;
  asm volatile("s_mov_b32 %0, m0\n\ts_mov_b32 m0, %2\n\ts_nop 0\n\tglobal_load_lds_dwordx4 %1, off\n\ts_mov_b32 m0, %0":"=&s"(keep):"v"(gsrc),"s"(lds_dst):"memory");}
__device__ __forceinline__ float max3f(float a,float b,float c){float r;asm("v_max3_f32 %0, %1, %2, %3":"=v"(r):"v"(a),"v"(b),"v"(c));return r;}
__device__ __forceinline__ float max2f(float a,float b){float r;asm("v_max_f32_e32 %0, %1, %2":"=v"(r):"v"(a),"v"(b));return r;}
__device__ __forceinline__ float fadd_s(float a,float b){float r;asm("v_add_f32_e32 %0, %1, %2":"=v"(r):"v"(a),"v"(b));return r;}
__device__ __forceinline__ float fsub_s(float a,float b){float r;asm("v_sub_f32_e32 %0, %1, %2":"=v"(r):"v"(a),"v"(b));return r;}
typedef float f32x2_t __attribute__((ext_vector_type(2))); typedef __bf16 bf16x2_t __attribute__((ext_vector_type(2)));
__device__ __forceinline__ unsigned cvtpk_s(float lo,float hi){f32x2_t v={lo,hi};bf16x2_t b=__builtin_convertvector(v,bf16x2_t);return __builtin_bit_cast(unsigned,b);}
#define WAIT_BAR(N) asm volatile("s_waitcnt vmcnt(" #N ") lgkmcnt(0)\n\ts_barrier":::"memory")

__device__ __forceinline__ void qkt(f32x16&p0,f32x16&p1,const char*Kslot,const bf16x8*qr,const f32x16&negm,int r32,int hi){
  const char*kb=Kslot+hi*1024+r32*16;
  #pragma unroll
  for(int d0=0;d0<4;++d0){
    const bf16x8 b0=*reinterpret_cast<const bf16x8*>(kb+d0*2048);
    const bf16x8 b1=*reinterpret_cast<const bf16x8*>(kb+d0*2048+512);
    if(d0==0){p0=__builtin_amdgcn_mfma_f32_32x32x16_bf16(b0,qr[0],negm,0,0,0);p1=__builtin_amdgcn_mfma_f32_32x32x16_bf16(b1,qr[0],negm,0,0,0);}
    else{p0=__builtin_amdgcn_mfma_f32_32x32x16_bf16(b0,qr[d0],p0,0,0,0);p1=__builtin_amdgcn_mfma_f32_32x32x16_bf16(b1,qr[d0],p1,0,0,0);}}
}
typedef __attribute__((address_space(3))) const char* lds_cptr;
typedef short v4i16_t __attribute__((ext_vector_type(4)));
__device__ __forceinline__ void kload8(bf16x8*kf,lds_cptr kp){
  kf[0]=*(const __attribute__((address_space(3))) bf16x8*)(kp);      kf[1]=*(const __attribute__((address_space(3))) bf16x8*)(kp+512);
  kf[2]=*(const __attribute__((address_space(3))) bf16x8*)(kp+2048); kf[3]=*(const __attribute__((address_space(3))) bf16x8*)(kp+2560);
  kf[4]=*(const __attribute__((address_space(3))) bf16x8*)(kp+4096); kf[5]=*(const __attribute__((address_space(3))) bf16x8*)(kp+4608);
  kf[6]=*(const __attribute__((address_space(3))) bf16x8*)(kp+6144); kf[7]=*(const __attribute__((address_space(3))) bf16x8*)(kp+6656);
}
__device__ __forceinline__ void kload2(bf16x8*kf,lds_cptr kp,int j){ kf[2*j]=*(const __attribute__((address_space(3))) bf16x8*)(kp+j*2048); kf[2*j+1]=*(const __attribute__((address_space(3))) bf16x8*)(kp+j*2048+512); }
__device__ __forceinline__ s16x4 vtr(lds_cptr p){ return __builtin_bit_cast(s16x4,__builtin_amdgcn_ds_read_tr16_b64_v4i16((__attribute__((address_space(3))) v4i16_t*)p)); }
__device__ __forceinline__ float rowmax(const f32x16&p0,const f32x16&p1){
  float a=max3f(p0[0],p0[1],p1[0]),b=max3f(p0[2],p0[3],p1[1]);a=max3f(a,p1[2],p1[3]);
  #pragma unroll
  for(int r=4;r<16;r+=4){a=max3f(a,p0[r],p0[r+1]);b=max3f(b,p0[r+2],p0[r+3]);a=max3f(a,p1[r],p1[r+1]);b=max3f(b,p1[r+2],p1[r+3]);}
  const float m=max2f(a,b);
  auto rr=__builtin_amdgcn_permlane32_swap(__float_as_uint(m),__float_as_uint(m),false,false);
  return max2f(__uint_as_float(rr[0]),__uint_as_float(rr[1]));
}
__device__ __forceinline__ void pv(f32x16*o,int vb,bf16x8 pa0,bf16x8 pa1,bf16x8 pa2,bf16x8 pa3){
  #pragma unroll
  for(int d0=0;d0<2;++d0){s16x4 lo[4],hi[4];
    #pragma unroll
    for(int ks=0;ks<4;++ks){
      asm volatile("ds_read_b64_tr_b16 %0,%1 offset:%c2":"=&v"(lo[ks]):"v"(vb),"i"(d0*4096+ks*1024):"memory");
      asm volatile("ds_read_b64_tr_b16 %0,%1 offset:%c2":"=&v"(hi[ks]):"v"(vb),"i"(d0*4096+ks*1024+512):"memory");}
    asm volatile("s_waitcnt lgkmcnt(0)":::"memory");SBAR();
    #define PK(k) (bf16x8){lo[k][0],lo[k][1],lo[k][2],lo[k][3],hi[k][0],hi[k][1],hi[k][2],hi[k][3]}
    o[d0]=__builtin_amdgcn_mfma_f32_32x32x16_bf16(pa0,PK(0),o[d0],0,0,0);
    o[d0]=__builtin_amdgcn_mfma_f32_32x32x16_bf16(pa1,PK(1),o[d0],0,0,0);
    o[d0]=__builtin_amdgcn_mfma_f32_32x32x16_bf16(pa2,PK(2),o[d0],0,0,0);
    o[d0]=__builtin_amdgcn_mfma_f32_32x32x16_bf16(pa3,PK(3),o[d0],0,0,0);
    #undef PK
  }
}

#ifndef ATTN_STORE16
#define ATTN_STORE16(p,v) (*(u32x4*)(p)=(v))
#endif
template<int THRL,int MODE> __device__ __forceinline__ void attn_unit(const AttnJob&J,char*shm){
  const int QP=J.qp,KP=J.kp,OP=J.op,NT0=J.nt0,ROW1=J.row1;
  const int tid=opq_tid(),lane=tid&63,r32=lane&31,hi=lane>>5; const int wid=__builtin_amdgcn_readfirstlane(tid>>6);
  const bf16*Qw=J.Q+(long)(wid*QBLK)*QP;
  const bf16*Kh=J.K,*Vh=J.V;
  const unsigned lds0=(unsigned)(uintptr_t)shm;
  float*wsf=(float*)(shm+LDS_WS)+wid*64;
  const bf16*ksrc=Kh+(long)lane*KP+wid*8;
  const bf16*vsrc=Vh+(long)(16*(wid&3)+(lane>>2))*KP+(wid>>2)*32+(lane&3)*8;
  const unsigned kdst=lds0+LDS_K+wid*1024, vdst=lds0+LDS_V+wid*1024;
  #define TROW(t) ((t)<NT0?(t)*KVBLK:ROW1+((t)-NT0)*KVBLK)
  #define DMA_K(t,slot) glds16(ksrc+(long)TROW(t)*KP,(unsigned)__builtin_amdgcn_readfirstlane(kdst+(slot)))
  #define DMA_V(t,slot) glds16(vsrc+(long)TROW(t)*KP,(unsigned)__builtin_amdgcn_readfirstlane(vdst+(slot)))
  const int vb0=(int)(lds0+LDS_V)+((lane>>4)&1)*32+(lane&3)*8+(4*hi+((lane&15)>>2))*64;
  const char*Kbase=shm+LDS_K; bf16x8 kf[8];
  const lds_cptr shm3=(lds_cptr)shm; const lds_cptr kp0=shm3+LDS_K+hi*1024+r32*16; const lds_cptr vp0=shm3+LDS_V+((lane>>4)&1)*32+(lane&3)*8+(4*hi+((lane&15)>>2))*64;
  const int NT=J.nt;
  DMA_K(0,0);DMA_V(0,0);DMA_K(1,SLOTB);
  bf16x8 qr[4];
  #pragma unroll
  for(int d0=0;d0<4;++d0)qr[d0]=*reinterpret_cast<const bf16x8*>(&Qw[(long)r32*QP+d0*16+hi*8]);
  float mhat=0.f,l_reg=0.f;f32x16 o[2];o[0]=f32x16{};o[1]=f32x16{};f32x16 negm=f32x16{};if constexpr(MODE==0)asm volatile("":"+v"(negm));
  const int kd0=J.kpos1+4*hi-(J.qpos0+wid*QBLK+r32);
  #define CMASK(P0,P1,t) do{ if constexpr(MODE==1){ if((t)>=NT0) wmask(P0,P1,kd0+((t)-NT0)*KVBLK); } }while(0)
  bool resc=false;
  #define START(P0,P1) do{ const float rm=rowmax(P0,P1); resc=false; \
    { const float dl=rm; mhat=fadd_s(mhat,dl); \
      _Pragma("unroll") for(int r=0;r<16;++r){P0[r]=fsub_s(P0[r],dl);P1[r]=fsub_s(P1[r],dl);} \
      if constexpr(MODE==0){ _Pragma("unroll") for(int r=0;r<16;++r)negm[r]=-mhat; asm volatile("":"+v"(negm)); } } \
    _Pragma("unroll") for(int r=0;r<16;++r)P0[r]=__builtin_amdgcn_exp2f(P0[r]); }while(0)
  #define RESC() do{ if(resc){ asm volatile("s_waitcnt lgkmcnt(0)":::"memory"); \
      _Pragma("unroll") for(int d_=0;d_<2;++d_) _Pragma("unroll") for(int r=0;r<16;++r)o[d_][r]*=wsf[crow(r,hi)]; } }while(0)
  f32x16 pA0,pA1,pB0,pB1;
  int sl_prev=0,sl_cur=0,sl_next=SLOTB;
  #define ROT() do{sl_prev=sl_cur;sl_cur=sl_next;sl_next=(sl_next==(NSLOT-1)*SLOTB)?0:sl_next+SLOTB;}while(0)
  DMA_K(2,2*SLOTB);
  WAIT_BAR(3);
  qkt(pA0,pA1,Kbase,qr,f32x16{},r32,hi);asm volatile("s_nop 15\n\ts_nop 7":"+v"(pA0),"+v"(pA1));CMASK(pA0,pA1,0);
  START(pA0,pA1);
  _Pragma("unroll") for(int r=0;r<16;++r)pA1[r]=__builtin_amdgcn_exp2f(pA1[r]);
  WAIT_BAR(0);
  DMA_K(3,0);DMA_V(1,SLOTB);
  ROT();
  kload8(kf,kp0+sl_cur);
  WAIT_BAR(2);
  s16x4 vlo[8],vhi[8]; u32x4 pw0,pw1,pw2,pw3;
  #define PKW(P,B) cvtpk_s(P[B],P[B+1])
  #define PAF(k) __builtin_bit_cast(bf16x8,pw##k)
  #define VFR(i) (bf16x8){vlo[i][0],vlo[i][1],vlo[i][2],vlo[i][3],vhi[i][0],vhi[i][1],vhi[i][2],vhi[i][3]}
  #define PIN(x) asm volatile("":"+v"(x))
  #define MX3(a,b,c) __builtin_fmaxf(__builtin_fmaxf((a),(b)),(c))
  #define GAPA(MF,A0,A1,A2,A3,W0,W1,PW) do{ MF; sacc+=A0; sacc+=A1; sacc+=A2; sacc+=A3; PIN(sacc); W0; W1; PIN(PW); SBAR(); }while(0)
  #define EX(v) __builtin_amdgcn_exp2f(MODE==1?(v)-mhat:(v))
  #define CINIT (MODE==1?f32x16{}:negm)
  #define GAPB(MF,X,B) do{ MF; X[B]=EX(X[B]); X[B+1]=EX(X[B+1]); X[B+2]=EX(X[B+2]); X[B+3]=EX(X[B+3]); PIN(X); SBAR(); }while(0)
  #define VRD(i) do{ vlo[i]=vtr(vp_+(((i)>>2)*4096+((i)&3)*1024)); vhi[i]=vtr(vp_+(((i)>>2)*4096+((i)&3)*1024+512)); }while(0)
  #define KRD(G,j) do{ if(G){ kload2(kf,kp0+sl_next,j); SBAR(); } }while(0)
  #define STEP(C0,C1,P0,P1,t,GK,GV,GL) do{ SBAR(); \
    const lds_cptr vp_=vp0+sl_prev; \
    VRD(0); SBAR(); float sacc=(P0[0]+P0[1]); \
    GAPA(C0=__builtin_amdgcn_mfma_f32_32x32x16_bf16(kf[0],qr[0],CINIT,0,0,0), P0[2],P0[3],P0[4],P0[5],     pw0[0]=PKW(P0,0), pw0[1]=PKW(P0,2), pw0); \
    VRD(4); SBAR(); GAPA(C1=__builtin_amdgcn_mfma_f32_32x32x16_bf16(kf[1],qr[0],CINIT,0,0,0), P0[6],P0[7],P0[8],P0[9],     pw0[2]=PKW(P0,4), pw0[3]=PKW(P0,6), pw0); \
    VRD(1); SBAR(); GAPA(C0=__builtin_amdgcn_mfma_f32_32x32x16_bf16(kf[2],qr[1],C0,0,0,0),   P0[10],P0[11],P0[12],P0[13], pw1[0]=PKW(P0,8), pw1[1]=PKW(P0,10), pw1); \
    VRD(5); SBAR(); GAPA(C1=__builtin_amdgcn_mfma_f32_32x32x16_bf16(kf[3],qr[1],C1,0,0,0),   P0[14],P0[15],P1[0],P1[1],   pw1[2]=PKW(P0,12),pw1[3]=PKW(P0,14), pw1); \
    VRD(2); SBAR(); GAPA(C0=__builtin_amdgcn_mfma_f32_32x32x16_bf16(kf[4],qr[2],C0,0,0,0),   P1[2],P1[3],P1[4],P1[5],     pw2[0]=PKW(P1,0), pw2[1]=PKW(P1,2), pw2); \
    VRD(6); SBAR(); GAPA(C1=__builtin_amdgcn_mfma_f32_32x32x16_bf16(kf[5],qr[2],C1,0,0,0),   P1[6],P1[7],P1[8],P1[9],     pw2[2]=PKW(P1,4), pw2[3]=PKW(P1,6), pw2); \
    VRD(3); SBAR(); GAPA(C0=__builtin_amdgcn_mfma_f32_32x32x16_bf16(kf[6],qr[3],C0,0,0,0),   P1[10],P1[11],P1[12],P1[13], pw3[0]=PKW(P1,8), pw3[1]=PKW(P1,10), pw3); \
    VRD(7); SBAR(); GAPA(C1=__builtin_amdgcn_mfma_f32_32x32x16_bf16(kf[7],qr[3],C1,0,0,0),   P1[14],P1[15],0.f,0.f,       pw3[2]=PKW(P1,12),pw3[3]=PKW(P1,14), pw3); \
    l_reg+=sacc; \
    if(GK){DMA_K((t)+3,sl_cur);} if(GV){DMA_V((t)+1,sl_next);} \
    CMASK(C0,C1,t); \
    { float a=MX3(C0[0],C0[1],C1[0]),b=MX3(C0[2],C0[3],C1[1]); a=MX3(a,C1[2],C1[3]); \
      _Pragma("unroll") for(int r=4;r<16;r+=4){a=MX3(a,C0[r],C0[r+1]);b=MX3(b,C0[r+2],C0[r+3]);a=MX3(a,C1[r],C1[r+1]);b=MX3(b,C1[r+2],C1[r+3]);} \
      float rm=__builtin_fmaxf(a,b); { auto rr=__builtin_amdgcn_permlane32_swap(__float_as_uint(rm),__float_as_uint(rm),false,false); rm=__builtin_fmaxf(__uint_as_float(rr[0]),__uint_as_float(rr[1])); } \
      if constexpr(MODE==1) rm-=mhat; \
      resc=false; \
      if(__builtin_expect(__any(rm>(float)THRL),0)){ const float dl=__builtin_fmaxf(rm,0.f); mhat+=dl; \
        if constexpr(MODE==0){ _Pragma("unroll") for(int r=0;r<16;++r){C0[r]-=dl;C1[r]-=dl;} \
        _Pragma("unroll") for(int r=0;r<16;++r)negm[r]=-mhat; asm volatile("":"+v"(negm)); } \
        const float f=__builtin_amdgcn_exp2f(-dl); l_reg*=f; if(hi==0)wsf[r32]=f; resc=true; } } \
    SBAR(); \
    GAPB(o[0]=__builtin_amdgcn_mfma_f32_32x32x16_bf16(PAF(0),VFR(0),o[0],0,0,0), C0,0); \
    GAPB(o[1]=__builtin_amdgcn_mfma_f32_32x32x16_bf16(PAF(0),VFR(4),o[1],0,0,0), C0,4); \
    KRD(GL,0); GAPB(o[0]=__builtin_amdgcn_mfma_f32_32x32x16_bf16(PAF(1),VFR(1),o[0],0,0,0), C0,8); \
    KRD(GL,1); GAPB(o[1]=__builtin_amdgcn_mfma_f32_32x32x16_bf16(PAF(1),VFR(5),o[1],0,0,0), C0,12); \
    KRD(GL,2); GAPB(o[0]=__builtin_amdgcn_mfma_f32_32x32x16_bf16(PAF(2),VFR(2),o[0],0,0,0), C1,0); \
    KRD(GL,3); GAPB(o[1]=__builtin_amdgcn_mfma_f32_32x32x16_bf16(PAF(2),VFR(6),o[1],0,0,0), C1,4); \
    GAPB(o[0]=__builtin_amdgcn_mfma_f32_32x32x16_bf16(PAF(3),VFR(3),o[0],0,0,0), C1,8); \
    GAPB(o[1]=__builtin_amdgcn_mfma_f32_32x32x16_bf16(PAF(3),VFR(7),o[1],0,0,0), C1,12); \
    }while(0)
  int t=1;
  for(;t+5<NT;t+=2){
    STEP(pB0,pB1,pA0,pA1,t,true,true,true);     WAIT_BAR(2); RESC(); ROT();
    STEP(pA0,pA1,pB0,pB1,t+1,true,true,true);   WAIT_BAR(2); RESC(); ROT();
  }
  #define ENDW(tt) do{ if((tt)+3<NT){WAIT_BAR(2);} else if((tt)+2<NT){WAIT_BAR(1);} else {WAIT_BAR(0);} }while(0)
  for(;t+1<NT;t+=2){
    STEP(pB0,pB1,pA0,pA1,t,(t+3<NT),(t+1<NT),(t+1<NT));       ENDW(t);   RESC(); ROT();
    STEP(pA0,pA1,pB0,pB1,t+1,(t+4<NT),(t+2<NT),(t+2<NT));     ENDW(t+1); RESC(); ROT();
  }
  STEP(pB0,pB1,pA0,pA1,NT-1,false,false,false); RESC();
  { float sacc=pB0[0]+pB0[1]; _Pragma("unroll") for(int r=2;r<16;++r)sacc+=pB0[r]; _Pragma("unroll") for(int r=0;r<16;++r)sacc+=pB1[r]; l_reg+=sacc;
    pw0=(u32x4){PKW(pB0,0),PKW(pB0,2),PKW(pB0,4),PKW(pB0,6)};pw1=(u32x4){PKW(pB0,8),PKW(pB0,10),PKW(pB0,12),PKW(pB0,14)};pw2=(u32x4){PKW(pB1,0),PKW(pB1,2),PKW(pB1,4),PKW(pB1,6)};pw3=(u32x4){PKW(pB1,8),PKW(pB1,10),PKW(pB1,12),PKW(pB1,14)};
    SBAR(); pv(o,vb0+sl_cur,PAF(0),PAF(1),PAF(2),PAF(3)); }
  #undef PKW
  #undef PAF
  #undef VFR
  #undef PIN
  #undef MX3
  #undef GAPA
  #undef GAPB
  #undef EX
  #undef CINIT
  #undef VRD
  #undef KRD
  #undef STEP
  #undef ENDW
  {auto rr=__builtin_amdgcn_permlane32_swap(__float_as_uint(l_reg),__float_as_uint(l_reg),false,false);l_reg=__uint_as_float(rr[0])+__uint_as_float(rr[1]);}
  l_reg+=__builtin_amdgcn_exp2f(J.sink2-mhat);
  if(hi==0)wsf[32+r32]=l_reg;asm volatile("s_waitcnt lgkmcnt(0)":::"memory");
  float rli[16];
  #pragma unroll
  for(int r=0;r<16;++r)rli[r]=__builtin_amdgcn_rcpf(wsf[32+crow(r,hi)]);
  bf16*Ow=J.O+(long)(wid*QBLK)*OP;
  { bf16*stg=(bf16*)(shm+LDS_OST)+wid*2048;
    #pragma unroll
    for(int r=0;r<16;++r){const int orow=crow(r,hi);
      #pragma unroll
      for(int d0=0;d0<2;++d0)stg[orow*64+d0*32+r32]=__float2bfloat16(o[d0][r]*rli[r]);}
    asm volatile("s_waitcnt lgkmcnt(0)":::"memory");
    #pragma unroll
    for(int i=0;i<4;++i){const int row=i*8+(lane>>3),ch=lane&7; const u32x4 v=*(const u32x4*)(stg+row*64+ch*8); ATTN_STORE16(Ow+(long)row*OP+ch*8,v);} }
  asm volatile("s_waitcnt lgkmcnt(0)\n\ts_barrier":::"memory");
  #undef TROW
  #undef DMA_K
  #undef DMA_V
  #undef CMASK
  #undef START
  #undef RESC
  #undef ROT
}
constexpr int ATTN_LDS_BYTES=LDS_BYTES;
#undef SBAR
#undef WAIT_BAR
}
#define GAS __attribute__((address_space(1)))
#define LAS __attribute__((address_space(3)))
typedef unsigned short bf16;
typedef unsigned v4u __attribute__((ext_vector_type(4)));
typedef float f32x4 __attribute__((ext_vector_type(4)));
typedef short bf16x8 __attribute__((ext_vector_type(8)));
typedef GAS unsigned gu32;
typedef GAS unsigned long long gu64;
#define RLX_AGENT __ATOMIC_RELAXED, __HIP_MEMORY_SCOPE_AGENT
#define LDS_WAIT() asm volatile("s_waitcnt lgkmcnt(0)" ::: "memory")
#define VM_WAIT() asm volatile("s_waitcnt vmcnt(0)" ::: "memory")
__device__ __forceinline__ unsigned long long rt() { return __builtin_amdgcn_s_memrealtime(); }
__device__ __forceinline__ unsigned f2bf(float f) { unsigned u = __builtin_bit_cast(unsigned, f); return (u + 0x7fffu + ((u >> 16) & 1u)) >> 16; }
__device__ __forceinline__ unsigned pk2(float lo, float hi) { return f2bf(lo) | (f2bf(hi) << 16); }

#define XB_TMO      128
#define XB_XCNT(j)  (256  + 64 * (j))
#define XB_XSUB(j)  (1280 + 64 * (j))
#define XB_XGEN(j)  (2304 + 64 * (j))
#define XB_TOP      3328
#define XB_TOPGEN   3392
#define XCD_BAR_WORDS 3456
#define XB_SPIN_CAP (1u << 18)

__device__ __forceinline__ unsigned xb_ld(unsigned* p)              { return __hip_atomic_load(p, __ATOMIC_RELAXED, __HIP_MEMORY_SCOPE_AGENT); }
__device__ __forceinline__ unsigned xb_add(unsigned* p, unsigned v) { return __hip_atomic_fetch_add(p, v, __ATOMIC_RELAXED, __HIP_MEMORY_SCOPE_AGENT); }
__device__ __forceinline__ unsigned xb_xcc_id() { return (unsigned)__builtin_amdgcn_s_getreg((3 << 11) | 20) & 0xFu; }
#define XB_SPIN(cond, bar) do { unsigned _sp = 0; while (cond) { __builtin_amdgcn_s_sleep(1); \
    if ((++_sp & 255u) == 0u) { if (xb_ld(&(bar)[XB_TMO])) break; if (_sp > XB_SPIN_CAP) { atomicAdd(&(bar)[XB_TMO], 1u); break; } } } } while (0)

struct XcdBarrier {
    unsigned* bar; unsigned x;
    volatile LAS unsigned* st;
};

__device__ __forceinline__ XcdBarrier xcd_barrier_post(unsigned* bar, volatile LAS unsigned* st) {
    XcdBarrier b; b.bar = bar; b.x = xb_xcc_id(); b.st = st;
    if (opq_tid() == 0) (void)xb_add(&bar[XB_XCNT(b.x)], 1u);
    return b;
}
__device__ __forceinline__ void xcd_barrier_complete(unsigned* bar, unsigned x, unsigned& nloc, unsigned& nx) {
    const unsigned G = gridDim.x * gridDim.y * gridDim.z;
    unsigned sum, cnt, mine, sp = 0u;
    for (;;) {
        sum = 0u; cnt = 0u; mine = 0u;
#pragma unroll
        for (unsigned j = 0; j < 16; ++j) { const unsigned c = xb_ld(&bar[XB_XCNT(j)]); sum += c; cnt += (c > 0u) ? 1u : 0u; mine = (j == x) ? c : mine; }
        if (sum == G) break;
        __builtin_amdgcn_s_sleep(1);
        if ((++sp & 255u) == 0u) { if (xb_ld(&bar[XB_TMO])) break; if (sp > XB_SPIN_CAP) { atomicAdd(&bar[XB_TMO], 1u); break; } }
    }
    nloc = mine > 0u ? mine : 1u; nx = cnt > 0u ? cnt : 1u;
}

__device__ __forceinline__ void xcd_barrier(const XcdBarrier& b) {
    asm volatile("s_waitcnt vmcnt(0)" ::: "memory");
    __syncthreads();
    if (opq_tid() == 0) {
        GAS unsigned* barg = (GAS unsigned*)b.bar; unsigned bxx = b.x; asm volatile("" : "+s"(barg), "+s"(bxx)); unsigned* bar = (unsigned*)barg;
        __builtin_amdgcn_s_waitcnt(0);
        unsigned nloc = b.st[0], nx = b.st[1];
        if (nloc == 0u) { xcd_barrier_complete(bar, bxx, nloc, nx); b.st[0] = nloc; b.st[1] = nx; }
        const unsigned old = xb_add(&bar[XB_XSUB(bxx)], 1u);
        const unsigned gen = old / nloc;
        if (old + 1u == (gen + 1u) * nloc) {
            __builtin_amdgcn_fence(__ATOMIC_RELEASE, "agent");
            asm volatile("s_waitcnt vmcnt(0)" ::: "memory");
            const unsigned og = xb_add(&bar[XB_TOP], 1u);
            const unsigned tg = og / nx;
            if (og + 1u == (tg + 1u) * nx) xb_add(&bar[XB_TOPGEN], 1u);
            else XB_SPIN(xb_ld(&bar[XB_TOPGEN]) == tg, bar);
            __builtin_amdgcn_fence(__ATOMIC_ACQUIRE, "agent");
            xb_add(&bar[XB_XGEN(bxx)], 1u);
            asm volatile("s_waitcnt vmcnt(0)" ::: "memory");
        } else {
            XB_SPIN(xb_ld(&bar[XB_XGEN(bxx)]) == gen, bar);
            __builtin_amdgcn_fence(__ATOMIC_ACQUIRE, "agent");
            asm volatile("s_waitcnt vmcnt(0)" ::: "memory");
        }
    }
    __syncthreads();
}
namespace cg = cooperative_groups;
constexpr int NWAVES = 8, NTHREADS = 512;
constexpr int R = 16640, NCTX = 256, SEQ = 16384, DM = 1024, INC = 6144, NL = 2, NEXP = 16384, SPAN = 65;
constexpr float ALPHA = 1.41421356237f, LN_EPS = 1e-6f, RMS_EPS = 1e-6f, LOG2E = 1.4426950408889634f;
constexpr float QSCALE = 0.125f * 1.4426950408889634f;
constexpr int C_QA = 0, C_KA = 512, C_VA = 640, C_QC = 768, C_KC = 1280, C_VC = 1408, C_XB = 1536, C_GB = 2048, C_GC = 2560, C_GL = 3072;
enum { I_X = 0, I_C, I_CTX, I_CCTX, I_WMOD, I_BMOD, I_WIN, I_QN, I_KN, I_CONVW, I_SINK, I_WBR, I_WOUT, I_LN1G, I_LN1B, I_WPQ, I_SK, I_UT, I_VT, I_LN2G, I_LN2B, N_IN };
constexpr size_t MiB = 1u << 20;
constexpr size_t WS_CTL = 0, CTL_ZERO_BYTES = 1 * MiB;
constexpr size_t WS_MODP = 1 * MiB;
constexpr size_t WS_MODV = WS_MODP + 1536 * 1024;
constexpr size_t WS_ROPE = WS_MODV + 128 * 1024;
constexpr size_t WS_WSM = 3 * MiB, WSM_L = 22 * MiB;
constexpr size_t OW_IN = 0, OW_BR = 12 * MiB, OW_OUT = 15 * MiB, OW_PQ = 17 * MiB, OW_SK = 21 * MiB;
constexpr size_t WS_U = WS_WSM + 2 * WSM_L, WS_V = WS_U + 32 * MiB;
constexpr size_t WS_X = WS_V + 32 * MiB;
constexpr size_t WS_G1 = WS_X + 65 * MiB;
constexpr size_t WS_YO = WS_G1, WS_PQ = WS_G1 + 65 * MiB, WS_IDX = WS_G1 + 130 * MiB, WS_WGT = WS_G1 + 139 * MiB;
constexpr size_t WS_HA = WS_G1 + 195 * MiB, WS_HB = WS_HA + 33 * MiB;
constexpr size_t WS_Y = WS_HB + 33 * MiB;
constexpr size_t WS_END = WS_Y + 49 * MiB;
static_assert(WS_END <= 512 * MiB, "d_ws map");
constexpr int CW_BAR = 4096;
constexpr int RING_BYTES = 131072, LDSCTL_OFF = RING_BYTES, MISC_OFF = LDSCTL_OFF + 320, LDS_BYTES = 147456;
typedef __bf16 bf16x2_t __attribute__((ext_vector_type(2)));
typedef unsigned u32x2 __attribute__((ext_vector_type(2)));

struct Args { const float* in[N_IN]; float* out; unsigned char* ws; int ph_lo, ph_hi, coop, pad; };

__device__ __forceinline__ float wave_sum(float v) {
#pragma unroll
    for (int o = 1; o < 64; o <<= 1) v += __shfl_xor(v, o);
    return v;
}
__device__ __forceinline__ float bflo(unsigned w) { return __uint_as_float(w << 16); }
__device__ __forceinline__ float bfhi(unsigned w) { return __uint_as_float(w & 0xffff0000u); }
__device__ __forceinline__ float bf1(bf16 h) { return __uint_as_float((unsigned)h << 16); }
__device__ __forceinline__ float dot2bf(unsigned w, unsigned x, float acc) { return __builtin_amdgcn_fdot2_f32_bf16(__builtin_bit_cast(bf16x2_t, w), __builtin_bit_cast(bf16x2_t, x), acc, false); }
__device__ __forceinline__ float silu_f(float x) { return x / (1.0f + __expf(-x)); }
__device__ __forceinline__ float gelu_f(float v) {
    const float av = fabsf(v), t = __builtin_amdgcn_rcpf(av * 0.2316418882f + 1.0f);
    float q = t * 0.5307027145f + (-0.7265760135f); q = q * t + 0.7107068705f; q = q * t + (-0.142248368f); q = q * t + 0.127414796f; q = q * t;
    const float e = __builtin_amdgcn_exp2f((v * v) * (-0.72134752044f));
    const float m = v * (q * e);
    return v < 0.f ? m : v - m;
}
__device__ __forceinline__ float vmaxf(float a, float b) { float r; asm("v_max_f32_e32 %0, %1, %2" : "=v"(r) : "v"(a), "v"(b)); return r; }
__device__ __forceinline__ float vminf(float a, float b) { float r; asm("v_min_f32_e32 %0, %1, %2" : "=v"(r) : "v"(a), "v"(b)); return r; }

typedef const __attribute__((address_space(4))) unsigned long long* kargp_t;
__device__ __forceinline__ const float* ain(int k) { kargp_t p = (kargp_t)__builtin_amdgcn_kernarg_segment_ptr(); return (const float*)(const GAS float*)(*(volatile kargp_t)(p + k)); }
__device__ __forceinline__ float* aout() { kargp_t p = (kargp_t)__builtin_amdgcn_kernarg_segment_ptr(); return (float*)(GAS float*)(*(volatile kargp_t)(p + N_IN)); }
struct Frame {
    LAS unsigned char* lds; unsigned char* lds_g;
    int tid, lane, wave, G, bx, vcu, gw, NGW;
    const float* in[N_IN]; float* out; unsigned char* ws;
};
__device__ __forceinline__ void p0_transpose_item(const float* W, int K, int N, bf16* WT, LAS float* scr, int item, int lane) {
    const int nblk = N / 32, kb = item / nblk, nb = item % nblk, k0 = 64 * kb, n0 = 32 * nb;
#pragma unroll 8
    for (int i = 0; i < 32; ++i) { const int kk = 2 * i + (lane >> 5); scr[kk * 33 + (lane & 31)] = W[(size_t)(k0 + kk) * N + n0 + (lane & 31)]; }
    LDS_WAIT(); asm volatile("" ::: "memory");
    const int c = lane & 7;
#pragma unroll
    for (int j = 0; j < 4; ++j) { const int n = (lane >> 3) + 8 * j; const LAS float* s = scr + (8 * c) * 33 + n;
        v4u o; o.x = pk2(s[0 * 33], s[1 * 33]); o.y = pk2(s[2 * 33], s[3 * 33]); o.z = pk2(s[4 * 33], s[5 * 33]); o.w = pk2(s[6 * 33], s[7 * 33]);
        *(GAS v4u*)(WT + (size_t)(n0 + n) * K + k0 + 8 * c) = o; }
    LDS_WAIT(); asm volatile("" ::: "memory");
}
__device__ __forceinline__ void conv_item(const float* src, bf16* dst, size_t item, int lane) {
    const float* s = src + item * 2048; bf16* d = dst + item * 2048;
    f32x4 a[4][2];
#pragma unroll
    for (int j = 0; j < 4; ++j) { a[j][0] = *(const GAS f32x4*)(s + j * 512 + lane * 8); a[j][1] = *(const GAS f32x4*)(s + j * 512 + lane * 8 + 4); }
#pragma unroll
    for (int j = 0; j < 4; ++j) { v4u o; o.x = pk2(a[j][0].x, a[j][0].y); o.y = pk2(a[j][0].z, a[j][0].w); o.z = pk2(a[j][1].x, a[j][1].y); o.w = pk2(a[j][1].z, a[j][1].w);
        *(GAS v4u*)(d + j * 512 + lane * 8) = o; }
}
__device__ __forceinline__ void convert_uv(const Frame& F, const Args& A, int l) {
    const float* us = ain(I_UT) + (size_t)l * NEXP * DM; const float* vs = ain(I_VT) + (size_t)l * NEXP * DM;
    bf16* ud = (bf16*)(F.ws + WS_U); bf16* vd = (bf16*)(F.ws + WS_V);
    for (int it = F.gw; it < 16384; it += F.NGW) { if (it < 8192) conv_item(us, ud, it, F.lane); else conv_item(vs, vd, it - 8192, F.lane); }
}
__device__ __forceinline__ void sincos_d(double a, float& s, float& c) {
    const double n = __builtin_rint(a * 0.63661977236758134308); const double r = a - n * 1.57079632679489661923; const double r2 = r * r;
    double sp = -2.50521083854417187751e-08; sp = sp * r2 + 2.75573192239858906526e-06; sp = sp * r2 - 1.98412698412698412698e-04; sp = sp * r2 + 8.33333333333333333333e-03; sp = sp * r2 - 1.66666666666666666667e-01; sp = sp * r2 * r + r;
    double cp = 2.08767569878680989792e-09; cp = cp * r2 - 2.75573192239858906526e-07; cp = cp * r2 + 2.48015873015873015873e-05; cp = cp * r2 - 1.38888888888888888889e-03; cp = cp * r2 + 4.16666666666666666667e-02; cp = cp * r2 - 0.5; cp = cp * r2 + 1.0;
    const int q = ((int)n) & 3;
    const double ss = (q == 0) ? sp : (q == 1) ? cp : (q == 2) ? -sp : -cp;
    const double cc = (q == 0) ? cp : (q == 1) ? -sp : (q == 2) ? -cp : sp;
    s = (float)ss; c = (float)cc;
}
__device__ __forceinline__ void p0_prologue(const Frame& F, const Args& A) {
    LAS float* scr = (LAS float*)(F.lds + F.wave * 16384);
    constexpr int I_MOD = 768, I_T = 5376, I_SKN = 128, I_RP = 64;
    constexpr int NIT = I_MOD + 2 * I_T + 2 * I_SKN + I_RP;
    for (int it = F.gw; it < NIT; it += F.NGW) {
        int r = it;
        if (r < I_MOD) {
            const int l = r / 384, jb = (r % 384) / 16, ks = r % 16;
            const float* W = ain(I_WMOD) + (size_t)l * DM * INC + (size_t)(ks * 64) * INC + jb * 256 + F.lane * 4;
            const float* cv = ain(I_C) + ks * 64; const float* xv = ain(I_CCTX) + ks * 64;
            f32x4 ac = {0.f, 0.f, 0.f, 0.f}, ax = {0.f, 0.f, 0.f, 0.f};
#pragma unroll 8
            for (int kk = 0; kk < 64; ++kk) { const f32x4 w = *(const GAS f32x4*)(W + (size_t)kk * INC); const float sc = silu_f(cv[kk]), sx = silu_f(xv[kk]); ac += w * sc; ax += w * sx; }
            float* P = (float*)(F.ws + WS_MODP) + ((size_t)(l * 16 + ks) * 2) * INC + jb * 256 + F.lane * 4;
            *(GAS f32x4*)P = ac; *(GAS f32x4*)(P + INC) = ax;
            continue; }
        r -= I_MOD;
        if (r < 2 * I_T) {
            const int l = r / I_T; int q = r % I_T; bf16* wsm = (bf16*)(F.ws + WS_WSM + (size_t)l * WSM_L);
            if (q < 3072) { p0_transpose_item(ain(I_WIN) + (size_t)l * DM * INC, DM, INC, (bf16*)((unsigned char*)wsm + OW_IN), scr, q, F.lane); continue; } q -= 3072;
            if (q < 768) { const int b = q / 256; p0_transpose_item(ain(I_WBR) + ((size_t)l * 3 + b) * 512 * DM, 512, DM, (bf16*)((unsigned char*)wsm + OW_BR) + (size_t)b * DM * 512, scr, q % 256, F.lane); continue; } q -= 768;
            if (q < 512) { p0_transpose_item(ain(I_WOUT) + (size_t)l * DM * DM, DM, DM, (bf16*)((unsigned char*)wsm + OW_OUT), scr, q, F.lane); continue; } q -= 512;
            p0_transpose_item(ain(I_WPQ) + (size_t)l * DM * 2048, DM, 2048, (bf16*)((unsigned char*)wsm + OW_PQ), scr, q, F.lane); continue; }
        r -= 2 * I_T;
        if (r < 2 * I_SKN) { const int l = r / I_SKN; conv_item(ain(I_SK) + (size_t)l * 262144, (bf16*)(F.ws + WS_WSM + (size_t)l * WSM_L + OW_SK), r % I_SKN, F.lane); continue; }
        r -= 2 * I_SKN;
        {
            const int e = r * 64 + F.lane, pos = e >> 4, i = e & 15;
            const float invf = __builtin_amdgcn_exp2f(-(float)i * (13.287712379549449f / 16.0f));
            const float ang = (float)pos * invf; float s, c; sincos_d((double)ang, s, c);
            float* T = (float*)(F.ws + WS_ROPE) + 2 * e; T[0] = c; T[1] = s; }
    }
    convert_uv(F, A, 0);
}
__device__ __forceinline__ void p1_mod_h0(const Frame& F, const Args& A, bf16* H) {
    LAS float* ml = (LAS float*)F.lds;
    const float* MP = (const float*)(F.ws + WS_MODP);
    for (int o = F.tid; o < 4096; o += NTHREADS) { const int v = o >> 11, j = o & 2047; float s = ain(I_BMOD)[j];
#pragma unroll
        for (int ks = 0; ks < 16; ++ks) s += MP[((size_t)ks * 2 + v) * INC + j];
        ml[o] = s; }
    for (int o = F.bx * NTHREADS + F.tid; o < NL * 2 * INC; o += F.G * NTHREADS) { const int l = o / (2 * INC), v = (o / INC) & 1, j = o % INC; float s = ain(I_BMOD)[l * INC + j];
#pragma unroll
        for (int ks = 0; ks < 16; ++ks) s += MP[((size_t)(l * 16 + ks) * 2 + v) * INC + j];
        ((float*)(F.ws + WS_MODV))[o] = s; }
    __syncthreads();
    for (int r = F.gw; r < R; r += F.NGW) {
        const int v = r < NCTX ? 1 : 0; const float* src = r < NCTX ? ain(I_CTX) + (size_t)r * DM : ain(I_X) + (size_t)(r - NCTX) * DM;
#pragma unroll
        for (int j = 0; j < 4; ++j) { const int c = 4 * F.lane + 256 * j; const f32x4 x = *(const GAS f32x4*)(src + c);
            const f32x4 sh = *(const LAS f32x4*)(ml + v * 2048 + c), sc = *(const LAS f32x4*)(ml + v * 2048 + 1024 + c);
            const f32x4 h = x * (sc + 1.0f) + sh; u32x2 w; w.x = pk2(h.x, h.y); w.y = pk2(h.z, h.w); *(GAS u32x2*)(H + (size_t)r * DM + c) = w; }
    }
}
__device__ __forceinline__ void post1_phase(const Frame& F, const Args& A, int l) {
    bf16* G1 = (bf16*)(F.ws + WS_G1); bf16* Y1 = (bf16*)(F.ws + WS_Y) + (size_t)R * 512;
    const float* rope = (const float*)(F.ws + WS_ROPE);
    const float* qn = ain(I_QN) + l * 64; const float* kn = ain(I_KN) + l * 64; const float* cw = ain(I_CONVW) + l * 3 * 512;
    const int g = F.lane >> 4, i = F.lane & 15;
    for (int r = F.gw; r < R; r += F.NGW) {
        bf16* row = G1 + (size_t)r * INC;
        float cr = 1.f, sr = 0.f, cc = 1.f, sc = 0.f;
        if (r >= NCTX) { const int t = r - NCTX, pr = t >> 6, pc = t & 63; cr = rope[(pr * 16 + i) * 2]; sr = rope[(pr * 16 + i) * 2 + 1]; cc = rope[(pc * 16 + i) * 2]; sc = rope[(pc * 16 + i) * 2 + 1]; }
#pragma unroll
        for (int it = 0; it < 5; ++it) {
            const int hh = it * 4 + g;
            const int base = hh < 8 ? C_QA + 64 * hh : hh < 10 ? C_KA + 64 * (hh - 8) : hh < 18 ? C_QC + 64 * (hh - 10) : C_KC + 64 * (hh - 18);
            float e0 = bf1(row[base + i]), e1 = bf1(row[base + 16 + i]), e2 = bf1(row[base + 32 + i]), e3 = bf1(row[base + 48 + i]);
            if (it < 3) {
                float ss = e0 * e0 + e1 * e1 + e2 * e2 + e3 * e3;
                ss += __shfl_xor(ss, 1); ss += __shfl_xor(ss, 2); ss += __shfl_xor(ss, 4); ss += __shfl_xor(ss, 8);
                if (hh < 10) { const float rs = __builtin_amdgcn_rsqf(ss * (1.0f / 64.0f) + RMS_EPS); const float* gn = hh < 8 ? qn : kn;
                    e0 *= rs * gn[i]; e1 *= rs * gn[16 + i]; e2 *= rs * gn[32 + i]; e3 *= rs * gn[48 + i]; }
            }
            float o0 = e0 * cr - e1 * sr, o1 = e1 * cr + e0 * sr, o2 = e2 * cc - e3 * sc, o3 = e3 * cc + e2 * sc;
            if (hh < 8 || (hh >= 10 && hh < 18)) { o0 *= QSCALE; o1 *= QSCALE; o2 *= QSCALE; o3 *= QSCALE; }
            row[base + i] = (bf16)f2bf(o0); row[base + 16 + i] = (bf16)f2bf(o1); row[base + 32 + i] = (bf16)f2bf(o2); row[base + 48 + i] = (bf16)f2bf(o3);
        }
        const int lo = r < NCTX ? 0 : NCTX, hi = r < NCTX ? NCTX - 1 : R - 1, ch = 8 * F.lane;
        float acc[8];
#pragma unroll
        for (int k = 0; k < 8; ++k) acc[k] = 0.f;
#pragma unroll
        for (int d = 0; d < 3; ++d) { const int rr = r - 1 + d;
            if (rr >= lo && rr <= hi) { const bf16* nr = G1 + (size_t)rr * INC;
                const v4u xb = *(const GAS v4u*)(nr + C_XB + ch), gc = *(const GAS v4u*)(nr + C_GC + ch);
                const f32x4 w0 = *(const GAS f32x4*)(cw + d * 512 + ch), w1 = *(const GAS f32x4*)(cw + d * 512 + ch + 4);
                acc[0] += w0.x * bflo(xb.x) * bflo(gc.x); acc[1] += w0.y * bfhi(xb.x) * bfhi(gc.x); acc[2] += w0.z * bflo(xb.y) * bflo(gc.y); acc[3] += w0.w * bfhi(xb.y) * bfhi(gc.y);
                acc[4] += w1.x * bflo(xb.z) * bflo(gc.z); acc[5] += w1.y * bfhi(xb.z) * bfhi(gc.z); acc[6] += w1.z * bflo(xb.w) * bflo(gc.w); acc[7] += w1.w * bfhi(xb.w) * bfhi(gc.w); } }
        const v4u gb = *(const GAS v4u*)(row + C_GB + ch);
        v4u o; o.x = pk2(acc[0] * bflo(gb.x), acc[1] * bfhi(gb.x)); o.y = pk2(acc[2] * bflo(gb.y), acc[3] * bfhi(gb.y)); o.z = pk2(acc[4] * bflo(gb.z), acc[5] * bfhi(gb.z)); o.w = pk2(acc[6] * bflo(gb.w), acc[7] * bfhi(gb.w));
        *(GAS v4u*)(Y1 + (size_t)r * 512 + ch) = o;
    }
}
__device__ __forceinline__ void ln1_phase(const Frame& F, const Args& A, int l, int row0, bf16* H2) {
    const float* YO = (const float*)(F.ws + WS_YO); float* X = (float*)(F.ws + WS_X); const float* MV = (const float*)(F.ws + WS_MODV) + (size_t)l * 2 * INC;
    const float* lg = ain(I_LN1G) + l * DM; const float* lb = ain(I_LN1B) + l * DM;
    for (int r = row0 + F.gw; r < R; r += F.NGW) {
        const float* mv = MV + (r < NCTX ? INC : 0);
        const float* xin = l == 0 ? (r < NCTX ? ain(I_CTX) + (size_t)r * DM : ain(I_X) + (size_t)(r - NCTX) * DM) : X + (size_t)r * DM;
        f32x4 v[4]; float s = 0.f;
#pragma unroll
        for (int j = 0; j < 4; ++j) { const int c = 4 * F.lane + 256 * j; const f32x4 x = *(const GAS f32x4*)(xin + c), y = *(const GAS f32x4*)(YO + (size_t)r * DM + c), g = *(const GAS f32x4*)(mv + 2048 + c);
            v[j] = x * ALPHA + g * y; s += (v[j].x + v[j].y) + (v[j].z + v[j].w); }
        const float mean = wave_sum(s) * (1.f / DM); float s2 = 0.f;
#pragma unroll
        for (int j = 0; j < 4; ++j) { v[j] = v[j] - mean; s2 += (v[j].x * v[j].x + v[j].y * v[j].y) + (v[j].z * v[j].z + v[j].w * v[j].w); }
        const float rstd = 1.f / sqrtf(wave_sum(s2) * (1.f / DM) + LN_EPS);
#pragma unroll
        for (int j = 0; j < 4; ++j) { const int c = 4 * F.lane + 256 * j; const f32x4 gg = *(const GAS f32x4*)(lg + c), bb = *(const GAS f32x4*)(lb + c);
            const f32x4 x1 = v[j] * rstd * gg + bb; *(GAS f32x4*)(X + (size_t)r * DM + c) = x1;
            const f32x4 sh = *(const GAS f32x4*)(mv + 3072 + c), sc = *(const GAS f32x4*)(mv + 4096 + c);
            const f32x4 h = x1 * (sc + 1.0f) + sh; u32x2 w; w.x = pk2(h.x, h.y); w.y = pk2(h.z, h.w); *(GAS u32x2*)(H2 + (size_t)r * DM + c) = w; }
    }
}
typedef float f32x16 __attribute__((ext_vector_type(16)));
__device__ __forceinline__ void ins16(float (&L)[16], float x) {
#pragma unroll
    for (int j = 0; j < 16; ++j) { const float h = vmaxf(L[j], x); x = vminf(L[j], x); L[j] = h; }
}
__device__ __forceinline__ void bitonic16_desc(float (&T)[16]) {
#pragma unroll
    for (int s = 8; s >= 1; s >>= 1)
#pragma unroll
        for (int i = 0; i < 16; ++i) if ((i & s) == 0) { const float h = vmaxf(T[i], T[i + s]), lo = vminf(T[i], T[i + s]); T[i] = h; T[i + s] = lo; }
}
__device__ __forceinline__ void subkey_top16(const bf16* qrow  , const bf16* keys  , int r32, int hi, float (&S)[16]) {
    bf16x8 qf[8];
#pragma unroll
    for (int ks = 0; ks < 8; ++ks) qf[ks] = *(const GAS bf16x8*)(qrow + ks * 16 + hi * 8);
    float L[16];
#pragma unroll
    for (int j = 0; j < 16; ++j) L[j] = -INFINITY;
#pragma unroll 1
    for (int nb = 0; nb < 4; ++nb) { f32x16 acc = f32x16{};
#pragma unroll
        for (int ks = 0; ks < 8; ++ks) { const bf16x8 kf = *(const GAS bf16x8*)(keys + (size_t)(nb * 32 + r32) * 128 + ks * 16 + hi * 8);
            acc = __builtin_amdgcn_mfma_f32_32x32x16_bf16(kf, qf[ks], acc, 0, 0, 0); }
#pragma unroll
        for (int rg = 0; rg < 16; ++rg) { const unsigned n = (unsigned)(nb * 32 + (rg & 3) + 8 * (rg >> 2) + 4 * hi);
            ins16(L, __uint_as_float((__float_as_uint(acc[rg]) & ~127u) | n)); } }
#pragma unroll
    for (int j = 0; j < 16; ++j) { const float other = __shfl_xor(L[15 - j], 32); S[j] = vmaxf(L[j], other); }
    bitonic16_desc(S);
}
__device__ __forceinline__ void scores_phase(const Frame& F, const Args& A, int l, int row0) {
    const bf16* PQ = (const bf16*)(F.ws + WS_PQ); const bf16* SK = (const bf16*)(F.ws + WS_WSM + (size_t)l * WSM_L + OW_SK);
    int* IDX = (int*)(F.ws + WS_IDX); float* WGT = (float*)(F.ws + WS_WGT);
    const int r32 = F.lane & 31, hi = F.lane >> 5;
    LAS unsigned* myl = (LAS unsigned*)(F.lds + F.wave * 2048 + F.lane * 32);
    const int nitems = ((R - row0) / 32) * 8;
    for (int it = F.gw; it < nitems; it += F.NGW) {
        const int h = it & 7, rb = row0 + (it >> 3) * 32, row = rb + r32;
        float S1[16], S2[16];
        subkey_top16(PQ + (size_t)row * 2048 + h * 256, SK + (size_t)(h * 2) * 16384, r32, hi, S1);
        subkey_top16(PQ + (size_t)row * 2048 + h * 256 + 128, SK + (size_t)(h * 2 + 1) * 16384, r32, hi, S2);
#pragma unroll
        for (int q = 0; q < 4; ++q) {
            myl[q] = (__float_as_uint(S1[4 * q]) & 127u) | ((__float_as_uint(S1[4 * q + 1]) & 127u) << 8) | ((__float_as_uint(S1[4 * q + 2]) & 127u) << 16) | ((__float_as_uint(S1[4 * q + 3]) & 127u) << 24);
            myl[4 + q] = (__float_as_uint(S2[4 * q]) & 127u) | ((__float_as_uint(S2[4 * q + 1]) & 127u) << 8) | ((__float_as_uint(S2[4 * q + 2]) & 127u) << 16) | ((__float_as_uint(S2[4 * q + 3]) & 127u) << 24); }
        float T[16];
#pragma unroll
        for (int j = 0; j < 16; ++j) T[j] = -INFINITY;
#pragma unroll
        for (int a = 0; a < 16; ++a)
#pragma unroll
            for (int b = 0; b < 16; ++b) if ((a + 1) * (b + 1) <= 16) ins16(T, __uint_as_float((__float_as_uint(S1[a] + S2[b]) & ~255u) | (unsigned)(a * 16 + b)));
        const float m = T[0]; float e[16], sum = 0.f;
#pragma unroll
        for (int j = 0; j < 16; ++j) { e[j] = __expf(T[j] - m); sum += e[j]; }
        const float inv = 1.0f / sum;
        LDS_WAIT();
        if (hi == 0) {
            const LAS unsigned char* lb = (const LAS unsigned char*)myl;
            int ex[16];
#pragma unroll
            for (int j = 0; j < 16; ++j) { const unsigned pid = __float_as_uint(T[j]) & 255u; ex[j] = (int)lb[pid >> 4] * 128 + (int)lb[16 + (pid & 15u)]; }
            int* ip = IDX + (size_t)row * 128 + h * 16; float* wp = WGT + (size_t)row * 128 + h * 16;
#pragma unroll
            for (int q = 0; q < 4; ++q) { *(GAS v4u*)(ip + 4 * q) = (v4u){(unsigned)ex[4 * q], (unsigned)ex[4 * q + 1], (unsigned)ex[4 * q + 2], (unsigned)ex[4 * q + 3]};
                *(GAS f32x4*)(wp + 4 * q) = (f32x4){e[4 * q] * inv, e[4 * q + 1] * inv, e[4 * q + 2] * inv, e[4 * q + 3] * inv}; }
        }
        LDS_WAIT();
    }
}
template <bool LAST> __device__ __forceinline__ void peer_phase(const Frame& F, const Args& A, int l, int row0, const bf16* H2, bf16* Hn) {
    const bf16* U = (const bf16*)(F.ws + WS_U); const bf16* V = (const bf16*)(F.ws + WS_V);
    const int* IDX = (const int*)(F.ws + WS_IDX); const float* WGT = (const float*)(F.ws + WS_WGT);
    float* X = (float*)(F.ws + WS_X); const float* MVl = (const float*)(F.ws + WS_MODV) + (size_t)l * 2 * INC; const float* MVn = (const float*)(F.ws + WS_MODV) + (size_t)(LAST ? l : l + 1) * 2 * INC;
    const float* lg = ain(I_LN2G) + l * DM; const float* lb = ain(I_LN2B) + l * DM;
    const int lane = F.lane, c0 = 8 * lane, c1 = 512 + 8 * lane;
    LAS int* idxL = (LAS int*)(F.lds + F.wave * 2048); LAS float* wL = (LAS float*)(F.lds + F.wave * 2048 + 512); LAS float* aL = (LAS float*)(F.lds + F.wave * 2048 + 1024);
    const int jx = (lane >> 3) & 7;
    for (int r = row0 + F.gw; r < R; r += F.NGW) {
        idxL[lane] = IDX[(size_t)r * 128 + lane]; idxL[64 + lane] = IDX[(size_t)r * 128 + 64 + lane];
        wL[lane] = WGT[(size_t)r * 128 + lane]; wL[64 + lane] = WGT[(size_t)r * 128 + 64 + lane];
        const v4u h0 = *(const GAS v4u*)(H2 + (size_t)r * DM + c0), h1 = *(const GAS v4u*)(H2 + (size_t)r * DM + c1);
#pragma unroll 2
        for (int c = 0; c < 16; ++c) {
            float p[8];
#pragma unroll
            for (int e = 0; e < 8; ++e) { const int ei = idxL[c * 8 + e]; const bf16* ur = U + (size_t)ei * DM;
                const v4u u0 = *(const GAS v4u*)(ur + c0), u1 = *(const GAS v4u*)(ur + c1);
                float a0 = dot2bf(u0.x, h0.x, 0.f), a1 = dot2bf(u0.y, h0.y, 0.f); a0 = dot2bf(u0.z, h0.z, a0); a1 = dot2bf(u0.w, h0.w, a1);
                a0 = dot2bf(u1.x, h1.x, a0); a1 = dot2bf(u1.y, h1.y, a1); a0 = dot2bf(u1.z, h1.z, a0); a1 = dot2bf(u1.w, h1.w, a1); p[e] = a0 + a1; }
            { const bool up = (lane & 32) != 0;
#pragma unroll
              for (int i = 0; i < 4; ++i) { const float a = p[i], b = p[i + 4]; p[i] = (up ? b : a) + __shfl_xor(up ? a : b, 32); } }
            { const bool up = (lane & 16) != 0;
#pragma unroll
              for (int i = 0; i < 2; ++i) { const float a = p[i], b = p[i + 2]; p[i] = (up ? b : a) + __shfl_xor(up ? a : b, 16); } }
            { const bool up = (lane & 8) != 0; const float a = p[0], b = p[1]; p[0] = (up ? b : a) + __shfl_xor(up ? a : b, 8); }
            float t = p[0]; t += __shfl_xor(t, 4); t += __shfl_xor(t, 2); t += __shfl_xor(t, 1);
            const float av = gelu_f(t) * wL[c * 8 + jx];
            if ((lane & 7) == 0) aL[c * 8 + jx] = av;
        }
        float f[16];
#pragma unroll
        for (int k = 0; k < 16; ++k) f[k] = 0.f;
#pragma unroll 2
        for (int c = 0; c < 16; ++c) {
#pragma unroll
            for (int e = 0; e < 8; ++e) { const int ei = idxL[c * 8 + e]; const float ae = aL[c * 8 + e]; const bf16* vr = V + (size_t)ei * DM;
                const v4u v0 = *(const GAS v4u*)(vr + c0), v1 = *(const GAS v4u*)(vr + c1);
                f[0] += ae * bflo(v0.x); f[1] += ae * bfhi(v0.x); f[2] += ae * bflo(v0.y); f[3] += ae * bfhi(v0.y); f[4] += ae * bflo(v0.z); f[5] += ae * bfhi(v0.z); f[6] += ae * bflo(v0.w); f[7] += ae * bfhi(v0.w);
                f[8] += ae * bflo(v1.x); f[9] += ae * bfhi(v1.x); f[10] += ae * bflo(v1.y); f[11] += ae * bfhi(v1.y); f[12] += ae * bflo(v1.z); f[13] += ae * bfhi(v1.z); f[14] += ae * bflo(v1.w); f[15] += ae * bfhi(v1.w); }
        }
        const float* mv = MVl + (r < NCTX ? INC : 0);
        float v[16]; float s = 0.f;
#pragma unroll
        for (int hseg = 0; hseg < 2; ++hseg)
#pragma unroll
            for (int q = 0; q < 2; ++q) { const int c = (hseg ? c1 : c0) + 4 * q; const f32x4 x = *(const GAS f32x4*)(X + (size_t)r * DM + c), g2 = *(const GAS f32x4*)(mv + 5120 + c);
#pragma unroll
                for (int k = 0; k < 4; ++k) { const float t = x[k] * ALPHA + g2[k] * f[hseg * 8 + q * 4 + k]; v[hseg * 8 + q * 4 + k] = t; s += t; } }
        const float mean = wave_sum(s) * (1.f / DM); float s2 = 0.f;
#pragma unroll
        for (int k = 0; k < 16; ++k) { v[k] -= mean; s2 += v[k] * v[k]; }
        const float rstd = 1.f / sqrtf(wave_sum(s2) * (1.f / DM) + LN_EPS);
        const float* mn = MVn + (r < NCTX ? INC : 0);
#pragma unroll
        for (int hseg = 0; hseg < 2; ++hseg)
#pragma unroll
            for (int q = 0; q < 2; ++q) { const int c = (hseg ? c1 : c0) + 4 * q; const f32x4 gg = *(const GAS f32x4*)(lg + c), bb = *(const GAS f32x4*)(lb + c);
                f32x4 x2;
#pragma unroll
                for (int k = 0; k < 4; ++k) x2[k] = v[hseg * 8 + q * 4 + k] * rstd * gg[k] + bb[k];
                if (LAST) { *(GAS f32x4*)(aout() + (size_t)(r - NCTX) * DM + c) = x2; }
                else { *(GAS f32x4*)(X + (size_t)r * DM + c) = x2;
                    const f32x4 sh = *(const GAS f32x4*)(mn + c), sc = *(const GAS f32x4*)(mn + 1024 + c); const f32x4 hh = x2 * (sc + 1.0f) + sh;
                    u32x2 w; w.x = pk2(hh.x, hh.y); w.y = pk2(hh.z, hh.w); *(GAS u32x2*)(Hn + (size_t)r * DM + c) = w; } }
    }
}
__device__ __forceinline__ void attn_phase(const Frame& F, const Args& A, int l) {
    using attn_body::AttnJob; typedef attn_body::bf16 abf;
    abf* G1 = (abf*)(F.ws + WS_G1); abf* Y0 = (abf*)(F.ws + WS_Y); abf* Y2 = Y0 + (size_t)2 * R * 512;
    char* shm = (char*)F.lds_g;
    const float* sink = ain(I_SINK) + l * 8;
#define OPAQUE_S(x) asm volatile("" : "+s"(x))
#pragma unroll 1
    for (int i = 0; i < 2; ++i) {
        int vc = F.vcu; OPAQUE_S(vc);
        const int u = 2 * vc + i, kvh = u >> 8, hq = kvh * 4 + ((u >> 6) & 3), qb = u & 63; const size_t row = NCTX + 256 * qb;
        AttnJob J; J.Q = G1 + row * INC + C_QA + hq * 64; J.K = G1 + C_KA + kvh * 64; J.V = G1 + C_VA + kvh * 64; J.O = Y0 + row * 512 + hq * 64;
        J.qp = INC; J.kp = INC; J.op = 512; J.nt = R / 64; J.nt0 = R / 64; J.row1 = 0; J.qpos0 = 0; J.kpos1 = 0; J.sink2 = -INFINITY;
        attn_body::attn_unit<8, 0>(J, shm);
    }
#ifndef AT_ONLYA
#pragma unroll 1
    for (int i = 0; i < 2; ++i) {
        int vc = F.vcu; OPAQUE_S(vc);
        const int u = 2 * vc + i, kvh = u >> 8, hq = kvh * 4 + ((u >> 6) & 3), qb = u & 63; const size_t row = NCTX + 256 * qb;
        const int q0 = 256 * qb, lo = q0 - 128 < 0 ? 0 : q0 - 128, hi = q0 + 384 > SEQ ? SEQ : q0 + 384;
        AttnJob J; J.Q = G1 + row * INC + C_QC + hq * 64; J.K = G1 + C_KC + kvh * 64; J.V = G1 + C_VC + kvh * 64; J.O = Y2 + row * 512 + hq * 64;
        J.qp = INC; J.kp = INC; J.op = 512; J.nt0 = NCTX / 64; J.nt = NCTX / 64 + (hi - lo) / 64; J.row1 = NCTX + lo; J.qpos0 = q0; J.kpos1 = lo; J.sink2 = sink[hq] * LOG2E;
        attn_body::attn_unit<8, 1>(J, shm);
    }
    int vx = F.vcu; OPAQUE_S(vx);
    if (l == 0 && vx < 16) {
        const int hq = vx & 7, kvh = hq >> 2; const bool isc = vx >= 8;
        AttnJob J; J.Q = G1 + (isc ? C_QC : C_QA) + hq * 64; J.K = G1 + (isc ? C_KC : C_KA) + kvh * 64; J.V = G1 + (isc ? C_VC : C_VA) + kvh * 64; J.O = (isc ? Y2 : Y0) + hq * 64;
        J.qp = INC; J.kp = INC; J.op = 512; J.nt = NCTX / 64; J.nt0 = NCTX / 64; J.row1 = 0; J.qpos0 = 0; J.kpos1 = 0; J.sink2 = isc ? sink[hq] * LOG2E : -INFINITY;
        attn_body::attn_unit<8, 0>(J, shm);
    }
#endif
}
constexpr int N_PHASES = 2 + 9 * NL;
__global__ void __launch_bounds__(NTHREADS, 2) mk_fwd(Args A) {
    extern __shared__ __attribute__((aligned(16))) unsigned char lds[];
    Frame F0;
    F0.lds = (LAS unsigned char*)lds; F0.lds_g = lds;
    F0.tid = threadIdx.x; F0.lane = F0.tid & 63; F0.wave = __builtin_amdgcn_readfirstlane(F0.tid >> 6);
    F0.G = gridDim.x; F0.bx = blockIdx.x; F0.vcu = (F0.G % 8 == 0) ? (F0.bx % 8) * (F0.G / 8) + F0.bx / 8 : F0.bx;
    F0.gw = F0.bx * NWAVES + F0.wave; F0.NGW = F0.G * NWAVES; F0.ws = A.ws;
    volatile LAS unsigned* MISC = (volatile LAS unsigned*)(F0.lds + MISC_OFF);
    for (int u = F0.tid; u < (LDS_BYTES - LDSCTL_OFF) / 4; u += NTHREADS) ((LAS unsigned*)(F0.lds + LDSCTL_OFF))[u] = 0u;
    __syncthreads();
    const int lo = A.ph_lo, hi = A.ph_hi;
    XcdBarrier bar; bar.bar = (unsigned*)(A.ws + WS_CTL) + CW_BAR; bar.x = 0; bar.st = nullptr;
    if (hi - lo > 1) bar = xcd_barrier_post((unsigned*)(A.ws + WS_CTL) + CW_BAR, MISC + 8);
#ifndef MK_ONLY
#define MK_ONLY -1
#endif
#ifndef MK_MASK
#define MK_MASK 0x7ff
#endif
#define ON(k) ((MK_ONLY < 0 || MK_ONLY == (k)) && ((MK_MASK >> (k)) & 1))
#pragma unroll 1
    for (int ph = lo; ph < hi; ++ph) {
        const int l = ph < 2 ? 0 : (ph - 2) / 9, kind = ph < 2 ? ph : 2 + (ph - 2) % 9;
        Frame F = F0;
        asm volatile("" : "+v"(F.tid), "+v"(F.lane)); asm volatile("" : "+s"(F.wave), "+s"(F.bx), "+s"(F.vcu), "+s"(F.gw));
        { GAS unsigned char* wsg = (GAS unsigned char*)F0.ws; asm volatile("" : "+s"(wsg)); F.ws = (unsigned char*)wsg; }
        bf16* HA = (bf16*)(F.ws + WS_HA); bf16* HB = (bf16*)(F.ws + WS_HB);
        bf16* Hin = (l & 1) ? HB : HA; bf16* Hmg = (l & 1) ? HA : HB;
        const int row0 = (l == NL - 1) ? NCTX : 0;
        const int Mr = R - row0, NPr = Mr / 256;
        unsigned char* wsm = F.ws + WS_WSM + (size_t)l * WSM_L;
        switch (kind) {
        case 0: if (ON(0)) { p0_prologue(F, A); } break;
        case 1: if (ON(1)) { p1_mod_h0(F, A, HA); } break;
        case 2: if (ON(2)) {
            pg8::Gemm g{(const pg8::bf16_t*)Hin, (const pg8::bf16_t*)(wsm + OW_IN), R, INC, DM}; pg8::StaticOrder S; S.init(R, INC, F.G, F.bx);
            pg8::EpiBf16<0> E{(pg8::bf16_t*)(F.ws + WS_G1), INC, nullptr, 0, 0, 1.f};
            pg8::gemm_phase<pg8::EpiBf16<0>, pg8::StaticOrder, true, true>(F.lds, g, S, E);
            if (l > 0) convert_uv(F, A, l);
        } break;
        case 3: if (ON(3)) { post1_phase(F, A, l); } break;
        case 4: if (ON(4)) { attn_phase(F, A, l); } break;
        case 5: if (ON(5)) {
            pg8::Gemm g{(const pg8::bf16_t*)(F.ws + WS_Y) + (size_t)row0 * 512, (const pg8::bf16_t*)(wsm + OW_BR), 3 * R, 3072, 512}; pg8::MergeOrder S; S.init(NPr, SPAN, F.G, F.bx);
            pg8::EpiMerge E{(pg8::bf16_t*)Hmg + (size_t)row0 * DM, (const pg8::bf16_t*)(F.ws + WS_G1) + (size_t)row0 * INC + C_GL, INC, SPAN};
            pg8::gemm_phase<pg8::EpiMerge, pg8::MergeOrder, true, true>(F.lds, g, S, E);
        } break;
        case 6: if (ON(6)) {
            pg8::Gemm g{(const pg8::bf16_t*)Hmg + (size_t)row0 * DM, (const pg8::bf16_t*)(wsm + OW_OUT), Mr, DM, DM}; pg8::StaticOrder S; S.init(Mr, DM, F.G, F.bx);
            pg8::EpiF32 E{(float*)(F.ws + WS_YO) + (size_t)row0 * DM, DM};
            pg8::gemm_phase<pg8::EpiF32, pg8::StaticOrder, true, true>(F.lds, g, S, E);
        } break;
        case 7: if (ON(7)) { ln1_phase(F, A, l, row0, Hin); } break;
        case 8: if (ON(8)) {
            pg8::Gemm g{(const pg8::bf16_t*)Hin + (size_t)row0 * DM, (const pg8::bf16_t*)(wsm + OW_PQ), Mr, 2048, DM}; pg8::StaticOrder S; S.init(Mr, 2048, F.G, F.bx);
            pg8::EpiBf16<0> E{(pg8::bf16_t*)(F.ws + WS_PQ) + (size_t)row0 * 2048, 2048, nullptr, 0, 0, 1.f};
            pg8::gemm_phase<pg8::EpiBf16<0>, pg8::StaticOrder, true, true>(F.lds, g, S, E);
        } break;
        case 9: if (ON(9)) { scores_phase(F, A, l, row0); } break;
        default: if (ON(10)) { if (l == NL - 1) peer_phase<true>(F, A, l, row0, Hin, Hmg); else peer_phase<false>(F, A, l, row0, Hin, Hmg); } break;
        }
        if (ph + 1 < hi) { if (A.coop && ph == lo) { cg::this_grid().sync(); } else { xcd_barrier(bar); } }
    }
#undef ON
}
#ifndef MK_MULTI
#define MK_MULTI 1
#endif
extern "C" void kernel_launch(void* const* d_in, const int* in_sizes, int n_in, void* d_out, int out_size, void* d_ws, size_t ws_size, hipStream_t stream) {
    static int grid = 0;
    if (grid == 0) {
        if (n_in != N_IN || out_size != SEQ * DM || ws_size < WS_END) { fprintf(stderr, "kernel_launch: unexpected shapes (n_in %d, out %d, ws %zu)\n", n_in, out_size, ws_size); grid = -1; return; }
        int dev = 0, cus = 0, per_cu = 0;
        if (hipGetDevice(&dev) != hipSuccess || hipDeviceGetAttribute(&cus, hipDeviceAttributeMultiprocessorCount, dev) != hipSuccess) { grid = -1; return; }
        if (hipFuncSetAttribute((const void*)mk_fwd, hipFuncAttributeMaxDynamicSharedMemorySize, LDS_BYTES) != hipSuccess) { grid = -1; return; }
        if (hipOccupancyMaxActiveBlocksPerMultiprocessor(&per_cu, (const void*)mk_fwd, NTHREADS, LDS_BYTES) != hipSuccess || per_cu < 1) { fprintf(stderr, "kernel_launch: occupancy query says %d\n", per_cu); }
        (void)hipGetLastError();
        grid = cus;
    }
    if (grid < 0) return;
    (void)hipMemsetAsync((char*)d_ws + WS_CTL, 0, CTL_ZERO_BYTES, stream);
    Args a{};
    for (int i = 0; i < N_IN; ++i) a.in[i] = (const float*)d_in[i];
    a.out = (float*)d_out; a.ws = (unsigned char*)d_ws;
#if MK_MULTI
    for (int p = 0; p < N_PHASES; ++p) { a.ph_lo = p; a.ph_hi = p + 1; a.coop = 0; hipLaunchKernelGGL(mk_fwd, dim3(grid), dim3(NTHREADS), LDS_BYTES, stream, a); }
#else
    a.ph_lo = 0; a.ph_hi = N_PHASES; a.coop = 1;
    void* args[] = {&a};
    hipError_t e = hipLaunchCooperativeKernel((void*)mk_fwd, dim3(grid), dim3(NTHREADS), args, LDS_BYTES, stream);
    if (e != hipSuccess) fprintf(stderr, "kernel_launch: cooperative launch failed: %s (grid %d)\n", hipGetErrorString(e), grid);
#endif
}
```

```cpp
#include <hip/hip_runtime.h>
#include <hip/hip_bf16.h>
#include <hip/hip_cooperative_groups.h>
#include <cstdio>
#include <cstdint>
#include <cmath>
__device__ __forceinline__ int opq_tid() { int t = threadIdx.x; asm volatile("" : "+v"(t)); return t; }
namespace pg8 {
#define PG8_LAS __attribute__((address_space(3)))
typedef unsigned short bf16_t;
typedef short bf16x8 __attribute__((ext_vector_type(8)));
typedef float f32x4 __attribute__((ext_vector_type(4)));
typedef unsigned u32x4 __attribute__((ext_vector_type(4)));
constexpr int BM = 256, BK = 64, HALF = 128, HTB = HALF * BK * 2  , STAGE_BYTES = 8 * HTB, NXCD = 8, WGM = 8;

__host__ __device__ __forceinline__ int lds_byte(int r, int c) { const int st = (r >> 4) * 2 + (c >> 5), rr = r & 15, cc = c & 31, ob = rr * 64 + cc * 2; return st * 1024 + (ob ^ (((ob >> 9) & 1) << 5)); }
__host__ __device__ __forceinline__ void stage_rc(int b, int& R, int& C) { const int st = b / 1024, sb = b % 1024, swz = sb ^ (((sb >> 9) & 1) << 5); R = (st >> 1) * 16 + swz / 64; C = (st & 1) * 32 + (swz % 64) / 2; }
__host__ __device__ __forceinline__ int perm32(int rho) { const int n = rho >> 4, i = rho & 15; return 8 * (i >> 2) + 4 * n + (i & 3); }

struct Unit { int pm, pn; };
struct Gemm { const bf16_t* A; const bf16_t* Bt; int M, N, K; };

struct StaticOrder {
    int nM, nN, nwg, G, c;
    __host__ __device__ void init(int M, int N, int G_, int c_) { nM = M / BM; nN = N / BM; nwg = nM * nN; G = G_; c = c_; }
    __host__ __device__ bool next(int i, Unit& u) const {
        const long L = (long)i * G + c; if (L >= nwg) return false;
        int wgid = (int)L; { const int q = nwg / NXCD, r = nwg % NXCD, xcd = wgid % NXCD, off = wgid / NXCD; wgid = (xcd < r ? xcd * (q + 1) : r * (q + 1) + (xcd - r) * q) + off; }
        const int nig = WGM * nN, gid = wgid / nig, fm = gid * WGM, gsz = (nM - fm) < WGM ? (nM - fm) : WGM;
        u.pm = fm + ((wgid % nig) % gsz); u.pn = (wgid % nig) / gsz; return true;
    }
    __device__ __forceinline__ void a_ready(const Unit&) const {}
    __device__ __forceinline__ void done(const Unit&) const {}
};

__device__ __forceinline__ unsigned cvt_pk_bf16(float lo, float hi) { unsigned r; asm volatile("v_cvt_pk_bf16_f32 %0, %1, %2" : "=v"(r) : "v"(lo), "v"(hi)); return r; }
typedef float f32x2 __attribute__((ext_vector_type(2)));
__device__ __forceinline__ f32x2 gelu_pk(f32x2 v) {
    const f32x2 av = __builtin_elementwise_abs(v), d = av * 0.2316418882f + 1.0f;
    f32x2 t; t.x = __builtin_amdgcn_rcpf(d.x); t.y = __builtin_amdgcn_rcpf(d.y);
    f32x2 q = t * 0.5307027145f + (-0.7265760135f); q = q * t + 0.7107068705f; q = q * t + (-0.142248368f); q = q * t + 0.127414796f; q = q * t;
    const f32x2 s = (v * v) * (-0.72134752044f);
    f32x2 e; e.x = __builtin_amdgcn_exp2f(s.x); e.y = __builtin_amdgcn_exp2f(s.y);
    const f32x2 m = v * (q * e), r = v - m;
    f32x2 o; o.x = v.x < 0.f ? m.x : r.x; o.y = v.y < 0.f ? m.y : r.y; return o;
}

template <int ACT  > struct EpiBf16 {
    static constexpr bool PERM = true, AFTER_DRAIN = false; static_assert(ACT == 0 || ACT == 1, "EpiBf16: ACT is 0 (none) or 1 (gelu_pk)");
    bf16_t* O; int ldc; const float* bias; int split_cols; size_t split_stride; float scale0;
    __device__ __forceinline__ void operator()(const f32x4 (&acc)[2][2][4][2], const Unit& u, int wr, int wc, int fr, int fq) const {
        const int row0 = u.pm * BM + wr * 64 + fr; int colt = u.pn * BM; bf16_t* base = O;
        float sc = 1.f; if (split_cols) { const int t = colt / split_cols; base += (size_t)t * split_stride; colt -= t * split_cols; if (t == 0) sc = scale0; }
        const int col0 = colt + wc * 32 + 8 * fq, bcol0 = u.pn * BM + wc * 32 + 8 * fq;
        f32x4 bv[2][2];
#pragma unroll
        for (int bj = 0; bj < 2; ++bj)
#pragma unroll
            for (int n = 0; n < 2; ++n) bv[bj][n] = bias ? *(const f32x4*)(bias + bcol0 + bj * HALF + 4 * n) : (f32x4){0.f, 0.f, 0.f, 0.f};
#pragma unroll
        for (int ai = 0; ai < 2; ++ai)
#pragma unroll
            for (int m = 0; m < 4; ++m) { bf16_t* rowp = base + (size_t)(row0 + ai * HALF + m * 16) * ldc + col0;
#pragma unroll
                for (int bj = 0; bj < 2; ++bj) { f32x4 v0 = acc[ai][bj][m][0] + bv[bj][0], v1 = acc[ai][bj][m][1] + bv[bj][1];
                    if (ACT == 1) { f32x2 a = gelu_pk((f32x2){v0[0], v0[1]}), b = gelu_pk((f32x2){v0[2], v0[3]}), c = gelu_pk((f32x2){v1[0], v1[1]}), d = gelu_pk((f32x2){v1[2], v1[3]});
                        v0 = (f32x4){a.x, a.y, b.x, b.y}; v1 = (f32x4){c.x, c.y, d.x, d.y}; }
                    v0 = v0 * sc; v1 = v1 * sc; u32x4 w; w.x = cvt_pk_bf16(v0[0], v0[1]); w.y = cvt_pk_bf16(v0[2], v0[3]); w.z = cvt_pk_bf16(v1[0], v1[1]); w.w = cvt_pk_bf16(v1[2], v1[3]);
                    *(u32x4*)(rowp + bj * HALF) = w; } }
    }
};

struct PanelStats {
    unsigned* xbuf;
    unsigned* cnt;
    unsigned* tmo;
    int ntn; float eps;
    unsigned code;
    __device__ __forceinline__ bool run(const f32x4 (&v)[2][2][4][2], const Unit& u, int wr, int wc, int fr, int fq, PG8_LAS unsigned char* lds, int wid, int lane) const {
        typedef float f32x2v __attribute__((ext_vector_type(2)));
        PG8_LAS f32x2v* P = (PG8_LAS f32x2v*)lds;
        PG8_LAS f32x2v* S = (PG8_LAS f32x2v*)(lds + 8192);
        PG8_LAS unsigned* flag = (PG8_LAS unsigned*)(lds + 8192 + 2048);
#pragma unroll
        for (int ai = 0; ai < 2; ++ai)
#pragma unroll
            for (int m = 0; m < 4; ++m) {
                float s = 0.f;
#pragma unroll
                for (int bj = 0; bj < 2; ++bj)
#pragma unroll
                    for (int n = 0; n < 2; ++n) { const f32x4 x = v[ai][bj][m][n]; s += (x[0] + x[1]) + (x[2] + x[3]); }
                s += __shfl_xor(s, 16); s += __shfl_xor(s, 32);
                const float mw = s * (1.0f / 64.0f); float q = 0.f;
#pragma unroll
                for (int bj = 0; bj < 2; ++bj)
#pragma unroll
                    for (int n = 0; n < 2; ++n) { const f32x4 d = v[ai][bj][m][n] - mw; q += (d[0] * d[0] + d[1] * d[1]) + (d[2] * d[2] + d[3] * d[3]); }
                q += __shfl_xor(q, 16); q += __shfl_xor(q, 32);
                if (fq == 0) P[(ai * HALF + wr * 64 + m * 16 + fr) * 4 + wc] = (f32x2v){mw, q};
            }
        asm volatile("s_waitcnt lgkmcnt(0)" ::: "memory"); __builtin_amdgcn_s_barrier(); asm volatile("" ::: "memory");
#if defined(BROKEN_EXCHANGE_NO_WAIT)
#warning BROKEN CONTROL BUILD: the row-statistics exchange does not wait; results are wrong by design
        if (blockIdx.x >= 64) { const long long t0_ = clock64(); while (clock64() - t0_ < 60000) __builtin_amdgcn_s_sleep(8); }
#endif
        const int row = wid * 32 + (lane & 31);
        if (lane < 32) {
            const f32x2v a = P[row * 4 + 0], b = P[row * 4 + 1], c = P[row * 4 + 2], d = P[row * 4 + 3];
            const float mt = (a.x + b.x + c.x + d.x) * 0.25f;
            const float da = a.x - mt, db = b.x - mt, dc = c.x - mt, dd = d.x - mt;
            const float m2 = (a.y + b.y) + (c.y + d.y) + 64.0f * ((da * da + db * db) + (dc * dc + dd * dd));
            unsigned long long* slot = (unsigned long long*)xbuf + ((size_t)(u.pm * BM + row) * 4 + u.pn);
            __hip_atomic_store(slot, ((unsigned long long)__float_as_uint(m2) << 32) | __float_as_uint(mt), __ATOMIC_RELAXED, __HIP_MEMORY_SCOPE_AGENT);
        }
        asm volatile("s_waitcnt vmcnt(0)" ::: "memory");
        if (lane == 0) __hip_atomic_fetch_add(cnt + 64 * u.pm, 1u, __ATOMIC_RELAXED, __HIP_MEMORY_SCOPE_AGENT);
        if (wid == 0) {
            bool dead = false; const unsigned long long t0 = __builtin_amdgcn_s_memrealtime(); const unsigned want = 8u * (unsigned)ntn;
            for (;;) {
#if defined(BROKEN_EXCHANGE_NO_WAIT)
                break;
#endif
                if ((unsigned)__builtin_amdgcn_readfirstlane(__hip_atomic_load(cnt + 64 * u.pm, __ATOMIC_RELAXED, __HIP_MEMORY_SCOPE_AGENT)) >= want) break;
                if (__builtin_amdgcn_s_memrealtime() - t0 > 2000000ull) {
                    if (lane == 0) { unsigned expect = 0u; __hip_atomic_compare_exchange_strong(tmo + 1, &expect, code | (unsigned)(u.pm & 0xff), __ATOMIC_RELAXED, __ATOMIC_RELAXED, __HIP_MEMORY_SCOPE_AGENT);
                                     __hip_atomic_store(tmo, 1u, __ATOMIC_RELAXED, __HIP_MEMORY_SCOPE_AGENT); }
                    dead = true; break; }
                __builtin_amdgcn_s_sleep(2);
            }
            __builtin_amdgcn_fence(__ATOMIC_ACQUIRE, "agent");
            if (lane == 0) flag[0] = dead ? 1u : 0u;
        }
        asm volatile("s_waitcnt vmcnt(0) lgkmcnt(0)" ::: "memory"); __builtin_amdgcn_s_barrier(); asm volatile("" ::: "memory");
        const bool bad = flag[0] != 0u;
        if (lane < 32) {
            const unsigned long long* slot = (const unsigned long long*)xbuf + (size_t)(u.pm * BM + row) * 4; float mt[4], m2[4]; float ms = 0.f;
#pragma unroll
            for (int t = 0; t < 4; ++t) { if (t < ntn) { const unsigned long long w = __hip_atomic_load(slot + t, __ATOMIC_RELAXED, __HIP_MEMORY_SCOPE_AGENT); mt[t] = __uint_as_float((unsigned)w); m2[t] = __uint_as_float((unsigned)(w >> 32)); } else { mt[t] = 0.f; m2[t] = 0.f; } ms += mt[t]; }
            const float mean = ms / (float)ntn; float q = 0.f;
#pragma unroll
            for (int t = 0; t < 4; ++t) if (t < ntn) { const float dm = mt[t] - mean; q += m2[t] + 256.0f * dm * dm; }
            S[row] = (f32x2v){mean, 1.0f / sqrtf(q / (256.0f * (float)ntn) + eps)};
        }
        asm volatile("s_waitcnt lgkmcnt(0)" ::: "memory"); __builtin_amdgcn_s_barrier(); asm volatile("" ::: "memory");
        return bad;
    }
};
struct EpiLnRes {
    static constexpr bool PERM = false, AFTER_DRAIN = true;
    const float* base; float* out; int ldc; const float* bias; PanelStats st; unsigned poison;
    __device__ __forceinline__ void fused(f32x4 (&acc)[2][2][4][2], const Unit& u, int wr, int wc, int fr, int fq, PG8_LAS unsigned char* lds, int wid, int lane) const {
        typedef float f32x2v __attribute__((ext_vector_type(2)));
        const PG8_LAS f32x2v* S = (const PG8_LAS f32x2v*)(lds + 8192);
        const int col0 = u.pn * BM + wc * 32 + 4 * fq;
#pragma unroll
        for (int bj = 0; bj < 2; ++bj)
#pragma unroll
            for (int n = 0; n < 2; ++n) { const f32x4 bv = bias ? *(const f32x4*)(bias + col0 + bj * HALF + n * 16) : (f32x4){0.f, 0.f, 0.f, 0.f};
#pragma unroll
                for (int ai = 0; ai < 2; ++ai)
#pragma unroll
                    for (int m = 0; m < 4; ++m) acc[ai][bj][m][n] += bv; }
        f32x4 pre[4][2][2];
#pragma unroll
        for (int m = 0; m < 4; ++m) { const size_t off = (size_t)(u.pm * BM + wr * 64 + m * 16 + fr) * ldc + col0;
#pragma unroll
            for (int bj = 0; bj < 2; ++bj)
#pragma unroll
                for (int n = 0; n < 2; ++n) pre[m][bj][n] = *(const f32x4*)(base + off + bj * HALF + n * 16); }
        const bool bad = st.run(acc, u, wr, wc, fr, fq, lds, wid, lane) || poison != 0u;
        const float qnan = __builtin_nanf("");
#pragma unroll
        for (int ai = 0; ai < 2; ++ai)
#pragma unroll
            for (int m = 0; m < 4; ++m) { const int r = ai * HALF + wr * 64 + m * 16 + fr; const f32x2v sr = S[r]; const size_t off = (size_t)(u.pm * BM + r) * ldc + col0;
#pragma unroll
                for (int bj = 0; bj < 2; ++bj)
#pragma unroll
                    for (int n = 0; n < 2; ++n) { const f32x4 bs = ai == 0 ? pre[m][bj][n] : *(const f32x4*)(base + off + bj * HALF + n * 16); f32x4 o = bs + (acc[ai][bj][m][n] - sr.x) * sr.y;
                        if (bad) o = (f32x4){qnan, qnan, qnan, qnan}; *(f32x4*)(out + off + bj * HALF + n * 16) = o; }
                if (m & 1) asm volatile("" ::: "memory"); }
    }
};
struct EpiLnResLn {
    static constexpr bool PERM = false, AFTER_DRAIN = true;
    const float* base; float* out; bf16_t* xn; int ldc; const float* bias; PanelStats st1, st2; unsigned poison;
    __device__ __forceinline__ void fused(f32x4 (&acc)[2][2][4][2], const Unit& u, int wr, int wc, int fr, int fq, PG8_LAS unsigned char* lds, int wid, int lane) const {
        typedef float f32x2v __attribute__((ext_vector_type(2))); typedef unsigned u32x2v __attribute__((ext_vector_type(2)));
        const PG8_LAS f32x2v* S = (const PG8_LAS f32x2v*)(lds + 8192);
        const int col0 = u.pn * BM + wc * 32 + 4 * fq;
#pragma unroll
        for (int bj = 0; bj < 2; ++bj)
#pragma unroll
            for (int n = 0; n < 2; ++n) { const f32x4 bv = bias ? *(const f32x4*)(bias + col0 + bj * HALF + n * 16) : (f32x4){0.f, 0.f, 0.f, 0.f};
#pragma unroll
                for (int ai = 0; ai < 2; ++ai)
#pragma unroll
                    for (int m = 0; m < 4; ++m) acc[ai][bj][m][n] += bv; }
        bool bad = st1.run(acc, u, wr, wc, fr, fq, lds, wid, lane) || poison != 0u;
        const float qnan = __builtin_nanf("");
#pragma unroll
        for (int ai = 0; ai < 2; ++ai)
#pragma unroll
            for (int m = 0; m < 4; ++m) { const int r = ai * HALF + wr * 64 + m * 16 + fr; const f32x2v sr = S[r]; const size_t off = (size_t)(u.pm * BM + r) * ldc + col0;
#pragma unroll
                for (int bj = 0; bj < 2; ++bj)
#pragma unroll
                    for (int n = 0; n < 2; ++n) { const f32x4 bs = *(const f32x4*)(base + off + bj * HALF + n * 16); acc[ai][bj][m][n] = bs + (acc[ai][bj][m][n] - sr.x) * sr.y; }
                asm volatile("" : "+v"(acc[ai][0][m][0]), "+v"(acc[ai][0][m][1]), "+v"(acc[ai][1][m][0]), "+v"(acc[ai][1][m][1]));
                if (m & 1) asm volatile("" ::: "memory"); }
        const bool bad1 = bad;
        bad = st2.run(acc, u, wr, wc, fr, fq, lds, wid, lane) || bad;
#pragma unroll
        for (int ai = 0; ai < 2; ++ai)
#pragma unroll
            for (int m = 0; m < 4; ++m) { const int r = ai * HALF + wr * 64 + m * 16 + fr; const f32x2v sr = S[r]; const size_t off = (size_t)(u.pm * BM + r) * ldc + col0;
#pragma unroll
                for (int bj = 0; bj < 2; ++bj)
#pragma unroll
                    for (int n = 0; n < 2; ++n) { const f32x4 x1 = acc[ai][bj][m][n]; *(f32x4*)(out + off + bj * HALF + n * 16) = bad1 ? (f32x4){qnan, qnan, qnan, qnan} : x1;
                        const f32x4 o = (x1 - sr.x) * sr.y; u32x2v w; w.x = cvt_pk_bf16(o[0], o[1]); w.y = cvt_pk_bf16(o[2], o[3]);
                        if (bad) { w.x = 0x7fc07fc0u; w.y = 0x7fc07fc0u; } *(u32x2v*)(xn + off + bj * HALF + n * 16) = w; }
                asm volatile("" ::: "memory"); }
    }
};

template <class Epi, class Sched, bool ALIGN_EPI = false, bool SP2 = false>
__device__ __forceinline__ void gemm_phase(PG8_LAS unsigned char* lds, const Gemm g, const Sched& S, const Epi& E) {
    const int tid = opq_tid(), wid = __builtin_amdgcn_readfirstlane(tid >> 6), lane = tid & 63, wr = wid >> 2, wc = wid & 3, fr = lane & 15, fq = lane >> 4;
    const int K = g.K, nt = K / BK;
    unsigned voffA[2], voffB[2];
#pragma unroll
    for (int i = 0; i < 2; ++i) { int R, C; stage_rc(tid * 16 + i * 8192, R, C); const int Rb = Epi::PERM ? ((R & ~31) + perm32(R & 31)) : R;
        voffA[i] = (unsigned)(R * K + C) * 2u; voffB[i] = (unsigned)(Rb * K + C) * 2u; }
    const size_t kstep = (size_t)(BK * 2);
    const size_t hstep = (size_t)HALF * K * 2;
    const size_t tstep = 2 * hstep;
    const unsigned ldsw = (unsigned)wid * 1024u;
    const int aoff = lds_byte(wr * 64 + fr, fq * 8), boff = lds_byte(wc * 32 + fr, fq * 8);
#define PG8_SA(b, h) (((b) * 2 + (h)) * HTB)
#define PG8_SB(b, h) ((4 + (b) * 2 + (h)) * HTB)
#define PG8_STAGE(bufoff, gbase, voff) do { _Pragma("unroll") for (int _i = 0; _i < 2; ++_i) \
        __builtin_amdgcn_global_load_lds((const unsigned*)((const char*)(gbase) + (voff)[_i]), (PG8_LAS unsigned*)(lds + (bufoff) + ldsw + _i * 8192), 16, 0, 0); } while (0)
#define PG8_LDA(dst, b, h) do { _Pragma("unroll") for (int m = 0; m < 4; ++m) _Pragma("unroll") for (int k = 0; k < 2; ++k) dst[m][k] = *(const PG8_LAS bf16x8*)(lds + PG8_SA(b, h) + aoff + m * 2048 + k * 1024); } while (0)
#define PG8_LDB(dst, b, h) do { _Pragma("unroll") for (int n = 0; n < 2; ++n) _Pragma("unroll") for (int k = 0; k < 2; ++k) dst[n][k] = *(const PG8_LAS bf16x8*)(lds + PG8_SB(b, h) + boff + n * 2048 + k * 1024); } while (0)
#define PG8_MMA(ai, bj, At, Bt) do { __builtin_amdgcn_s_setprio(1); _Pragma("unroll") for (int m = 0; m < 4; ++m) _Pragma("unroll") for (int n = 0; n < 2; ++n) _Pragma("unroll") for (int k = 0; k < 2; ++k) \
        acc[ai][bj][m][n] = __builtin_amdgcn_mfma_f32_16x16x32_bf16(Bt[n][k], At[m][k], acc[ai][bj][m][n], 0, 0, 0); __builtin_amdgcn_s_setprio(0); } while (0)
#define PG8_WAIT_V(n) asm volatile("s_waitcnt vmcnt(" #n ")" ::: "memory")
#define PG8_WAIT_L(n) asm volatile("s_waitcnt lgkmcnt(" #n ")" ::: "memory")
#define PG8_BAR __builtin_amdgcn_s_barrier()
#define PG8_SCHED __builtin_amdgcn_sched_barrier(0)
    Unit cur, nxt; int ui = 0;
    if (!S.next(0, cur)) return;
    f32x4 acc[2][2][4][2];
#pragma unroll
    for (int a = 0; a < 2; ++a)
#pragma unroll
        for (int b = 0; b < 2; ++b)
#pragma unroll
            for (int m = 0; m < 4; ++m)
#pragma unroll
                for (int n = 0; n < 2; ++n) acc[a][b][m][n] = (f32x4){0.f, 0.f, 0.f, 0.f};
    bf16x8 At[4][2], B0[2][2], B1[2][2];
    const char* cA = (const char*)g.A + (size_t)cur.pm * tstep; const char* cB = (const char*)g.Bt + (size_t)cur.pn * tstep;
    S.a_ready(cur);
    if constexpr (SP2) {
        PG8_STAGE(PG8_SB(0, 0), cB, voffB); PG8_STAGE(PG8_SB(0, 1), cB + hstep, voffB); PG8_STAGE(PG8_SA(0, 0), cA, voffA); PG8_STAGE(PG8_SA(0, 1), cA + hstep, voffA);
        if (wr == 1) PG8_BAR;
        PG8_WAIT_V(2); PG8_BAR;
        PG8_STAGE(PG8_SB(1, 0), cB + kstep, voffB); PG8_STAGE(PG8_SA(1, 0), cA + kstep, voffA); PG8_STAGE(PG8_SB(1, 1), cB + hstep + kstep, voffB);
        PG8_WAIT_V(6); PG8_BAR;
    } else {
        PG8_STAGE(PG8_SB(0, 0), cB, voffB); PG8_STAGE(PG8_SA(0, 0), cA, voffA); PG8_STAGE(PG8_SB(0, 1), cB + hstep, voffB); PG8_STAGE(PG8_SA(0, 1), cA + hstep, voffA);
        if (wr == 1) PG8_BAR;
        PG8_WAIT_V(4); PG8_BAR;
        PG8_STAGE(PG8_SB(1, 0), cB + kstep, voffB); PG8_STAGE(PG8_SA(1, 0), cA + kstep, voffA); PG8_STAGE(PG8_SB(1, 1), cB + hstep + kstep, voffB);
        PG8_WAIT_V(6); PG8_BAR;
    }
    for (;;) {
        const bool has_next = S.next(ui + 1, nxt);
        const char* nA = has_next ? (const char*)g.A + (size_t)nxt.pm * tstep : cA; const char* nB = has_next ? (const char*)g.Bt + (size_t)nxt.pn * tstep : cB;
        for (int t = 0; t < nt; t += 2) {
            const bool last = (t == nt - 2);
            const char* a1 = cA + (size_t)(t + 1) * kstep;
            const char* a2 = last ? nA : cA + (size_t)(t + 2) * kstep; const char* b2 = last ? nB : cB + (size_t)(t + 2) * kstep;
            const char* a3 = a2 + kstep; const char* b3 = b2 + kstep;
            if (last && has_next) S.a_ready(nxt);
            if constexpr (SP2) {
            PG8_LDB(B0, 0, 0); PG8_LDB(B1, 0, 1); PG8_SCHED; PG8_LDA(At, 0, 0); PG8_STAGE(PG8_SA(1, 1), a1 + hstep, voffA);
            PG8_WAIT_V(8); PG8_WAIT_L(0); PG8_BAR; PG8_MMA(0, 0, At, B0); PG8_MMA(0, 1, At, B1); PG8_BAR; PG8_SCHED;
            PG8_LDA(At, 0, 1); PG8_STAGE(PG8_SB(0, 0), b2, voffB); PG8_STAGE(PG8_SB(0, 1), b2 + hstep, voffB); PG8_STAGE(PG8_SA(0, 0), a2, voffA);
            PG8_WAIT_V(8); PG8_WAIT_L(0); PG8_BAR; PG8_MMA(1, 0, At, B0); PG8_MMA(1, 1, At, B1); PG8_BAR; PG8_SCHED;
            PG8_LDB(B0, 1, 0); PG8_LDB(B1, 1, 1); PG8_SCHED; PG8_LDA(At, 1, 0); PG8_STAGE(PG8_SA(0, 1), a2 + hstep, voffA);
            PG8_WAIT_V(8); PG8_WAIT_L(0); PG8_BAR; PG8_MMA(0, 0, At, B0); PG8_MMA(0, 1, At, B1); PG8_BAR; PG8_SCHED;
            PG8_LDA(At, 1, 1); PG8_STAGE(PG8_SB(1, 0), b3, voffB); PG8_STAGE(PG8_SB(1, 1), b3 + hstep, voffB); PG8_STAGE(PG8_SA(1, 0), a3, voffA);
            PG8_WAIT_V(8); PG8_WAIT_L(0); PG8_BAR; PG8_MMA(1, 0, At, B0); PG8_MMA(1, 1, At, B1); PG8_BAR; PG8_SCHED;
            } else {
            PG8_LDB(B0, 0, 0); PG8_SCHED; PG8_LDA(At, 0, 0); PG8_STAGE(PG8_SA(1, 1), a1 + hstep, voffA);
            PG8_WAIT_L(8); PG8_BAR; PG8_WAIT_L(0); PG8_MMA(0, 0, At, B0); PG8_BAR; PG8_SCHED;
            PG8_LDB(B1, 0, 1); PG8_STAGE(PG8_SB(0, 0), b2, voffB);
            PG8_BAR; PG8_WAIT_L(0); PG8_MMA(0, 1, At, B1); PG8_BAR;
            PG8_LDA(At, 0, 1); PG8_STAGE(PG8_SA(0, 0), a2, voffA);
            PG8_BAR; PG8_WAIT_L(0); PG8_MMA(1, 0, At, B0); PG8_BAR; PG8_SCHED;
            PG8_STAGE(PG8_SB(0, 1), b2 + hstep, voffB);
            PG8_WAIT_V(6); PG8_BAR; PG8_MMA(1, 1, At, B1); PG8_BAR;
            PG8_LDB(B0, 1, 0); PG8_SCHED; PG8_LDA(At, 1, 0); PG8_STAGE(PG8_SA(0, 1), a2 + hstep, voffA);
            PG8_WAIT_L(8); PG8_BAR; PG8_WAIT_L(0); PG8_MMA(0, 0, At, B0); PG8_BAR; PG8_SCHED;
            PG8_LDB(B1, 1, 1); PG8_STAGE(PG8_SB(1, 0), b3, voffB);
            PG8_BAR; PG8_WAIT_L(0); PG8_MMA(0, 1, At, B1); PG8_BAR;
            PG8_LDA(At, 1, 1); PG8_STAGE(PG8_SA(1, 0), a3, voffA);
            PG8_BAR; PG8_WAIT_L(0); PG8_MMA(1, 0, At, B0); PG8_BAR; PG8_SCHED;
            PG8_STAGE(PG8_SB(1, 1), b3 + hstep, voffB);
            PG8_WAIT_V(6); PG8_BAR; PG8_MMA(1, 1, At, B1); PG8_BAR;
            }
        }
        if constexpr (ALIGN_EPI) { if (wr == 0) PG8_BAR; }
        if constexpr (!Epi::AFTER_DRAIN) { E(acc, cur, wr, wc, fr, fq); S.done(cur); }
        if (!has_next) break;
#pragma unroll
        for (int a = 0; a < 2; ++a)
#pragma unroll
            for (int b = 0; b < 2; ++b)
#pragma unroll
                for (int m = 0; m < 4; ++m)
#pragma unroll
                    for (int n = 0; n < 2; ++n) acc[a][b][m][n] = (f32x4){0.f, 0.f, 0.f, 0.f};
        cur = nxt; cA = nA; cB = nB; ++ui;
        if constexpr (ALIGN_EPI) { if (wr == 1) PG8_BAR; }
    }
    PG8_WAIT_V(0);
    if constexpr (!ALIGN_EPI) { if (wr == 0) PG8_BAR; }
    PG8_BAR;
    if constexpr (Epi::AFTER_DRAIN) { E.fused(acc, cur, wr, wc, fr, fq, lds, wid, lane); S.done(cur); }
#undef PG8_SA
#undef PG8_SB
#undef PG8_STAGE
#undef PG8_LDA
#undef PG8_LDB
#undef PG8_MMA
#undef PG8_WAIT_V
#undef PG8_WAIT_L
#undef PG8_BAR
#undef PG8_SCHED
}
}
namespace pg8 {
struct EpiF32 {
    static constexpr bool PERM = false, AFTER_DRAIN = false;
    float* C; int ldc;
    __device__ __forceinline__ void operator()(const f32x4 (&acc)[2][2][4][2], const Unit& u, int wr, int wc, int fr, int fq) const {
        const int row0 = u.pm * BM + wr * 64 + fr, col0 = u.pn * BM + wc * 32 + 4 * fq;
#pragma unroll
        for (int ai = 0; ai < 2; ++ai)
#pragma unroll
            for (int m = 0; m < 4; ++m) { float* rowp = C + (size_t)(row0 + ai * HALF + m * 16) * ldc + col0;
#pragma unroll
                for (int bj = 0; bj < 2; ++bj)
#pragma unroll
                    for (int n = 0; n < 2; ++n) *(f32x4*)(rowp + bj * HALF + n * 16) = acc[ai][bj][m][n]; }
    }
};
__device__ __forceinline__ float bf_lo(unsigned w) { return __uint_as_float(w << 16); }
__device__ __forceinline__ float bf_hi(unsigned w) { return __uint_as_float(w & 0xffff0000u); }
__device__ __forceinline__ float sigmoidf_(float x) { return 1.0f / (1.0f + __expf(-x)); }
struct EpiMerge {
    static constexpr bool PERM = true, AFTER_DRAIN = false;
    bf16_t* Mg; const bf16_t* glog; int ldg; int SP;
    __device__ __forceinline__ void operator()(const f32x4 (&acc)[2][2][4][2], const Unit& u, int wr, int wc, int fr, int fq) const {
        const int b = u.pn >> 2, pn = u.pn & 3, pm = u.pm - b * SP;
        const int row0 = pm * BM + wr * 64 + fr, col0 = pn * BM + wc * 32 + 8 * fq;
#pragma unroll
        for (int ai = 0; ai < 2; ++ai)
#pragma unroll
            for (int m = 0; m < 4; ++m) { const size_t row = (size_t)(row0 + ai * HALF + m * 16);
#pragma unroll
                for (int bj = 0; bj < 2; ++bj) { const int col = col0 + bj * HALF;
                    const u32x4 g = *(const u32x4*)(glog + row * ldg + b * 1024 + col);
                    f32x4 v0 = acc[ai][bj][m][0], v1 = acc[ai][bj][m][1];
                    v0[0] *= sigmoidf_(bf_lo(g.x)); v0[1] *= sigmoidf_(bf_hi(g.x)); v0[2] *= sigmoidf_(bf_lo(g.y)); v0[3] *= sigmoidf_(bf_hi(g.y));
                    v1[0] *= sigmoidf_(bf_lo(g.z)); v1[1] *= sigmoidf_(bf_hi(g.z)); v1[2] *= sigmoidf_(bf_lo(g.w)); v1[3] *= sigmoidf_(bf_hi(g.w));
                    u32x4* dst = (u32x4*)(Mg + row * 1024 + col);
                    if (b != 0) { const u32x4 o = *dst;
                        v0[0] += bf_lo(o.x); v0[1] += bf_hi(o.x); v0[2] += bf_lo(o.y); v0[3] += bf_hi(o.y);
                        v1[0] += bf_lo(o.z); v1[1] += bf_hi(o.z); v1[2] += bf_lo(o.w); v1[3] += bf_hi(o.w); }
                    u32x4 w; w.x = cvt_pk_bf16(v0[0], v0[1]); w.y = cvt_pk_bf16(v0[2], v0[3]); w.z = cvt_pk_bf16(v1[0], v1[1]); w.w = cvt_pk_bf16(v1[2], v1[3]);
                    *dst = w; } }
    }
};
struct MergeOrder {
    int NP, SP, nwg, G, c;
    __host__ __device__ void init(int NP_, int SP_, int G_, int c_) { NP = NP_; SP = SP_; nwg = NP_ * 4; G = G_; c = c_; }
    __host__ __device__ bool next(int i, Unit& u) const {
        const int ti = i / 3, b = i - 3 * ti;
        const long L = (long)ti * G + c; if (L >= nwg) return false;
        int wgid = (int)L; { const int q = nwg / NXCD, r = nwg % NXCD, xcd = wgid % NXCD, off = wgid / NXCD; wgid = (xcd < r ? xcd * (q + 1) : r * (q + 1) + (xcd - r) * q) + off; }
        const int nN = 4, nig = WGM * nN, gid = wgid / nig, fm = gid * WGM, gsz = (NP - fm) < WGM ? (NP - fm) : WGM;
        const int pm = fm + ((wgid % nig) % gsz), pn = (wgid % nig) / gsz;
        u.pm = b * SP + pm; u.pn = b * 4 + pn; return true;
    }
    __device__ __forceinline__ void a_ready(const Unit&) const {}
    __device__ __forceinline__ void done(const Unit&) const {}
};
}
#include <hip/hip_bf16.h>
#include <cmath>
namespace attn_body {
using bf16=__hip_bfloat16;
using bf16x8=__attribute__((ext_vector_type(8)))short;
using s16x4=__attribute__((ext_vector_type(4)))short;
using f32x16=__attribute__((ext_vector_type(16)))float;
using u32x4=__attribute__((ext_vector_type(4)))unsigned;
constexpr int D=64;
constexpr int NW=8,QBLK=32,QB=QBLK*NW,KVBLK=64;
constexpr int ATTN_UNIT_ROWS=QB;
__device__ __forceinline__ int crow(int r,int hi){return (r&3)+8*(r>>2)+4*hi;}
#define SBAR() __builtin_amdgcn_sched_barrier(0)
constexpr int WIN=128;
__device__ __forceinline__ void wmask(f32x16&p0,f32x16&p1,int kd){
  const float NEG=-INFINITY;
  #pragma unroll
  for(int r=0;r<16;++r){const int d0=kd+(r&3)+8*(r>>2); if(d0>WIN||d0<-WIN)p0[r]=NEG; const int d1=d0+32; if(d1>WIN||d1<-WIN)p1[r]=NEG;}
}
struct AttnJob {
  const bf16* Q; const bf16* K; const bf16* V; bf16* O;
  int qp, kp, op;
  int nt, nt0, row1;
  int qpos0, kpos1;
  float sink2;
};
constexpr int NSLOT=3, SLOTB=8192;
constexpr int LDS_K=0, LDS_V=NSLOT*SLOTB, LDS_WS=2*NSLOT*SLOTB, LDS_OST=LDS_WS+NW*64*4, LDS_BYTES=LDS_OST+NW*4096;
constexpr float C2=0.125f*1.4426950408889634f;
__device__ __forceinline__ void glds16(const void*gsrc,unsigned lds_dst){unsigned keep;
  asm volatile("s_mov_b32 %0, m0\n\ts_mov_b32 m0, %2\n\ts_nop 0\n\tglobal_load_lds_dwordx4 %1, off\n\ts_mov_b32 m0, %0":"=&s"(keep):"v"(gsrc),"s"(lds_dst):"memory");}
__device__ __forceinline__ float max3f(float a,float b,float c){float r;asm("v_max3_f32 %0, %1, %2, %3":"=v"(r):"v"(a),"v"(b),"v"(c));return r;}
__device__ __forceinline__ float max2f(float a,float b){float r;asm("v_max_f32_e32 %0, %1, %2":"=v"(r):"v"(a),"v"(b));return r;}
__device__ __forceinline__ float fadd_s(float a,float b){float r;asm("v_add_f32_e32 %0, %1, %2":"=v"(r):"v"(a),"v"(b));return r;}
__device__ __forceinline__ float fsub_s(float a,float b){float r;asm("v_sub_f32_e32 %0, %1, %2":"=v"(r):"v"(a),"v"(b));return r;}
typedef float f32x2_t __attribute__((ext_vector_type(2))); typedef __bf16 bf16x2_t __attribute__((ext_vector_type(2)));
__device__ __forceinline__ unsigned cvtpk_s(float lo,float hi){f32x2_t v={lo,hi};bf16x2_t b=__builtin_convertvector(v,bf16x2_t);return __builtin_bit_cast(unsigned,b);}
#define WAIT_BAR(N) asm volatile("s_waitcnt vmcnt(" #N ") lgkmcnt(0)\n\ts_barrier":::"memory")

__device__ __forceinline__ void qkt(f32x16&p0,f32x16&p1,const char*Kslot,const bf16x8*qr,const f32x16&negm,int r32,int hi){
  const char*kb=Kslot+hi*1024+r32*16;
  #pragma unroll
  for(int d0=0;d0<4;++d0){
    const bf16x8 b0=*reinterpret_cast<const bf16x8*>(kb+d0*2048);
    const bf16x8 b1=*reinterpret_cast<const bf16x8*>(kb+d0*2048+512);
    if(d0==0){p0=__builtin_amdgcn_mfma_f32_32x32x16_bf16(b0,qr[0],negm,0,0,0);p1=__builtin_amdgcn_mfma_f32_32x32x16_bf16(b1,qr[0],negm,0,0,0);}
    else{p0=__builtin_amdgcn_mfma_f32_32x32x16_bf16(b0,qr[d0],p0,0,0,0);p1=__builtin_amdgcn_mfma_f32_32x32x16_bf16(b1,qr[d0],p1,0,0,0);}}
}
typedef __attribute__((address_space(3))) const char* lds_cptr;
typedef short v4i16_t __attribute__((ext_vector_type(4)));
__device__ __forceinline__ void kload8(bf16x8*kf,lds_cptr kp){
  kf[0]=*(const __attribute__((address_space(3))) bf16x8*)(kp);      kf[1]=*(const __attribute__((address_space(3))) bf16x8*)(kp+512);
  kf[2]=*(const __attribute__((address_space(3))) bf16x8*)(kp+2048); kf[3]=*(const __attribute__((address_space(3))) bf16x8*)(kp+2560);
  kf[4]=*(const __attribute__((address_space(3))) bf16x8*)(kp+4096); kf[5]=*(const __attribute__((address_space(3))) bf16x8*)(kp+4608);
  kf[6]=*(const __attribute__((address_space(3))) bf16x8*)(kp+6144); kf[7]=*(const __attribute__((address_space(3))) bf16x8*)(kp+6656);
}
__device__ __forceinline__ void kload2(bf16x8*kf,lds_cptr kp,int j){ kf[2*j]=*(const __attribute__((address_space(3))) bf16x8*)(kp+j*2048); kf[2*j+1]=*(const __attribute__((address_space(3))) bf16x8*)(kp+j*2048+512); }
__device__ __forceinline__ s16x4 vtr(lds_cptr p){ return __builtin_bit_cast(s16x4,__builtin_amdgcn_ds_read_tr16_b64_v4i16((__attribute__((address_space(3))) v4i16_t*)p)); }
__device__ __forceinline__ float rowmax(const f32x16&p0,const f32x16&p1){
  float a=max3f(p0[0],p0[1],p1[0]),b=max3f(p0[2],p0[3],p1[1]);a=max3f(a,p1[2],p1[3]);
  #pragma unroll
  for(int r=4;r<16;r+=4){a=max3f(a,p0[r],p0[r+1]);b=max3f(b,p0[r+2],p0[r+3]);a=max3f(a,p1[r],p1[r+1]);b=max3f(b,p1[r+2],p1[r+3]);}
  const float m=max2f(a,b);
  auto rr=__builtin_amdgcn_permlane32_swap(__float_as_uint(m),__float_as_uint(m),false,false);
  return max2f(__uint_as_float(rr[0]),__uint_as_float(rr[1]));
}
__device__ __forceinline__ void pv(f32x16*o,int vb,bf16x8 pa0,bf16x8 pa1,bf16x8 pa2,bf16x8 pa3){
  #pragma unroll
  for(int d0=0;d0<2;++d0){s16x4 lo[4],hi[4];
    #pragma unroll
    for(int ks=0;ks<4;++ks){
      asm volatile("ds_read_b64_tr_b16 %0,%1 offset:%c2":"=&v"(lo[ks]):"v"(vb),"i"(d0*4096+ks*1024):"memory");
      asm volatile("ds_read_b64_tr_b16 %0,%1 offset:%c2":"=&v"(hi[ks]):"v"(vb),"i"(d0*4096+ks*1024+512):"memory");}
    asm volatile("s_waitcnt lgkmcnt(0)":::"memory");SBAR();
    #define PK(k) (bf16x8){lo[k][0],lo[k][1],lo[k][2],lo[k][3],hi[k][0],hi[k][1],hi[k][2],hi[k][3]}
    o[d0]=__builtin_amdgcn_mfma_f32_32x32x16_bf16(pa0,PK(0),o[d0],0,0,0);
    o[d0]=__builtin_amdgcn_mfma_f32_32x32x16_bf16(pa1,PK(1),o[d0],0,0,0);
    o[d0]=__builtin_amdgcn_mfma_f32_32x32x16_bf16(pa2,PK(2),o[d0],0,0,0);
    o[d0]=__builtin_amdgcn_mfma_f32_32x32x16_bf16(pa3,PK(3),o[d0],0,0,0);
    #undef PK
  }
}

#ifndef ATTN_STORE16
#define ATTN_STORE16(p,v) (*(u32x4*)(p)=(v))
#endif
template<int THRL,int MODE> __device__ __forceinline__ void attn_unit(const AttnJob&J,char*shm){
  const int QP=J.qp,KP=J.kp,OP=J.op,NT0=J.nt0,ROW1=J.row1;
  const int tid=opq_tid(),lane=tid&63,r32=lane&31,hi=lane>>5; const int wid=__builtin_amdgcn_readfirstlane(tid>>6);
  const bf16*Qw=J.Q+(long)(wid*QBLK)*QP;
  const bf16*Kh=J.K,*Vh=J.V;
  const unsigned lds0=(unsigned)(uintptr_t)shm;
  float*wsf=(float*)(shm+LDS_WS)+wid*64;
  const bf16*ksrc=Kh+(long)lane*KP+wid*8;
  const bf16*vsrc=Vh+(long)(16*(wid&3)+(lane>>2))*KP+(wid>>2)*32+(lane&3)*8;
  const unsigned kdst=lds0+LDS_K+wid*1024, vdst=lds0+LDS_V+wid*1024;
  #define TROW(t) ((t)<NT0?(t)*KVBLK:ROW1+((t)-NT0)*KVBLK)
  #define DMA_K(t,slot) glds16(ksrc+(long)TROW(t)*KP,(unsigned)__builtin_amdgcn_readfirstlane(kdst+(slot)))
  #define DMA_V(t,slot) glds16(vsrc+(long)TROW(t)*KP,(unsigned)__builtin_amdgcn_readfirstlane(vdst+(slot)))
  const int vb0=(int)(lds0+LDS_V)+((lane>>4)&1)*32+(lane&3)*8+(4*hi+((lane&15)>>2))*64;
  const char*Kbase=shm+LDS_K; bf16x8 kf[8];
  const lds_cptr shm3=(lds_cptr)shm; const lds_cptr kp0=shm3+LDS_K+hi*1024+r32*16; const lds_cptr vp0=shm3+LDS_V+((lane>>4)&1)*32+(lane&3)*8+(4*hi+((lane&15)>>2))*64;
  const int NT=J.nt;
  DMA_K(0,0);DMA_V(0,0);DMA_K(1,SLOTB);
  bf16x8 qr[4];
  #pragma unroll
  for(int d0=0;d0<4;++d0)qr[d0]=*reinterpret_cast<const bf16x8*>(&Qw[(long)r32*QP+d0*16+hi*8]);
  float mhat=0.f,l_reg=0.f;f32x16 o[2];o[0]=f32x16{};o[1]=f32x16{};f32x16 negm=f32x16{};if constexpr(MODE==0)asm volatile("":"+v"(negm));
  const int kd0=J.kpos1+4*hi-(J.qpos0+wid*QBLK+r32);
  #define CMASK(P0,P1,t) do{ if constexpr(MODE==1){ if((t)>=NT0) wmask(P0,P1,kd0+((t)-NT0)*KVBLK); } }while(0)
  bool resc=false;
  #define START(P0,P1) do{ const float rm=rowmax(P0,P1); resc=false; \
    { const float dl=rm; mhat=fadd_s(mhat,dl); \
      _Pragma("unroll") for(int r=0;r<16;++r){P0[r]=fsub_s(P0[r],dl);P1[r]=fsub_s(P1[r],dl);} \
      if constexpr(MODE==0){ _Pragma("unroll") for(int r=0;r<16;++r)negm[r]=-mhat; asm volatile("":"+v"(negm)); } } \
    _Pragma("unroll") for(int r=0;r<16;++r)P0[r]=__builtin_amdgcn_exp2f(P0[r]); }while(0)
  #define RESC() do{ if(resc){ asm volatile("s_waitcnt lgkmcnt(0)":::"memory"); \
      _Pragma("unroll") for(int d_=0;d_<2;++d_) _Pragma("unroll") for(int r=0;r<16;++r)o[d_][r]*=wsf[crow(r,hi)]; } }while(0)
  f32x16 pA0,pA1,pB0,pB1;
  int sl_prev=0,sl_cur=0,sl_next=SLOTB;
  #define ROT() do{sl_prev=sl_cur;sl_cur=sl_next;sl_next=(sl_next==(NSLOT-1)*SLOTB)?0:sl_next+SLOTB;}while(0)
  DMA_K(2,2*SLOTB);
  WAIT_BAR(3);
  qkt(pA0,pA1,Kbase,qr,f32x16{},r32,hi);asm volatile("s_nop 15\n\ts_nop 7":"+v"(pA0),"+v"(pA1));CMASK(pA0,pA1,0);
  START(pA0,pA1);
  _Pragma("unroll") for(int r=0;r<16;++r)pA1[r]=__builtin_amdgcn_exp2f(pA1[r]);
  WAIT_BAR(0);
  DMA_K(3,0);DMA_V(1,SLOTB);
  ROT();
  kload8(kf,kp0+sl_cur);
  WAIT_BAR(2);
  s16x4 vlo[8],vhi[8]; u32x4 pw0,pw1,pw2,pw3;
  #define PKW(P,B) cvtpk_s(P[B],P[B+1])
  #define PAF(k) __builtin_bit_cast(bf16x8,pw##k)
  #define VFR(i) (bf16x8){vlo[i][0],vlo[i][1],vlo[i][2],vlo[i][3],vhi[i][0],vhi[i][1],vhi[i][2],vhi[i][3]}
  #define PIN(x) asm volatile("":"+v"(x))
  #define MX3(a,b,c) __builtin_fmaxf(__builtin_fmaxf((a),(b)),(c))
  #define GAPA(MF,A0,A1,A2,A3,W0,W1,PW) do{ MF; sacc+=A0; sacc+=A1; sacc+=A2; sacc+=A3; PIN(sacc); W0; W1; PIN(PW); SBAR(); }while(0)
  #define EX(v) __builtin_amdgcn_exp2f(MODE==1?(v)-mhat:(v))
  #define CINIT (MODE==1?f32x16{}:negm)
  #define GAPB(MF,X,B) do{ MF; X[B]=EX(X[B]); X[B+1]=EX(X[B+1]); X[B+2]=EX(X[B+2]); X[B+3]=EX(X[B+3]); PIN(X); SBAR(); }while(0)
  #define VRD(i) do{ vlo[i]=vtr(vp_+(((i)>>2)*4096+((i)&3)*1024)); vhi[i]=vtr(vp_+(((i)>>2)*4096+((i)&3)*1024+512)); }while(0)
  #define KRD(G,j) do{ if(G){ kload2(kf,kp0+sl_next,j); SBAR(); } }while(0)
  #define STEP(C0,C1,P0,P1,t,GK,GV,GL) do{ SBAR(); \
    const lds_cptr vp_=vp0+sl_prev; \
    VRD(0); SBAR(); float sacc=(P0[0]+P0[1]); \
    GAPA(C0=__builtin_amdgcn_mfma_f32_32x32x16_bf16(kf[0],qr[0],CINIT,0,0,0), P0[2],P0[3],P0[4],P0[5],     pw0[0]=PKW(P0,0), pw0[1]=PKW(P0,2), pw0); \
    VRD(4); SBAR(); GAPA(C1=__builtin_amdgcn_mfma_f32_32x32x16_bf16(kf[1],qr[0],CINIT,0,0,0), P0[6],P0[7],P0[8],P0[9],     pw0[2]=PKW(P0,4), pw0[3]=PKW(P0,6), pw0); \
    VRD(1); SBAR(); GAPA(C0=__builtin_amdgcn_mfma_f32_32x32x16_bf16(kf[2],qr[1],C0,0,0,0),   P0[10],P0[11],P0[12],P0[13], pw1[0]=PKW(P0,8), pw1[1]=PKW(P0,10), pw1); \
    VRD(5); SBAR(); GAPA(C1=__builtin_amdgcn_mfma_f32_32x32x16_bf16(kf[3],qr[1],C1,0,0,0),   P0[14],P0[15],P1[0],P1[1],   pw1[2]=PKW(P0,12),pw1[3]=PKW(P0,14), pw1); \
    VRD(2); SBAR(); GAPA(C0=__builtin_amdgcn_mfma_f32_32x32x16_bf16(kf[4],qr[2],C0,0,0,0),   P1[2],P1[3],P1[4],P1[5],     pw2[0]=PKW(P1,0), pw2[1]=PKW(P1,2), pw2); \
    VRD(6); SBAR(); GAPA(C1=__builtin_amdgcn_mfma_f32_32x32x16_bf16(kf[5],qr[2],C1,0,0,0),   P1[6],P1[7],P1[8],P1[9],     pw2[2]=PKW(P1,4), pw2[3]=PKW(P1,6), pw2); \
    VRD(3); SBAR(); GAPA(C0=__builtin_amdgcn_mfma_f32_32x32x16_bf16(kf[6],qr[3],C0,0,0,0),   P1[10],P1[11],P1[12],P1[13], pw3[0]=PKW(P1,8), pw3[1]=PKW(P1,10), pw3); \
    VRD(7); SBAR(); GAPA(C1=__builtin_amdgcn_mfma_f32_32x32x16_bf16(kf[7],qr[3],C1,0,0,0),   P1[14],P1[15],0.f,0.f,       pw3[2]=PKW(P1,12),pw3[3]=PKW(P1,14), pw3); \
    l_reg+=sacc; \
    if(GK){DMA_K((t)+3,sl_cur);} if(GV){DMA_V((t)+1,sl_next);} \
    CMASK(C0,C1,t); \
    { float a=MX3(C0[0],C0[1],C1[0]),b=MX3(C0[2],C0[3],C1[1]); a=MX3(a,C1[2],C1[3]); \
      _Pragma("unroll") for(int r=4;r<16;r+=4){a=MX3(a,C0[r],C0[r+1]);b=MX3(b,C0[r+2],C0[r+3]);a=MX3(a,C1[r],C1[r+1]);b=MX3(b,C1[r+2],C1[r+3]);} \
      float rm=__builtin_fmaxf(a,b); { auto rr=__builtin_amdgcn_permlane32_swap(__float_as_uint(rm),__float_as_uint(rm),false,false); rm=__builtin_fmaxf(__uint_as_float(rr[0]),__uint_as_float(rr[1])); } \
      if constexpr(MODE==1) rm-=mhat; \
      resc=false; \
      if(__builtin_expect(__any(rm>(float)THRL),0)){ const float dl=__builtin_fmaxf(rm,0.f); mhat+=dl; \
        if constexpr(MODE==0){ _Pragma("unroll") for(int r=0;r<16;++r){C0[r]-=dl;C1[r]-=dl;} \
        _Pragma("unroll") for(int r=0;r<16;++r)negm[r]=-mhat; asm volatile("":"+v"(negm)); } \
        const float f=__builtin_amdgcn_exp2f(-dl); l_reg*=f; if(hi==0)wsf[r32]=f; resc=true; } } \
    SBAR(); \
    GAPB(o[0]=__builtin_amdgcn_mfma_f32_32x32x16_bf16(PAF(0),VFR(0),o[0],0,0,0), C0,0); \
    GAPB(o[1]=__builtin_amdgcn_mfma_f32_32x32x16_bf16(PAF(0),VFR(4),o[1],0,0,0), C0,4); \
    KRD(GL,0); GAPB(o[0]=__builtin_amdgcn_mfma_f32_32x32x16_bf16(PAF(1),VFR(1),o[0],0,0,0), C0,8); \
    KRD(GL,1); GAPB(o[1]=__builtin_amdgcn_mfma_f32_32x32x16_bf16(PAF(1),VFR(5),o[1],0,0,0), C0,12); \
    KRD(GL,2); GAPB(o[0]=__builtin_amdgcn_mfma_f32_32x32x16_bf16(PAF(2),VFR(2),o[0],0,0,0), C1,0); \
    KRD(GL,3); GAPB(o[1]=__builtin_amdgcn_mfma_f32_32x32x16_bf16(PAF(2),VFR(6),o[1],0,0,0), C1,4); \
    GAPB(o[0]=__builtin_amdgcn_mfma_f32_32x32x16_bf16(PAF(3),VFR(3),o[0],0,0,0), C1,8); \
    GAPB(o[1]=__builtin_amdgcn_mfma_f32_32x32x16_bf16(PAF(3),VFR(7),o[1],0,0,0), C1,12); \
    }while(0)
  int t=1;
  for(;t+5<NT;t+=2){
    STEP(pB0,pB1,pA0,pA1,t,true,true,true);     WAIT_BAR(2); RESC(); ROT();
    STEP(pA0,pA1,pB0,pB1,t+1,true,true,true);   WAIT_BAR(2); RESC(); ROT();
  }
  #define ENDW(tt) do{ if((tt)+3<NT){WAIT_BAR(2);} else if((tt)+2<NT){WAIT_BAR(1);} else {WAIT_BAR(0);} }while(0)
  for(;t+1<NT;t+=2){
    STEP(pB0,pB1,pA0,pA1,t,(t+3<NT),(t+1<NT),(t+1<NT));       ENDW(t);   RESC(); ROT();
    STEP(pA0,pA1,pB0,pB1,t+1,(t+4<NT),(t+2<NT),(t+2<NT));     ENDW(t+1); RESC(); ROT();
  }
  STEP(pB0,pB1,pA0,pA1,NT-1,false,false,false); RESC();
  { float sacc=pB0[0]+pB0[1]; _Pragma("unroll") for(int r=2;r<16;++r)sacc+=pB0[r]; _Pragma("unroll") for(int r=0;r<16;++r)sacc+=pB1[r]; l_reg+=sacc;
    pw0=(u32x4){PKW(pB0,0),PKW(pB0,2),PKW(pB0,4),PKW(pB0,6)};pw1=(u32x4){PKW(pB0,8),PKW(pB0,10),PKW(pB0,12),PKW(pB0,14)};pw2=(u32x4){PKW(pB1,0),PKW(pB1,2),PKW(pB1,4),PKW(pB1,6)};pw3=(u32x4){PKW(pB1,8),PKW(pB1,10),PKW(pB1,12),PKW(pB1,14)};
    SBAR(); pv(o,vb0+sl_cur,PAF(0),PAF(1),PAF(2),PAF(3)); }
  #undef PKW
  #undef PAF
  #undef VFR
  #undef PIN
  #undef MX3
  #undef GAPA
  #undef GAPB
  #undef EX
  #undef CINIT
  #undef VRD
  #undef KRD
  #undef STEP
  #undef ENDW
  {auto rr=__builtin_amdgcn_permlane32_swap(__float_as_uint(l_reg),__float_as_uint(l_reg),false,false);l_reg=__uint_as_float(rr[0])+__uint_as_float(rr[1]);}
  l_reg+=__builtin_amdgcn_exp2f(J.sink2-mhat);
  if(hi==0)wsf[32+r32]=l_reg;asm volatile("s_waitcnt lgkmcnt(0)":::"memory");
  float rli[16];
  #pragma unroll
  for(int r=0;r<16;++r)rli[r]=__builtin_amdgcn_rcpf(wsf[32+crow(r,hi)]);
  bf16*Ow=J.O+(long)(wid*QBLK)*OP;
  { bf16*stg=(bf16*)(shm+LDS_OST)+wid*2048;
    #pragma unroll
    for(int r=0;r<16;++r){const int orow=crow(r,hi);
      #pragma unroll
      for(int d0=0;d0<2;++d0)stg[orow*64+d0*32+r32]=__float2bfloat16(o[d0][r]*rli[r]);}
    asm volatile("s_waitcnt lgkmcnt(0)":::"memory");
    #pragma unroll
    for(int i=0;i<4;++i){const int row=i*8+(lane>>3),ch=lane&7; const u32x4 v=*(const u32x4*)(stg+row*64+ch*8); ATTN_STORE16(Ow+(long)row*OP+ch*8,v);} }
  asm volatile("s_waitcnt lgkmcnt(0)\n\ts_barrier":::"memory");
  #undef TROW
  #undef DMA_K
  #undef DMA_V
  #undef CMASK
  #undef START
  #undef RESC
  #undef ROT
}
constexpr int ATTN_LDS_BYTES=LDS_BYTES;
#undef SBAR
#undef WAIT_BAR
}
#define GAS __attribute__((address_space(1)))
#define LAS __attribute__((address_space(3)))
typedef unsigned short bf16;
typedef unsigned v4u __attribute__((ext_vector_type(4)));
typedef float f32x4 __attribute__((ext_vector_type(4)));
typedef short bf16x8 __attribute__((ext_vector_type(8)));
typedef GAS unsigned gu32;
typedef GAS unsigned long long gu64;
#define RLX_AGENT __ATOMIC_RELAXED, __HIP_MEMORY_SCOPE_AGENT
#define LDS_WAIT() asm volatile("s_waitcnt lgkmcnt(0)" ::: "memory")
#define VM_WAIT() asm volatile("s_waitcnt vmcnt(0)" ::: "memory")
__device__ __forceinline__ unsigned long long rt() { return __builtin_amdgcn_s_memrealtime(); }
__device__ __forceinline__ unsigned f2bf(float f) { unsigned u = __builtin_bit_cast(unsigned, f); return (u + 0x7fffu + ((u >> 16) & 1u)) >> 16; }
__device__ __forceinline__ unsigned pk2(float lo, float hi) { return f2bf(lo) | (f2bf(hi) << 16); }

#define XB_TMO      128
#define XB_XCNT(j)  (256  + 64 * (j))
#define XB_XSUB(j)  (1280 + 64 * (j))
#define XB_XGEN(j)  (2304 + 64 * (j))
#define XB_TOP      3328
#define XB_TOPGEN   3392
#define XCD_BAR_WORDS 3456
#define XB_SPIN_CAP (1u << 18)

__device__ __forceinline__ unsigned xb_ld(unsigned* p)              { return __hip_atomic_load(p, __ATOMIC_RELAXED, __HIP_MEMORY_SCOPE_AGENT); }
__device__ __forceinline__ unsigned xb_add(unsigned* p, unsigned v) { return __hip_atomic_fetch_add(p, v, __ATOMIC_RELAXED, __HIP_MEMORY_SCOPE_AGENT); }
__device__ __forceinline__ unsigned xb_xcc_id() { return (unsigned)__builtin_amdgcn_s_getreg((3 << 11) | 20) & 0xFu; }
#define XB_SPIN(cond, bar) do { unsigned _sp = 0; while (cond) { __builtin_amdgcn_s_sleep(1); \
    if ((++_sp & 255u) == 0u) { if (xb_ld(&(bar)[XB_TMO])) break; if (_sp > XB_SPIN_CAP) { atomicAdd(&(bar)[XB_TMO], 1u); break; } } } } while (0)

struct XcdBarrier {
    unsigned* bar; unsigned x;
    volatile LAS unsigned* st;
};

__device__ __forceinline__ XcdBarrier xcd_barrier_post(unsigned* bar, volatile LAS unsigned* st) {
    XcdBarrier b; b.bar = bar; b.x = xb_xcc_id(); b.st = st;
    if (opq_tid() == 0) (void)xb_add(&bar[XB_XCNT(b.x)], 1u);
    return b;
}
__device__ __forceinline__ void xcd_barrier_complete(unsigned* bar, unsigned x, unsigned& nloc, unsigned& nx) {
    const unsigned G = gridDim.x * gridDim.y * gridDim.z;
    unsigned sum, cnt, mine, sp = 0u;
    for (;;) {
        sum = 0u; cnt = 0u; mine = 0u;
#pragma unroll
        for (unsigned j = 0; j < 16; ++j) { const unsigned c = xb_ld(&bar[XB_XCNT(j)]); sum += c; cnt += (c > 0u) ? 1u : 0u; mine = (j == x) ? c : mine; }
        if (sum == G) break;
        __builtin_amdgcn_s_sleep(1);
        if ((++sp & 255u) == 0u) { if (xb_ld(&bar[XB_TMO])) break; if (sp > XB_SPIN_CAP) { atomicAdd(&bar[XB_TMO], 1u); break; } }
    }
    nloc = mine > 0u ? mine : 1u; nx = cnt > 0u ? cnt : 1u;
}

__device__ __forceinline__ void xcd_barrier(const XcdBarrier& b) {
    asm volatile("s_waitcnt vmcnt(0)" ::: "memory");
    __syncthreads();
    if (opq_tid() == 0) {
        GAS unsigned* barg = (GAS unsigned*)b.bar; unsigned bxx = b.x; asm volatile("" : "+s"(barg), "+s"(bxx)); unsigned* bar = (unsigned*)barg;
        __builtin_amdgcn_s_waitcnt(0);
        unsigned nloc = b.st[0], nx = b.st[1];
        if (nloc == 0u) { xcd_barrier_complete(bar, bxx, nloc, nx); b.st[0] = nloc; b.st[1] = nx; }
        const unsigned old = xb_add(&bar[XB_XSUB(bxx)], 1u);
        const unsigned gen = old / nloc;
        if (old + 1u == (gen + 1u) * nloc) {
            __builtin_amdgcn_fence(__ATOMIC_RELEASE, "agent");
            asm volatile("s_waitcnt vmcnt(0)" ::: "memory");
            const unsigned og = xb_add(&bar[XB_TOP], 1u);
            const unsigned tg = og / nx;
            if (og + 1u == (tg + 1u) * nx) xb_add(&bar[XB_TOPGEN], 1u);
            else XB_SPIN(xb_ld(&bar[XB_TOPGEN]) == tg, bar);
            __builtin_amdgcn_fence(__ATOMIC_ACQUIRE, "agent");
            xb_add(&bar[XB_XGEN(bxx)], 1u);
            asm volatile("s_waitcnt vmcnt(0)" ::: "memory");
        } else {
            XB_SPIN(xb_ld(&bar[XB_XGEN(bxx)]) == gen, bar);
            __builtin_amdgcn_fence(__ATOMIC_ACQUIRE, "agent");
            asm volatile("s_waitcnt vmcnt(0)" ::: "memory");
        }
    }
    __syncthreads();
}
namespace cg = cooperative_groups;
constexpr int NWAVES = 8, NTHREADS = 512;
constexpr int R = 16640, NCTX = 256, SEQ = 16384, DM = 1024, INC = 6144, NL = 2, NEXP = 16384, SPAN = 65;
constexpr float ALPHA = 1.41421356237f, LN_EPS = 1e-6f, RMS_EPS = 1e-6f, LOG2E = 1.4426950408889634f;
constexpr float QSCALE = 0.125f * 1.4426950408889634f;
constexpr int C_QA = 0, C_KA = 512, C_VA = 640, C_QC = 768, C_KC = 1280, C_VC = 1408, C_XB = 1536, C_GB = 2048, C_GC = 2560, C_GL = 3072;
enum { I_X = 0, I_C, I_CTX, I_CCTX, I_WMOD, I_BMOD, I_WIN, I_QN, I_KN, I_CONVW, I_SINK, I_WBR, I_WOUT, I_LN1G, I_LN1B, I_WPQ, I_SK, I_UT, I_VT, I_LN2G, I_LN2B, N_IN };
constexpr size_t MiB = 1u << 20;
constexpr size_t WS_CTL = 0, CTL_ZERO_BYTES = 1 * MiB;
constexpr size_t WS_MODP = 1 * MiB;
constexpr size_t WS_MODV = WS_MODP + 1536 * 1024;
constexpr size_t WS_ROPE = WS_MODV + 128 * 1024;
constexpr size_t WS_WSM = 3 * MiB, WSM_L = 22 * MiB;
constexpr size_t OW_IN = 0, OW_BR = 12 * MiB, OW_OUT = 15 * MiB, OW_PQ = 17 * MiB, OW_SK = 21 * MiB;
constexpr size_t WS_U = WS_WSM + 2 * WSM_L, WS_V = WS_U + 32 * MiB;
constexpr size_t WS_X = WS_V + 32 * MiB;
constexpr size_t WS_G1 = WS_X + 65 * MiB;
constexpr size_t WS_YO = WS_G1, WS_PQ = WS_G1 + 65 * MiB, WS_IDX = WS_G1 + 130 * MiB, WS_WGT = WS_G1 + 139 * MiB;
constexpr size_t WS_HA = WS_G1 + 195 * MiB, WS_HB = WS_HA + 33 * MiB;
constexpr size_t WS_Y = WS_HB + 33 * MiB;
constexpr size_t WS_END = WS_Y + 49 * MiB;
static_assert(WS_END <= 512 * MiB, "d_ws map");
constexpr int CW_BAR = 4096;
constexpr int RING_BYTES = 131072, LDSCTL_OFF = RING_BYTES, MISC_OFF = LDSCTL_OFF + 320, LDS_BYTES = 147456;
typedef __bf16 bf16x2_t __attribute__((ext_vector_type(2)));
typedef unsigned u32x2 __attribute__((ext_vector_type(2)));

struct Args { const float* in[N_IN]; float* out; unsigned char* ws; int ph_lo, ph_hi, coop, pad; };

__device__ __forceinline__ float wave_sum(float v) {
#pragma unroll
    for (int o = 1; o < 64; o <<= 1) v += __shfl_xor(v, o);
    return v;
}
__device__ __forceinline__ float bflo(unsigned w) { return __uint_as_float(w << 16); }
__device__ __forceinline__ float bfhi(unsigned w) { return __uint_as_float(w & 0xffff0000u); }
__device__ __forceinline__ float bf1(bf16 h) { return __uint_as_float((unsigned)h << 16); }
__device__ __forceinline__ float dot2bf(unsigned w, unsigned x, float acc) { return __builtin_amdgcn_fdot2_f32_bf16(__builtin_bit_cast(bf16x2_t, w), __builtin_bit_cast(bf16x2_t, x), acc, false); }
__device__ __forceinline__ float silu_f(float x) { return x / (1.0f + __expf(-x)); }
__device__ __forceinline__ float gelu_f(float v) {
    const float av = fabsf(v), t = __builtin_amdgcn_rcpf(av * 0.2316418882f + 1.0f);
    float q = t * 0.5307027145f + (-0.7265760135f); q = q * t + 0.7107068705f; q = q * t + (-0.142248368f); q = q * t + 0.127414796f; q = q * t;
    const float e = __builtin_amdgcn_exp2f((v * v) * (-0.72134752044f));
    const float m = v * (q * e);
    return v < 0.f ? m : v - m;
}
__device__ __forceinline__ float vmaxf(float a, float b) { float r; asm("v_max_f32_e32 %0, %1, %2" : "=v"(r) : "v"(a), "v"(b)); return r; }
__device__ __forceinline__ float vminf(float a, float b) { float r; asm("v_min_f32_e32 %0, %1, %2" : "=v"(r) : "v"(a), "v"(b)); return r; }

typedef const __attribute__((address_space(4))) unsigned long long* kargp_t;
__device__ __forceinline__ const float* ain(int k) { kargp_t p = (kargp_t)__builtin_amdgcn_kernarg_segment_ptr(); return (const float*)(const GAS float*)(*(volatile kargp_t)(p + k)); }
__device__ __forceinline__ float* aout() { kargp_t p = (kargp_t)__builtin_amdgcn_kernarg_segment_ptr(); return (float*)(GAS float*)(*(volatile kargp_t)(p + N_IN)); }
struct Frame {
    LAS unsigned char* lds; unsigned char* lds_g;
    int tid, lane, wave, G, bx, vcu, gw, NGW;
    const float* in[N_IN]; float* out; unsigned char* ws;
};
__device__ __forceinline__ void p0_transpose_item(const float* W, int K, int N, bf16* WT, LAS float* scr, int item, int lane) {
    const int nblk = N / 32, kb = item / nblk, nb = item % nblk, k0 = 64 * kb, n0 = 32 * nb;
#pragma unroll 8
    for (int i = 0; i < 32; ++i) { const int kk = 2 * i + (lane >> 5); scr[kk * 33 + (lane & 31)] = W[(size_t)(k0 + kk) * N + n0 + (lane & 31)]; }
    LDS_WAIT(); asm volatile("" ::: "memory");
    const int c = lane & 7;
#pragma unroll
    for (int j = 0; j < 4; ++j) { const int n = (lane >> 3) + 8 * j; const LAS float* s = scr + (8 * c) * 33 + n;
        v4u o; o.x = pk2(s[0 * 33], s[1 * 33]); o.y = pk2(s[2 * 33], s[3 * 33]); o.z = pk2(s[4 * 33], s[5 * 33]); o.w = pk2(s[6 * 33], s[7 * 33]);
        *(GAS v4u*)(WT + (size_t)(n0 + n) * K + k0 + 8 * c) = o; }
    LDS_WAIT(); asm volatile("" ::: "memory");
}
__device__ __forceinline__ void conv_item(const float* src, bf16* dst, size_t item, int lane) {
    const float* s = src + item * 2048; bf16* d = dst + item * 2048;
    f32x4 a[4][2];
#pragma unroll
    for (int j = 0; j < 4; ++j) { a[j][0] = *(const GAS f32x4*)(s + j * 512 + lane * 8); a[j][1] = *(const GAS f32x4*)(s + j * 512 + lane * 8 + 4); }
#pragma unroll
    for (int j = 0; j < 4; ++j) { v4u o; o.x = pk2(a[j][0].x, a[j][0].y); o.y = pk2(a[j][0].z, a[j][0].w); o.z = pk2(a[j][1].x, a[j][1].y); o.w = pk2(a[j][1].z, a[j][1].w);
        *(GAS v4u*)(d + j * 512 + lane * 8) = o; }
}
__device__ __forceinline__ void convert_uv(const Frame& F, const Args& A, int l) {
    const float* us = ain(I_UT) + (size_t)l * NEXP * DM; const float* vs = ain(I_VT) + (size_t)l * NEXP * DM;
    bf16* ud = (bf16*)(F.ws + WS_U); bf16* vd = (bf16*)(F.ws + WS_V);
    for (int it = F.gw; it < 16384; it += F.NGW) { if (it < 8192) conv_item(us, ud, it, F.lane); else conv_item(vs, vd, it - 8192, F.lane); }
}
__device__ __forceinline__ void sincos_d(double a, float& s, float& c) {
    const double n = __builtin_rint(a * 0.63661977236758134308); const double r = a - n * 1.57079632679489661923; const double r2 = r * r;
    double sp = -2.50521083854417187751e-08; sp = sp * r2 + 2.75573192239858906526e-06; sp = sp * r2 - 1.98412698412698412698e-04; sp = sp * r2 + 8.33333333333333333333e-03; sp = sp * r2 - 1.66666666666666666667e-01; sp = sp * r2 * r + r;
    double cp = 2.08767569878680989792e-09; cp = cp * r2 - 2.75573192239858906526e-07; cp = cp * r2 + 2.48015873015873015873e-05; cp = cp * r2 - 1.38888888888888888889e-03; cp = cp * r2 + 4.16666666666666666667e-02; cp = cp * r2 - 0.5; cp = cp * r2 + 1.0;
    const int q = ((int)n) & 3;
    const double ss = (q == 0) ? sp : (q == 1) ? cp : (q == 2) ? -sp : -cp;
    const double cc = (q == 0) ? cp : (q == 1) ? -sp : (q == 2) ? -cp : sp;
    s = (float)ss; c = (float)cc;
}
__device__ __forceinline__ void p0_prologue(const Frame& F, const Args& A) {
    LAS float* scr = (LAS float*)(F.lds + F.wave * 16384);
    constexpr int I_MOD = 768, I_T = 5376, I_SKN = 128, I_RP = 64;
    constexpr int NIT = I_MOD + 2 * I_T + 2 * I_SKN + I_RP;
    for (int it = F.gw; it < NIT; it += F.NGW) {
        int r = it;
        if (r < I_MOD) {
            const int l = r / 384, jb = (r % 384) / 16, ks = r % 16;
            const float* W = ain(I_WMOD) + (size_t)l * DM * INC + (size_t)(ks * 64) * INC + jb * 256 + F.lane * 4;
            const float* cv = ain(I_C) + ks * 64; const float* xv = ain(I_CCTX) + ks * 64;
            f32x4 ac = {0.f, 0.f, 0.f, 0.f}, ax = {0.f, 0.f, 0.f, 0.f};
#pragma unroll 8
            for (int kk = 0; kk < 64; ++kk) { const f32x4 w = *(const GAS f32x4*)(W + (size_t)kk * INC); const float sc = silu_f(cv[kk]), sx = silu_f(xv[kk]); ac += w * sc; ax += w * sx; }
            float* P = (float*)(F.ws + WS_MODP) + ((size_t)(l * 16 + ks) * 2) * INC + jb * 256 + F.lane * 4;
            *(GAS f32x4*)P = ac; *(GAS f32x4*)(P + INC) = ax;
            continue; }
        r -= I_MOD;
        if (r < 2 * I_T) {
            const int l = r / I_T; int q = r % I_T; bf16* wsm = (bf16*)(F.ws + WS_WSM + (size_t)l * WSM_L);
            if (q < 3072) { p0_transpose_item(ain(I_WIN) + (size_t)l * DM * INC, DM, INC, (bf16*)((unsigned char*)wsm + OW_IN), scr, q, F.lane); continue; } q -= 3072;
            if (q < 768) { const int b = q / 256; p0_transpose_item(ain(I_WBR) + ((size_t)l * 3 + b) * 512 * DM, 512, DM, (bf16*)((unsigned char*)wsm + OW_BR) + (size_t)b * DM * 512, scr, q % 256, F.lane); continue; } q -= 768;
            if (q < 512) { p0_transpose_item(ain(I_WOUT) + (size_t)l * DM * DM, DM, DM, (bf16*)((unsigned char*)wsm + OW_OUT), scr, q, F.lane); continue; } q -= 512;
            p0_transpose_item(ain(I_WPQ) + (size_t)l * DM * 2048, DM, 2048, (bf16*)((unsigned char*)wsm + OW_PQ), scr, q, F.lane); continue; }
        r -= 2 * I_T;
        if (r < 2 * I_SKN) { const int l = r / I_SKN; conv_item(ain(I_SK) + (size_t)l * 262144, (bf16*)(F.ws + WS_WSM + (size_t)l * WSM_L + OW_SK), r % I_SKN, F.lane); continue; }
        r -= 2 * I_SKN;
        {
            const int e = r * 64 + F.lane, pos = e >> 4, i = e & 15;
            const float invf = __builtin_amdgcn_exp2f(-(float)i * (13.287712379549449f / 16.0f));
            const float ang = (float)pos * invf; float s, c; sincos_d((double)ang, s, c);
            float* T = (float*)(F.ws + WS_ROPE) + 2 * e; T[0] = c; T[1] = s; }
    }
    convert_uv(F, A, 0);
}
__device__ __forceinline__ void p1_mod_h0(const Frame& F, const Args& A, bf16* H) {
    LAS float* ml = (LAS float*)F.lds;
    const float* MP = (const float*)(F.ws + WS_MODP);
    for (int o = F.tid; o < 4096; o += NTHREADS) { const int v = o >> 11, j = o & 2047; float s = ain(I_BMOD)[j];
#pragma unroll
        for (int ks = 0; ks < 16; ++ks) s += MP[((size_t)ks * 2 + v) * INC + j];
        ml[o] = s; }
    for (int o = F.bx * NTHREADS + F.tid; o < NL * 2 * INC; o += F.G * NTHREADS) { const int l = o / (2 * INC), v = (o / INC) & 1, j = o % INC; float s = ain(I_BMOD)[l * INC + j];
#pragma unroll
        for (int ks = 0; ks < 16; ++ks) s += MP[((size_t)(l * 16 + ks) * 2 + v) * INC + j];
        ((float*)(F.ws + WS_MODV))[o] = s; }
    __syncthreads();
    for (int r = F.gw; r < R; r += F.NGW) {
        const int v = r < NCTX ? 1 : 0; const float* src = r < NCTX ? ain(I_CTX) + (size_t)r * DM : ain(I_X) + (size_t)(r - NCTX) * DM;
#pragma unroll
        for (int j = 0; j < 4; ++j) { const int c = 4 * F.lane + 256 * j; const f32x4 x = *(const GAS f32x4*)(src + c);
            const f32x4 sh = *(const LAS f32x4*)(ml + v * 2048 + c), sc = *(const LAS f32x4*)(ml + v * 2048 + 1024 + c);
            const f32x4 h = x * (sc + 1.0f) + sh; u32x2 w; w.x = pk2(h.x, h.y); w.y = pk2(h.z, h.w); *(GAS u32x2*)(H + (size_t)r * DM + c) = w; }
    }
}
__device__ __forceinline__ void post1_phase(const Frame& F, const Args& A, int l) {
    bf16* G1 = (bf16*)(F.ws + WS_G1); bf16* Y1 = (bf16*)(F.ws + WS_Y) + (size_t)R * 512;
    const float* rope = (const float*)(F.ws + WS_ROPE);
    const float* qn = ain(I_QN) + l * 64; const float* kn = ain(I_KN) + l * 64; const float* cw = ain(I_CONVW) + l * 3 * 512;
    const int g = F.lane >> 4, i = F.lane & 15;
    for (int r = F.gw; r < R; r += F.NGW) {
        bf16* row = G1 + (size_t)r * INC;
        float cr = 1.f, sr = 0.f, cc = 1.f, sc = 0.f;
        if (r >= NCTX) { const int t = r - NCTX, pr = t >> 6, pc = t & 63; cr = rope[(pr * 16 + i) * 2]; sr = rope[(pr * 16 + i) * 2 + 1]; cc = rope[(pc * 16 + i) * 2]; sc = rope[(pc * 16 + i) * 2 + 1]; }
#pragma unroll
        for (int it = 0; it < 5; ++it) {
            const int hh = it * 4 + g;
            const int base = hh < 8 ? C_QA + 64 * hh : hh < 10 ? C_KA + 64 * (hh - 8) : hh < 18 ? C_QC + 64 * (hh - 10) : C_KC + 64 * (hh - 18);
            float e0 = bf1(row[base + i]), e1 = bf1(row[base + 16 + i]), e2 = bf1(row[base + 32 + i]), e3 = bf1(row[base + 48 + i]);
            if (it < 3) {
                float ss = e0 * e0 + e1 * e1 + e2 * e2 + e3 * e3;
                ss += __shfl_xor(ss, 1); ss += __shfl_xor(ss, 2); ss += __shfl_xor(ss, 4); ss += __shfl_xor(ss, 8);
                if (hh < 10) { const float rs = __builtin_amdgcn_rsqf(ss * (1.0f / 64.0f) + RMS_EPS); const float* gn = hh < 8 ? qn : kn;
                    e0 *= rs * gn[i]; e1 *= rs * gn[16 + i]; e2 *= rs * gn[32 + i]; e3 *= rs * gn[48 + i]; }
            }
            float o0 = e0 * cr - e1 * sr, o1 = e1 * cr + e0 * sr, o2 = e2 * cc - e3 * sc, o3 = e3 * cc + e2 * sc;
            if (hh < 8 || (hh >= 10 && hh < 18)) { o0 *= QSCALE; o1 *= QSCALE; o2 *= QSCALE; o3 *= QSCALE; }
            row[base + i] = (bf16)f2bf(o0); row[base + 16 + i] = (bf16)f2bf(o1); row[base + 32 + i] = (bf16)f2bf(o2); row[base + 48 + i] = (bf16)f2bf(o3);
        }
        const int lo = r < NCTX ? 0 : NCTX, hi = r < NCTX ? NCTX - 1 : R - 1, ch = 8 * F.lane;
        float acc[8];
#pragma unroll
        for (int k = 0; k < 8; ++k) acc[k] = 0.f;
#pragma unroll
        for (int d = 0; d < 3; ++d) { const int rr = r - 1 + d;
            if (rr >= lo && rr <= hi) { const bf16* nr = G1 + (size_t)rr * INC;
                const v4u xb = *(const GAS v4u*)(nr + C_XB + ch), gc = *(const GAS v4u*)(nr + C_GC + ch);
                const f32x4 w0 = *(const GAS f32x4*)(cw + d * 512 + ch), w1 = *(const GAS f32x4*)(cw + d * 512 + ch + 4);
                acc[0] += w0.x * bflo(xb.x) * bflo(gc.x); acc[1] += w0.y * bfhi(xb.x) * bfhi(gc.x); acc[2] += w0.z * bflo(xb.y) * bflo(gc.y); acc[3] += w0.w * bfhi(xb.y) * bfhi(gc.y);
                acc[4] += w1.x * bflo(xb.z) * bflo(gc.z); acc[5] += w1.y * bfhi(xb.z) * bfhi(gc.z); acc[6] += w1.z * bflo(xb.w) * bflo(gc.w); acc[7] += w1.w * bfhi(xb.w) * bfhi(gc.w); } }
        const v4u gb = *(const GAS v4u*)(row + C_GB + ch);
        v4u o; o.x = pk2(acc[0] * bflo(gb.x), acc[1] * bfhi(gb.x)); o.y = pk2(acc[2] * bflo(gb.y), acc[3] * bfhi(gb.y)); o.z = pk2(acc[4] * bflo(gb.z), acc[5] * bfhi(gb.z)); o.w = pk2(acc[6] * bflo(gb.w), acc[7] * bfhi(gb.w));
        *(GAS v4u*)(Y1 + (size_t)r * 512 + ch) = o;
    }
}
__device__ __forceinline__ void ln1_phase(const Frame& F, const Args& A, int l, int row0, bf16* H2) {
    const float* YO = (const float*)(F.ws + WS_YO); float* X = (float*)(F.ws + WS_X); const float* MV = (const float*)(F.ws + WS_MODV) + (size_t)l * 2 * INC;
    const float* lg = ain(I_LN1G) + l * DM; const float* lb = ain(I_LN1B) + l * DM;
    for (int r = row0 + F.gw; r < R; r += F.NGW) {
        const float* mv = MV + (r < NCTX ? INC : 0);
        const float* xin = l == 0 ? (r < NCTX ? ain(I_CTX) + (size_t)r * DM : ain(I_X) + (size_t)(r - NCTX) * DM) : X + (size_t)r * DM;
        f32x4 v[4]; float s = 0.f;
#pragma unroll
        for (int j = 0; j < 4; ++j) { const int c = 4 * F.lane + 256 * j; const f32x4 x = *(const GAS f32x4*)(xin + c), y = *(const GAS f32x4*)(YO + (size_t)r * DM + c), g = *(const GAS f32x4*)(mv + 2048 + c);
            v[j] = x * ALPHA + g * y; s += (v[j].x + v[j].y) + (v[j].z + v[j].w); }
        const float mean = wave_sum(s) * (1.f / DM); float s2 = 0.f;
#pragma unroll
        for (int j = 0; j < 4; ++j) { v[j] = v[j] - mean; s2 += (v[j].x * v[j].x + v[j].y * v[j].y) + (v[j].z * v[j].z + v[j].w * v[j].w); }
        const float rstd = 1.f / sqrtf(wave_sum(s2) * (1.f / DM) + LN_EPS);
#pragma unroll
        for (int j = 0; j < 4; ++j) { const int c = 4 * F.lane + 256 * j; const f32x4 gg = *(const GAS f32x4*)(lg + c), bb = *(const GAS f32x4*)(lb + c);
            const f32x4 x1 = v[j] * rstd * gg + bb; *(GAS f32x4*)(X + (size_t)r * DM + c) = x1;
            const f32x4 sh = *(const GAS f32x4*)(mv + 3072 + c), sc = *(const GAS f32x4*)(mv + 4096 + c);
            const f32x4 h = x1 * (sc + 1.0f) + sh; u32x2 w; w.x = pk2(h.x, h.y); w.y = pk2(h.z, h.w); *(GAS u32x2*)(H2 + (size_t)r * DM + c) = w; }
    }
}
typedef float f32x16 __attribute__((ext_vector_type(16)));
__device__ __forceinline__ void ins16(float (&L)[16], float x) {
#pragma unroll
    for (int j = 0; j < 16; ++j) { const float h = vmaxf(L[j], x); x = vminf(L[j], x); L[j] = h; }
}
__device__ __forceinline__ void bitonic16_desc(float (&T)[16]) {
#pragma unroll
    for (int s = 8; s >= 1; s >>= 1)
#pragma unroll
        for (int i = 0; i < 16; ++i) if ((i & s) == 0) { const float h = vmaxf(T[i], T[i + s]), lo = vminf(T[i], T[i + s]); T[i] = h; T[i + s] = lo; }
}
__device__ __forceinline__ void subkey_top16(const bf16* qrow  , const bf16* keys  , int r32, int hi, float (&S)[16]) {
    bf16x8 qf[8];
#pragma unroll
    for (int ks = 0; ks < 8; ++ks) qf[ks] = *(const GAS bf16x8*)(qrow + ks * 16 + hi * 8);
    float L[16];
#pragma unroll
    for (int j = 0; j < 16; ++j) L[j] = -INFINITY;
#pragma unroll 1
    for (int nb = 0; nb < 4; ++nb) { f32x16 acc = f32x16{};
#pragma unroll
        for (int ks = 0; ks < 8; ++ks) { const bf16x8 kf = *(const GAS bf16x8*)(keys + (size_t)(nb * 32 + r32) * 128 + ks * 16 + hi * 8);
            acc = __builtin_amdgcn_mfma_f32_32x32x16_bf16(kf, qf[ks], acc, 0, 0, 0); }
#pragma unroll
        for (int rg = 0; rg < 16; ++rg) { const unsigned n = (unsigned)(nb * 32 + (rg & 3) + 8 * (rg >> 2) + 4 * hi);
            ins16(L, __uint_as_float((__float_as_uint(acc[rg]) & ~127u) | n)); } }
#pragma unroll
    for (int j = 0; j < 16; ++j) { const float other = __shfl_xor(L[15 - j], 32); S[j] = vmaxf(L[j], other); }
    bitonic16_desc(S);
}
__device__ __forceinline__ void scores_phase(const Frame& F, const Args& A, int l, int row0) {
    const bf16* PQ = (const bf16*)(F.ws + WS_PQ); const bf16* SK = (const bf16*)(F.ws + WS_WSM + (size_t)l * WSM_L + OW_SK);
    int* IDX = (int*)(F.ws + WS_IDX); float* WGT = (float*)(F.ws + WS_WGT);
    const int r32 = F.lane & 31, hi = F.lane >> 5;
    LAS unsigned* myl = (LAS unsigned*)(F.lds + F.wave * 2048 + F.lane * 32);
    const int nitems = ((R - row0) / 32) * 8;
    for (int it = F.gw; it < nitems; it += F.NGW) {
        const int h = it & 7, rb = row0 + (it >> 3) * 32, row = rb + r32;
        float S1[16], S2[16];
        subkey_top16(PQ + (size_t)row * 2048 + h * 256, SK + (size_t)(h * 2) * 16384, r32, hi, S1);
        subkey_top16(PQ + (size_t)row * 2048 + h * 256 + 128, SK + (size_t)(h * 2 + 1) * 16384, r32, hi, S2);
#pragma unroll
        for (int q = 0; q < 4; ++q) {
            myl[q] = (__float_as_uint(S1[4 * q]) & 127u) | ((__float_as_uint(S1[4 * q + 1]) & 127u) << 8) | ((__float_as_uint(S1[4 * q + 2]) & 127u) << 16) | ((__float_as_uint(S1[4 * q + 3]) & 127u) << 24);
            myl[4 + q] = (__float_as_uint(S2[4 * q]) & 127u) | ((__float_as_uint(S2[4 * q + 1]) & 127u) << 8) | ((__float_as_uint(S2[4 * q + 2]) & 127u) << 16) | ((__float_as_uint(S2[4 * q + 3]) & 127u) << 24); }
        float T[16];
#pragma unroll
        for (int j = 0; j < 16; ++j) T[j] = -INFINITY;
#pragma unroll
        for (int a = 0; a < 16; ++a)
#pragma unroll
            for (int b = 0; b < 16; ++b) if ((a + 1) * (b + 1) <= 16) ins16(T, __uint_as_float((__float_as_uint(S1[a] + S2[b]) & ~255u) | (unsigned)(a * 16 + b)));
        const float m = T[0]; float e[16], sum = 0.f;
#pragma unroll
        for (int j = 0; j < 16; ++j) { e[j] = __expf(T[j] - m); sum += e[j]; }
        const float inv = 1.0f / sum;
        LDS_WAIT();
        if (hi == 0) {
            const LAS unsigned char* lb = (const LAS unsigned char*)myl;
            int ex[16];
#pragma unroll
            for (int j = 0; j < 16; ++j) { const unsigned pid = __float_as_uint(T[j]) & 255u; ex[j] = (int)lb[pid >> 4] * 128 + (int)lb[16 + (pid & 15u)]; }
            int* ip = IDX + (size_t)row * 128 + h * 16; float* wp = WGT + (size_t)row * 128 + h * 16;
#pragma unroll
            for (int q = 0; q < 4; ++q) { *(GAS v4u*)(ip + 4 * q) = (v4u){(unsigned)ex[4 * q], (unsigned)ex[4 * q + 1], (unsigned)ex[4 * q + 2], (unsigned)ex[4 * q + 3]};
                *(GAS f32x4*)(wp + 4 * q) = (f32x4){e[4 * q] * inv, e[4 * q + 1] * inv, e[4 * q + 2] * inv, e[4 * q + 3] * inv}; }
        }
        LDS_WAIT();
    }
}
template <bool LAST> __device__ __forceinline__ void peer_phase(const Frame& F, const Args& A, int l, int row0, const bf16* H2, bf16* Hn) {
    const bf16* U = (const bf16*)(F.ws + WS_U); const bf16* V = (const bf16*)(F.ws + WS_V);
    const int* IDX = (const int*)(F.ws + WS_IDX); const float* WGT = (const float*)(F.ws + WS_WGT);
    float* X = (float*)(F.ws + WS_X); const float* MVl = (const float*)(F.ws + WS_MODV) + (size_t)l * 2 * INC; const float* MVn = (const float*)(F.ws + WS_MODV) + (size_t)(LAST ? l : l + 1) * 2 * INC;
    const float* lg = ain(I_LN2G) + l * DM; const float* lb = ain(I_LN2B) + l * DM;
    const int lane = F.lane, c0 = 8 * lane, c1 = 512 + 8 * lane;
    LAS int* idxL = (LAS int*)(F.lds + F.wave * 2048); LAS float* wL = (LAS float*)(F.lds + F.wave * 2048 + 512); LAS float* aL = (LAS float*)(F.lds + F.wave * 2048 + 1024);
    const int jx = (lane >> 3) & 7;
    for (int r = row0 + F.gw; r < R; r += F.NGW) {
        idxL[lane] = IDX[(size_t)r * 128 + lane]; idxL[64 + lane] = IDX[(size_t)r * 128 + 64 + lane];
        wL[lane] = WGT[(size_t)r * 128 + lane]; wL[64 + lane] = WGT[(size_t)r * 128 + 64 + lane];
        const v4u h0 = *(const GAS v4u*)(H2 + (size_t)r * DM + c0), h1 = *(const GAS v4u*)(H2 + (size_t)r * DM + c1);
#pragma unroll 2
        for (int c = 0; c < 16; ++c) {
            float p[8];
#pragma unroll
            for (int e = 0; e < 8; ++e) { const int ei = idxL[c * 8 + e]; const bf16* ur = U + (size_t)ei * DM;
                const v4u u0 = *(const GAS v4u*)(ur + c0), u1 = *(const GAS v4u*)(ur + c1);
                float a0 = dot2bf(u0.x, h0.x, 0.f), a1 = dot2bf(u0.y, h0.y, 0.f); a0 = dot2bf(u0.z, h0.z, a0); a1 = dot2bf(u0.w, h0.w, a1);
                a0 = dot2bf(u1.x, h1.x, a0); a1 = dot2bf(u1.y, h1.y, a1); a0 = dot2bf(u1.z, h1.z, a0); a1 = dot2bf(u1.w, h1.w, a1); p[e] = a0 + a1; }
            { const bool up = (lane & 32) != 0;
#pragma unroll
              for (int i = 0; i < 4; ++i) { const float a = p[i], b = p[i + 4]; p[i] = (up ? b : a) + __shfl_xor(up ? a : b, 32); } }
            { const bool up = (lane & 16) != 0;
#pragma unroll
              for (int i = 0; i < 2; ++i) { const float a = p[i], b = p[i + 2]; p[i] = (up ? b : a) + __shfl_xor(up ? a : b, 16); } }
            { const bool up = (lane & 8) != 0; const float a = p[0], b = p[1]; p[0] = (up ? b : a) + __shfl_xor(up ? a : b, 8); }
            float t = p[0]; t += __shfl_xor(t, 4); t += __shfl_xor(t, 2); t += __shfl_xor(t, 1);
            const float av = gelu_f(t) * wL[c * 8 + jx];
            if ((lane & 7) == 0) aL[c * 8 + jx] = av;
        }
        float f[16];
#pragma unroll
        for (int k = 0; k < 16; ++k) f[k] = 0.f;
#pragma unroll 2
        for (int c = 0; c < 16; ++c) {
#pragma unroll
            for (int e = 0; e < 8; ++e) { const int ei = idxL[c * 8 + e]; const float ae = aL[c * 8 + e]; const bf16* vr = V + (size_t)ei * DM;
                const v4u v0 = *(const GAS v4u*)(vr + c0), v1 = *(const GAS v4u*)(vr + c1);
                f[0] += ae * bflo(v0.x); f[1] += ae * bfhi(v0.x); f[2] += ae * bflo(v0.y); f[3] += ae * bfhi(v0.y); f[4] += ae * bflo(v0.z); f[5] += ae * bfhi(v0.z); f[6] += ae * bflo(v0.w); f[7] += ae * bfhi(v0.w);
                f[8] += ae * bflo(v1.x); f[9] += ae * bfhi(v1.x); f[10] += ae * bflo(v1.y); f[11] += ae * bfhi(v1.y); f[12] += ae * bflo(v1.z); f[13] += ae * bfhi(v1.z); f[14] += ae * bflo(v1.w); f[15] += ae * bfhi(v1.w); }
        }
        const float* mv = MVl + (r < NCTX ? INC : 0);
        float v[16]; float s = 0.f;
#pragma unroll
        for (int hseg = 0; hseg < 2; ++hseg)
#pragma unroll
            for (int q = 0; q < 2; ++q) { const int c = (hseg ? c1 : c0) + 4 * q; const f32x4 x = *(const GAS f32x4*)(X + (size_t)r * DM + c), g2 = *(const GAS f32x4*)(mv + 5120 + c);
#pragma unroll
                for (int k = 0; k < 4; ++k) { const float t = x[k] * ALPHA + g2[k] * f[hseg * 8 + q * 4 + k]; v[hseg * 8 + q * 4 + k] = t; s += t; } }
        const float mean = wave_sum(s) * (1.f / DM); float s2 = 0.f;
#pragma unroll
        for (int k = 0; k < 16; ++k) { v[k] -= mean; s2 += v[k] * v[k]; }
        const float rstd = 1.f / sqrtf(wave_sum(s2) * (1.f / DM) + LN_EPS);
        const float* mn = MVn + (r < NCTX ? INC : 0);
#pragma unroll
        for (int hseg = 0; hseg < 2; ++hseg)
#pragma unroll
            for (int q = 0; q < 2; ++q) { const int c = (hseg ? c1 : c0) + 4 * q; const f32x4 gg = *(const GAS f32x4*)(lg + c), bb = *(const GAS f32x4*)(lb + c);
                f32x4 x2;
#pragma unroll
                for (int k = 0; k < 4; ++k) x2[k] = v[hseg * 8 + q * 4 + k] * rstd * gg[k] + bb[k];
                if (LAST) { *(GAS f32x4*)(aout() + (size_t)(r - NCTX) * DM + c) = x2; }
                else { *(GAS f32x4*)(X + (size_t)r * DM + c) = x2;
                    const f32x4 sh = *(const GAS f32x4*)(mn + c), sc = *(const GAS f32x4*)(mn + 1024 + c); const f32x4 hh = x2 * (sc + 1.0f) + sh;
                    u32x2 w; w.x = pk2(hh.x, hh.y); w.y = pk2(hh.z, hh.w); *(GAS u32x2*)(Hn + (size_t)r * DM + c) = w; } }
    }
}
__device__ __forceinline__ void attn_phase(const Frame& F, const Args& A, int l) {
    using attn_body::AttnJob; typedef attn_body::bf16 abf;
    abf* G1 = (abf*)(F.ws + WS_G1); abf* Y0 = (abf*)(F.ws + WS_Y); abf* Y2 = Y0 + (size_t)2 * R * 512;
    char* shm = (char*)F.lds_g;
    const float* sink = ain(I_SINK) + l * 8;
#define OPAQUE_S(x) asm volatile("" : "+s"(x))
#pragma unroll 1
    for (int i = 0; i < 2; ++i) {
        int vc = F.vcu; OPAQUE_S(vc);
        const int u = 2 * vc + i, kvh = u >> 8, hq = kvh * 4 + ((u >> 6) & 3), qb = u & 63; const size_t row = NCTX + 256 * qb;
        AttnJob J; J.Q = G1 + row * INC + C_QA + hq * 64; J.K = G1 + C_KA + kvh * 64; J.V = G1 + C_VA + kvh * 64; J.O = Y0 + row * 512 + hq * 64;
        J.qp = INC; J.kp = INC; J.op = 512; J.nt = R / 64; J.nt0 = R / 64; J.row1 = 0; J.qpos0 = 0; J.kpos1 = 0; J.sink2 = -INFINITY;
        attn_body::attn_unit<8, 0>(J, shm);
    }
#ifndef AT_ONLYA
#pragma unroll 1
    for (int i = 0; i < 2; ++i) {
        int vc = F.vcu; OPAQUE_S(vc);
        const int u = 2 * vc + i, kvh = u >> 8, hq = kvh * 4 + ((u >> 6) & 3), qb = u & 63; const size_t row = NCTX + 256 * qb;
        const int q0 = 256 * qb, lo = q0 - 128 < 0 ? 0 : q0 - 128, hi = q0 + 384 > SEQ ? SEQ : q0 + 384;
        AttnJob J; J.Q = G1 + row * INC + C_QC + hq * 64; J.K = G1 + C_KC + kvh * 64; J.V = G1 + C_VC + kvh * 64; J.O = Y2 + row * 512 + hq * 64;
        J.qp = INC; J.kp = INC; J.op = 512; J.nt0 = NCTX / 64; J.nt = NCTX / 64 + (hi - lo) / 64; J.row1 = NCTX + lo; J.qpos0 = q0; J.kpos1 = lo; J.sink2 = sink[hq] * LOG2E;
        attn_body::attn_unit<8, 1>(J, shm);
    }
    int vx = F.vcu; OPAQUE_S(vx);
    if (l == 0 && vx < 16) {
        const int hq = vx & 7, kvh = hq >> 2; const bool isc = vx >= 8;
        AttnJob J; J.Q = G1 + (isc ? C_QC : C_QA) + hq * 64; J.K = G1 + (isc ? C_KC : C_KA) + kvh * 64; J.V = G1 + (isc ? C_VC : C_VA) + kvh * 64; J.O = (isc ? Y2 : Y0) + hq * 64;
        J.qp = INC; J.kp = INC; J.op = 512; J.nt = NCTX / 64; J.nt0 = NCTX / 64; J.row1 = 0; J.qpos0 = 0; J.kpos1 = 0; J.sink2 = isc ? sink[hq] * LOG2E : -INFINITY;
        attn_body::attn_unit<8, 0>(J, shm);
    }
#endif
}
constexpr int N_PHASES = 2 + 9 * NL;
__global__ void __launch_bounds__(NTHREADS, 2) mk_fwd(Args A) {
    extern __shared__ __attribute__((aligned(16))) unsigned char lds[];
    Frame F0;
    F0.lds = (LAS unsigned char*)lds; F0.lds_g = lds;
    F0.tid = threadIdx.x; F0.lane = F0.tid & 63; F0.wave = __builtin_amdgcn_readfirstlane(F0.tid >> 6);
    F0.G = gridDim.x; F0.bx = blockIdx.x; F0.vcu = (F0.G % 8 == 0) ? (F0.bx % 8) * (F0.G / 8) + F0.bx / 8 : F0.bx;
    F0.gw = F0.bx * NWAVES + F0.wave; F0.NGW = F0.G * NWAVES; F0.ws = A.ws;
    volatile LAS unsigned* MISC = (volatile LAS unsigned*)(F0.lds + MISC_OFF);
    for (int u = F0.tid; u < (LDS_BYTES - LDSCTL_OFF) / 4; u += NTHREADS) ((LAS unsigned*)(F0.lds + LDSCTL_OFF))[u] = 0u;
    __syncthreads();
    const int lo = A.ph_lo, hi = A.ph_hi;
    XcdBarrier bar; bar.bar = (unsigned*)(A.ws + WS_CTL) + CW_BAR; bar.x = 0; bar.st = nullptr;
    if (hi - lo > 1) bar = xcd_barrier_post((unsigned*)(A.ws + WS_CTL) + CW_BAR, MISC + 8);
#ifndef MK_ONLY
#define MK_ONLY -1
#endif
#ifndef MK_MASK
#define MK_MASK 0x7ff
#endif
#define ON(k) ((MK_ONLY < 0 || MK_ONLY == (k)) && ((MK_MASK >> (k)) & 1))
#pragma unroll 1
    for (int ph = lo; ph < hi; ++ph) {
        const int l = ph < 2 ? 0 : (ph - 2) / 9, kind = ph < 2 ? ph : 2 + (ph - 2) % 9;
        Frame F = F0;
        asm volatile("" : "+v"(F.tid), "+v"(F.lane)); asm volatile("" : "+s"(F.wave), "+s"(F.bx), "+s"(F.vcu), "+s"(F.gw));
        { GAS unsigned char* wsg = (GAS unsigned char*)F0.ws; asm volatile("" : "+s"(wsg)); F.ws = (unsigned char*)wsg; }
        bf16* HA = (bf16*)(F.ws + WS_HA); bf16* HB = (bf16*)(F.ws + WS_HB);
        bf16* Hin = (l & 1) ? HB : HA; bf16* Hmg = (l & 1) ? HA : HB;
        const int row0 = (l == NL - 1) ? NCTX : 0;
        const int Mr = R - row0, NPr = Mr / 256;
        unsigned char* wsm = F.ws + WS_WSM + (size_t)l * WSM_L;
        switch (kind) {
        case 0: if (ON(0)) { p0_prologue(F, A); } break;
        case 1: if (ON(1)) { p1_mod_h0(F, A, HA); } break;
        case 2: if (ON(2)) {
            pg8::Gemm g{(const pg8::bf16_t*)Hin, (const pg8::bf16_t*)(wsm + OW_IN), R, INC, DM}; pg8::StaticOrder S; S.init(R, INC, F.G, F.bx);
            pg8::EpiBf16<0> E{(pg8::bf16_t*)(F.ws + WS_G1), INC, nullptr, 0, 0, 1.f};
            pg8::gemm_phase<pg8::EpiBf16<0>, pg8::StaticOrder, true, true>(F.lds, g, S, E);
            if (l > 0) convert_uv(F, A, l);
        } break;
        case 3: if (ON(3)) { post1_phase(F, A, l); } break;
        case 4: if (ON(4)) { attn_phase(F, A, l); } break;
        case 5: if (ON(5)) {
            pg8::Gemm g{(const pg8::bf16_t*)(F.ws + WS_Y) + (size_t)row0 * 512, (const pg8::bf16_t*)(wsm + OW_BR), 3 * R, 3072, 512}; pg8::MergeOrder S; S.init(NPr, SPAN, F.G, F.bx);
            pg8::EpiMerge E{(pg8::bf16_t*)Hmg + (size_t)row0 * DM, (const pg8::bf16_t*)(F.ws + WS_G1) + (size_t)row0 * INC + C_GL, INC, SPAN};
            pg8::gemm_phase<pg8::EpiMerge, pg8::MergeOrder, true, true>(F.lds, g, S, E);
        } break;
        case 6: if (ON(6)) {
            pg8::Gemm g{(const pg8::bf16_t*)Hmg + (size_t)row0 * DM, (const pg8::bf16_t*)(wsm + OW_OUT), Mr, DM, DM}; pg8::StaticOrder S; S.init(Mr, DM, F.G, F.bx);
            pg8::EpiF32 E{(float*)(F.ws + WS_YO) + (size_t)row0 * DM, DM};
            pg8::gemm_phase<pg8::EpiF32, pg8::StaticOrder, true, true>(F.lds, g, S, E);
        } break;
        case 7: if (ON(7)) { ln1_phase(F, A, l, row0, Hin); } break;
        case 8: if (ON(8)) {
            pg8::Gemm g{(const pg8::bf16_t*)Hin + (size_t)row0 * DM, (const pg8::bf16_t*)(wsm + OW_PQ), Mr, 2048, DM}; pg8::StaticOrder S; S.init(Mr, 2048, F.G, F.bx);
            pg8::EpiBf16<0> E{(pg8::bf16_t*)(F.ws + WS_PQ) + (size_t)row0 * 2048, 2048, nullptr, 0, 0, 1.f};
            pg8::gemm_phase<pg8::EpiBf16<0>, pg8::StaticOrder, true, true>(F.lds, g, S, E);
        } break;
        case 9: if (ON(9)) { scores_phase(F, A, l, row0); } break;
        default: if (ON(10)) { if (l == NL - 1) peer_phase<true>(F, A, l, row0, Hin, Hmg); else peer_phase<false>(F, A, l, row0, Hin, Hmg); } break;
        }
        if (ph + 1 < hi) { if (A.coop && ph == lo) { cg::this_grid().sync(); } else { xcd_barrier(bar); } }
    }
#undef ON
}
#ifndef MK_MULTI
#define MK_MULTI 0
#endif
extern "C" void kernel_launch(void* const* d_in, const int* in_sizes, int n_in, void* d_out, int out_size, void* d_ws, size_t ws_size, hipStream_t stream) {
    static int grid = 0;
    if (grid == 0) {
        if (n_in != N_IN || out_size != SEQ * DM || ws_size < WS_END) { fprintf(stderr, "kernel_launch: unexpected shapes (n_in %d, out %d, ws %zu)\n", n_in, out_size, ws_size); grid = -1; return; }
        int dev = 0, cus = 0, per_cu = 0;
        if (hipGetDevice(&dev) != hipSuccess || hipDeviceGetAttribute(&cus, hipDeviceAttributeMultiprocessorCount, dev) != hipSuccess) { grid = -1; return; }
        if (hipFuncSetAttribute((const void*)mk_fwd, hipFuncAttributeMaxDynamicSharedMemorySize, LDS_BYTES) != hipSuccess) { grid = -1; return; }
        if (hipOccupancyMaxActiveBlocksPerMultiprocessor(&per_cu, (const void*)mk_fwd, NTHREADS, LDS_BYTES) != hipSuccess || per_cu < 1) { fprintf(stderr, "kernel_launch: occupancy query says %d\n", per_cu); }
        (void)hipGetLastError();
        grid = cus;
    }
    if (grid < 0) return;
    (void)hipMemsetAsync((char*)d_ws + WS_CTL, 0, CTL_ZERO_BYTES, stream);
    Args a{};
    for (int i = 0; i < N_IN; ++i) a.in[i] = (const float*)d_in[i];
    a.out = (float*)d_out; a.ws = (unsigned char*)d_ws;
#if MK_MULTI
    for (int p = 0; p < N_PHASES; ++p) { a.ph_lo = p; a.ph_hi = p + 1; a.coop = 0; hipLaunchKernelGGL(mk_fwd, dim3(grid), dim3(NTHREADS), LDS_BYTES, stream, a); }
#else
    a.ph_lo = 0; a.ph_hi = N_PHASES; a.coop = 1;
    void* args[] = {&a};
    hipError_t e = hipLaunchCooperativeKernel((void*)mk_fwd, dim3(grid), dim3(NTHREADS), args, LDS_BYTES, stream);
    if (e != hipSuccess) fprintf(stderr, "kernel_launch: cooperative launch failed: %s (grid %d)\n", hipGetErrorString(e), grid);
#endif
}
```

```cpp
#include <hip/hip_runtime.h>
#include <hip/hip_bf16.h>
#include <hip/hip_cooperative_groups.h>
#include <cstdio>
#include <cstdint>
#include <cmath>
__device__ __forceinline__ int opq_tid() { int t = threadIdx.x; asm volatile("" : "+v"(t)); return t; }
namespace pg8 {
#define PG8_LAS __attribute__((address_space(3)))
typedef unsigned short bf16_t;
typedef short bf16x8 __attribute__((ext_vector_type(8)));
typedef float f32x4 __attribute__((ext_vector_type(4)));
typedef unsigned u32x4 __attribute__((ext_vector_type(4)));
constexpr int BM = 256, BK = 64, HALF = 128, HTB = HALF * BK * 2  , STAGE_BYTES = 8 * HTB, NXCD = 8, WGM = 8;

__host__ __device__ __forceinline__ int lds_byte(int r, int c) { const int st = (r >> 4) * 2 + (c >> 5), rr = r & 15, cc = c & 31, ob = rr * 64 + cc * 2; return st * 1024 + (ob ^ (((ob >> 9) & 1) << 5)); }
__host__ __device__ __forceinline__ void stage_rc(int b, int& R, int& C) { const int st = b / 1024, sb = b % 1024, swz = sb ^ (((sb >> 9) & 1) << 5); R = (st >> 1) * 16 + swz / 64; C = (st & 1) * 32 + (swz % 64) / 2; }
__host__ __device__ __forceinline__ int perm32(int rho) { const int n = rho >> 4, i = rho & 15; return 8 * (i >> 2) + 4 * n + (i & 3); }

struct Unit { int pm, pn; };
struct Gemm { const bf16_t* A; const bf16_t* Bt; int M, N, K; };

struct StaticOrder {
    int nM, nN, nwg, G, c;
    __host__ __device__ void init(int M, int N, int G_, int c_) { nM = M / BM; nN = N / BM; nwg = nM * nN; G = G_; c = c_; }
    __host__ __device__ bool next(int i, Unit& u) const {
        const long L = (long)i * G + c; if (L >= nwg) return false;
        int wgid = (int)L; { const int q = nwg / NXCD, r = nwg % NXCD, xcd = wgid % NXCD, off = wgid / NXCD; wgid = (xcd < r ? xcd * (q + 1) : r * (q + 1) + (xcd - r) * q) + off; }
        const int nig = WGM * nN, gid = wgid / nig, fm = gid * WGM, gsz = (nM - fm) < WGM ? (nM - fm) : WGM;
        u.pm = fm + ((wgid % nig) % gsz); u.pn = (wgid % nig) / gsz; return true;
    }
    __device__ __forceinline__ void a_ready(const Unit&) const {}
    __device__ __forceinline__ void done(const Unit&) const {}
};

__device__ __forceinline__ unsigned cvt_pk_bf16(float lo, float hi) { unsigned r; asm volatile("v_cvt_pk_bf16_f32 %0, %1, %2" : "=v"(r) : "v"(lo), "v"(hi)); return r; }
typedef float f32x2 __attribute__((ext_vector_type(2)));
__device__ __forceinline__ f32x2 gelu_pk(f32x2 v) {
    const f32x2 av = __builtin_elementwise_abs(v), d = av * 0.2316418882f + 1.0f;
    f32x2 t; t.x = __builtin_amdgcn_rcpf(d.x); t.y = __builtin_amdgcn_rcpf(d.y);
    f32x2 q = t * 0.5307027145f + (-0.7265760135f); q = q * t + 0.7107068705f; q = q * t + (-0.142248368f); q = q * t + 0.127414796f; q = q * t;
    const f32x2 s = (v * v) * (-0.72134752044f);
    f32x2 e; e.x = __builtin_amdgcn_exp2f(s.x); e.y = __builtin_amdgcn_exp2f(s.y);
    const f32x2 m = v * (q * e), r = v - m;
    f32x2 o; o.x = v.x < 0.f ? m.x : r.x; o.y = v.y < 0.f ? m.y : r.y; return o;
}

template <int ACT  > struct EpiBf16 {
    static constexpr bool PERM = true, AFTER_DRAIN = false; static_assert(ACT == 0 || ACT == 1, "EpiBf16: ACT is 0 (none) or 1 (gelu_pk)");
    bf16_t* O; int ldc; const float* bias; int split_cols; size_t split_stride; float scale0;
    __device__ __forceinline__ void operator()(const f32x4 (&acc)[2][2][4][2], const Unit& u, int wr, int wc, int fr, int fq) const {
        const int row0 = u.pm * BM + wr * 64 + fr; int colt = u.pn * BM; bf16_t* base = O;
        float sc = 1.f; if (split_cols) { const int t = colt / split_cols; base += (size_t)t * split_stride; colt -= t * split_cols; if (t == 0) sc = scale0; }
        const int col0 = colt + wc * 32 + 8 * fq, bcol0 = u.pn * BM + wc * 32 + 8 * fq;
        f32x4 bv[2][2];
#pragma unroll
        for (int bj = 0; bj < 2; ++bj)
#pragma unroll
            for (int n = 0; n < 2; ++n) bv[bj][n] = bias ? *(const f32x4*)(bias + bcol0 + bj * HALF + 4 * n) : (f32x4){0.f, 0.f, 0.f, 0.f};
#pragma unroll
        for (int ai = 0; ai < 2; ++ai)
#pragma unroll
            for (int m = 0; m < 4; ++m) { bf16_t* rowp = base + (size_t)(row0 + ai * HALF + m * 16) * ldc + col0;
#pragma unroll
                for (int bj = 0; bj < 2; ++bj) { f32x4 v0 = acc[ai][bj][m][0] + bv[bj][0], v1 = acc[ai][bj][m][1] + bv[bj][1];
                    if (ACT == 1) { f32x2 a = gelu_pk((f32x2){v0[0], v0[1]}), b = gelu_pk((f32x2){v0[2], v0[3]}), c = gelu_pk((f32x2){v1[0], v1[1]}), d = gelu_pk((f32x2){v1[2], v1[3]});
                        v0 = (f32x4){a.x, a.y, b.x, b.y}; v1 = (f32x4){c.x, c.y, d.x, d.y}; }
                    v0 = v0 * sc; v1 = v1 * sc; u32x4 w; w.x = cvt_pk_bf16(v0[0], v0[1]); w.y = cvt_pk_bf16(v0[2], v0[3]); w.z = cvt_pk_bf16(v1[0], v1[1]); w.w = cvt_pk_bf16(v1[2], v1[3]);
                    *(u32x4*)(rowp + bj * HALF) = w; } }
    }
};

struct PanelStats {
    unsigned* xbuf;
    unsigned* cnt;
    unsigned* tmo;
    int ntn; float eps;
    unsigned code;
    __device__ __forceinline__ bool run(const f32x4 (&v)[2][2][4][2], const Unit& u, int wr, int wc, int fr, int fq, PG8_LAS unsigned char* lds, int wid, int lane) const {
        typedef float f32x2v __attribute__((ext_vector_type(2)));
        PG8_LAS f32x2v* P = (PG8_LAS f32x2v*)lds;
        PG8_LAS f32x2v* S = (PG8_LAS f32x2v*)(lds + 8192);
        PG8_LAS unsigned* flag = (PG8_LAS unsigned*)(lds + 8192 + 2048);
#pragma unroll
        for (int ai = 0; ai < 2; ++ai)
#pragma unroll
            for (int m = 0; m < 4; ++m) {
                float s = 0.f;
#pragma unroll
                for (int bj = 0; bj < 2; ++bj)
#pragma unroll
                    for (int n = 0; n < 2; ++n) { const f32x4 x = v[ai][bj][m][n]; s += (x[0] + x[1]) + (x[2] + x[3]); }
                s += __shfl_xor(s, 16); s += __shfl_xor(s, 32);
                const float mw = s * (1.0f / 64.0f); float q = 0.f;
#pragma unroll
                for (int bj = 0; bj < 2; ++bj)
#pragma unroll
                    for (int n = 0; n < 2; ++n) { const f32x4 d = v[ai][bj][m][n] - mw; q += (d[0] * d[0] + d[1] * d[1]) + (d[2] * d[2] + d[3] * d[3]); }
                q += __shfl_xor(q, 16); q += __shfl_xor(q, 32);
                if (fq == 0) P[(ai * HALF + wr * 64 + m * 16 + fr) * 4 + wc] = (f32x2v){mw, q};
            }
        asm volatile("s_waitcnt lgkmcnt(0)" ::: "memory"); __builtin_amdgcn_s_barrier(); asm volatile("" ::: "memory");
#if defined(BROKEN_EXCHANGE_NO_WAIT)
#warning BROKEN CONTROL BUILD: the row-statistics exchange does not wait; results are wrong by design
        if (blockIdx.x >= 64) { const long long t0_ = clock64(); while (clock64() - t0_ < 60000) __builtin_amdgcn_s_sleep(8); }
#endif
        const int row = wid * 32 + (lane & 31);
        if (lane < 32) {
            const f32x2v a = P[row * 4 + 0], b = P[row * 4 + 1], c = P[row * 4 + 2], d = P[row * 4 + 3];
            const float mt = (a.x + b.x + c.x + d.x) * 0.25f;
            const float da = a.x - mt, db = b.x - mt, dc = c.x - mt, dd = d.x - mt;
            const float m2 = (a.y + b.y) + (c.y + d.y) + 64.0f * ((da * da + db * db) + (dc * dc + dd * dd));
            unsigned long long* slot = (unsigned long long*)xbuf + ((size_t)(u.pm * BM + row) * 4 + u.pn);
            __hip_atomic_store(slot, ((unsigned long long)__float_as_uint(m2) << 32) | __float_as_uint(mt), __ATOMIC_RELAXED, __HIP_MEMORY_SCOPE_AGENT);
        }
        asm volatile("s_waitcnt vmcnt(0)" ::: "memory");
        if (lane == 0) __hip_atomic_fetch_add(cnt + 64 * u.pm, 1u, __ATOMIC_RELAXED, __HIP_MEMORY_SCOPE_AGENT);
        if (wid == 0) {
            bool dead = false; const unsigned long long t0 = __builtin_amdgcn_s_memrealtime(); const unsigned want = 8u * (unsigned)ntn;
            for (;;) {
#if defined(BROKEN_EXCHANGE_NO_WAIT)
                break;
#endif
                if ((unsigned)__builtin_amdgcn_readfirstlane(__hip_atomic_load(cnt + 64 * u.pm, __ATOMIC_RELAXED, __HIP_MEMORY_SCOPE_AGENT)) >= want) break;
                if (__builtin_amdgcn_s_memrealtime() - t0 > 2000000ull) {
                    if (lane == 0) { unsigned expect = 0u; __hip_atomic_compare_exchange_strong(tmo + 1, &expect, code | (unsigned)(u.pm & 0xff), __ATOMIC_RELAXED, __ATOMIC_RELAXED, __HIP_MEMORY_SCOPE_AGENT);
                                     __hip_atomic_store(tmo, 1u, __ATOMIC_RELAXED, __HIP_MEMORY_SCOPE_AGENT); }
                    dead = true; break; }
                __builtin_amdgcn_s_sleep(2);
            }
            __builtin_amdgcn_fence(__ATOMIC_ACQUIRE, "agent");
            if (lane == 0) flag[0] = dead ? 1u : 0u;
        }
        asm volatile("s_waitcnt vmcnt(0) lgkmcnt(0)" ::: "memory"); __builtin_amdgcn_s_barrier(); asm volatile("" ::: "memory");
        const bool bad = flag[0] != 0u;
        if (lane < 32) {
            const unsigned long long* slot = (const unsigned long long*)xbuf + (size_t)(u.pm * BM + row) * 4; float mt[4], m2[4]; float ms = 0.f;
#pragma unroll
            for (int t = 0; t < 4; ++t) { if (t < ntn) { const unsigned long long w = __hip_atomic_load(slot + t, __ATOMIC_RELAXED, __HIP_MEMORY_SCOPE_AGENT); mt[t] = __uint_as_float((unsigned)w); m2[t] = __uint_as_float((unsigned)(w >> 32)); } else { mt[t] = 0.f; m2[t] = 0.f; } ms += mt[t]; }
            const float mean = ms / (float)ntn; float q = 0.f;
#pragma unroll
            for (int t = 0; t < 4; ++t) if (t < ntn) { const float dm = mt[t] - mean; q += m2[t] + 256.0f * dm * dm; }
            S[row] = (f32x2v){mean, 1.0f / sqrtf(q / (256.0f * (float)ntn) + eps)};
        }
        asm volatile("s_waitcnt lgkmcnt(0)" ::: "memory"); __builtin_amdgcn_s_barrier(); asm volatile("" ::: "memory");
        return bad;
    }
};
struct EpiLnRes {
    static constexpr bool PERM = false, AFTER_DRAIN = true;
    const float* base; float* out; int ldc; const float* bias; PanelStats st; unsigned poison;
    __device__ __forceinline__ void fused(f32x4 (&acc)[2][2][4][2], const Unit& u, int wr, int wc, int fr, int fq, PG8_LAS unsigned char* lds, int wid, int lane) const {
        typedef float f32x2v __attribute__((ext_vector_type(2)));
        const PG8_LAS f32x2v* S = (const PG8_LAS f32x2v*)(lds + 8192);
        const int col0 = u.pn * BM + wc * 32 + 4 * fq;
#pragma unroll
        for (int bj = 0; bj < 2; ++bj)
#pragma unroll
            for (int n = 0; n < 2; ++n) { const f32x4 bv = bias ? *(const f32x4*)(bias + col0 + bj * HALF + n * 16) : (f32x4){0.f, 0.f, 0.f, 0.f};
#pragma unroll
                for (int ai = 0; ai < 2; ++ai)
#pragma unroll
                    for (int m = 0; m < 4; ++m) acc[ai][bj][m][n] += bv; }
        f32x4 pre[4][2][2];
#pragma unroll
        for (int m = 0; m < 4; ++m) { const size_t off = (size_t)(u.pm * BM + wr * 64 + m * 16 + fr) * ldc + col0;
#pragma unroll
            for (int bj = 0; bj < 2; ++bj)
#pragma unroll
                for (int n = 0; n < 2; ++n) pre[m][bj][n] = *(const f32x4*)(base + off + bj * HALF + n * 16); }
        const bool bad = st.run(acc, u, wr, wc, fr, fq, lds, wid, lane) || poison != 0u;
        const float qnan = __builtin_nanf("");
#pragma unroll
        for (int ai = 0; ai < 2; ++ai)
#pragma unroll
            for (int m = 0; m < 4; ++m) { const int r = ai * HALF + wr * 64 + m * 16 + fr; const f32x2v sr = S[r]; const size_t off = (size_t)(u.pm * BM + r) * ldc + col0;
#pragma unroll
                for (int bj = 0; bj < 2; ++bj)
#pragma unroll
                    for (int n = 0; n < 2; ++n) { const f32x4 bs = ai == 0 ? pre[m][bj][n] : *(const f32x4*)(base + off + bj * HALF + n * 16); f32x4 o = bs + (acc[ai][bj][m][n] - sr.x) * sr.y;
                        if (bad) o = (f32x4){qnan, qnan, qnan, qnan}; *(f32x4*)(out + off + bj * HALF + n * 16) = o; }
                if (m & 1) asm volatile("" ::: "memory"); }
    }
};
struct EpiLnResLn {
    static constexpr bool PERM = false, AFTER_DRAIN = true;
    const float* base; float* out; bf16_t* xn; int ldc; const float* bias; PanelStats st1, st2; unsigned poison;
    __device__ __forceinline__ void fused(f32x4 (&acc)[2][2][4][2], const Unit& u, int wr, int wc, int fr, int fq, PG8_LAS unsigned char* lds, int wid, int lane) const {
        typedef float f32x2v __attribute__((ext_vector_type(2))); typedef unsigned u32x2v __attribute__((ext_vector_type(2)));
        const PG8_LAS f32x2v* S = (const PG8_LAS f32x2v*)(lds + 8192);
        const int col0 = u.pn * BM + wc * 32 + 4 * fq;
#pragma unroll
        for (int bj = 0; bj < 2; ++bj)
#pragma unroll
            for (int n = 0; n < 2; ++n) { const f32x4 bv = bias ? *(const f32x4*)(bias + col0 + bj * HALF + n * 16) : (f32x4){0.f, 0.f, 0.f, 0.f};
#pragma unroll
                for (int ai = 0; ai < 2; ++ai)
#pragma unroll
                    for (int m = 0; m < 4; ++m) acc[ai][bj][m][n] += bv; }
        bool bad = st1.run(acc, u, wr, wc, fr, fq, lds, wid, lane) || poison != 0u;
        const float qnan = __builtin_nanf("");
#pragma unroll
        for (int ai = 0; ai < 2; ++ai)
#pragma unroll
            for (int m = 0; m < 4; ++m) { const int r = ai * HALF + wr * 64 + m * 16 + fr; const f32x2v sr = S[r]; const size_t off = (size_t)(u.pm * BM + r) * ldc + col0;
#pragma unroll
                for (int bj = 0; bj < 2; ++bj)
#pragma unroll
                    for (int n = 0; n < 2; ++n) { const f32x4 bs = *(const f32x4*)(base + off + bj * HALF + n * 16); acc[ai][bj][m][n] = bs + (acc[ai][bj][m][n] - sr.x) * sr.y; }
                asm volatile("" : "+v"(acc[ai][0][m][0]), "+v"(acc[ai][0][m][1]), "+v"(acc[ai][1][m][0]), "+v"(acc[ai][1][m][1]));
                if (m & 1) asm volatile("" ::: "memory"); }
        const bool bad1 = bad;
        bad = st2.run(acc, u, wr, wc, fr, fq, lds, wid, lane) || bad;
#pragma unroll
        for (int ai = 0; ai < 2; ++ai)
#pragma unroll
            for (int m = 0; m < 4; ++m) { const int r = ai * HALF + wr * 64 + m * 16 + fr; const f32x2v sr = S[r]; const size_t off = (size_t)(u.pm * BM + r) * ldc + col0;
#pragma unroll
                for (int bj = 0; bj < 2; ++bj)
#pragma unroll
                    for (int n = 0; n < 2; ++n) { const f32x4 x1 = acc[ai][bj][m][n]; *(f32x4*)(out + off + bj * HALF + n * 16) = bad1 ? (f32x4){qnan, qnan, qnan, qnan} : x1;
                        const f32x4 o = (x1 - sr.x) * sr.y; u32x2v w; w.x = cvt_pk_bf16(o[0], o[1]); w.y = cvt_pk_bf16(o[2], o[3]);
                        if (bad) { w.x = 0x7fc07fc0u; w.y = 0x7fc07fc0u; } *(u32x2v*)(xn + off + bj * HALF + n * 16) = w; }
                asm volatile("" ::: "memory"); }
    }
};

template <class Epi, class Sched, bool ALIGN_EPI = false, bool SP2 = false>
__device__ __forceinline__ void gemm_phase(PG8_LAS unsigned char* lds, const Gemm g, const Sched& S, const Epi& E) {
    const int tid = opq_tid(), wid = __builtin_amdgcn_readfirstlane(tid >> 6), lane = tid & 63, wr = wid >> 2, wc = wid & 3, fr = lane & 15, fq = lane >> 4;
    const int K = g.K, nt = K / BK;
    unsigned voffA[2], voffB[2];
#pragma unroll
    for (int i = 0; i < 2; ++i) { int R, C; stage_rc(tid * 16 + i * 8192, R, C); const int Rb = Epi::PERM ? ((R & ~31) + perm32(R & 31)) : R;
        voffA[i] = (unsigned)(R * K + C) * 2u; voffB[i] = (unsigned)(Rb * K + C) * 2u; }
    const size_t kstep = (size_t)(BK * 2);
    const size_t hstep = (size_t)HALF * K * 2;
    const size_t tstep = 2 * hstep;
    const unsigned ldsw = (unsigned)wid * 1024u;
    const int aoff = lds_byte(wr * 64 + fr, fq * 8), boff = lds_byte(wc * 32 + fr, fq * 8);
#define PG8_SA(b, h) (((b) * 2 + (h)) * HTB)
#define PG8_SB(b, h) ((4 + (b) * 2 + (h)) * HTB)
#define PG8_STAGE(bufoff, gbase, voff) do { _Pragma("unroll") for (int _i = 0; _i < 2; ++_i) \
        __builtin_amdgcn_global_load_lds((const unsigned*)((const char*)(gbase) + (voff)[_i]), (PG8_LAS unsigned*)(lds + (bufoff) + ldsw + _i * 8192), 16, 0, 0); } while (0)
#define PG8_LDA(dst, b, h) do { _Pragma("unroll") for (int m = 0; m < 4; ++m) _Pragma("unroll") for (int k = 0; k < 2; ++k) dst[m][k] = *(const PG8_LAS bf16x8*)(lds + PG8_SA(b, h) + aoff + m * 2048 + k * 1024); } while (0)
#define PG8_LDB(dst, b, h) do { _Pragma("unroll") for (int n = 0; n < 2; ++n) _Pragma("unroll") for (int k = 0; k < 2; ++k) dst[n][k] = *(const PG8_LAS bf16x8*)(lds + PG8_SB(b, h) + boff + n * 2048 + k * 1024); } while (0)
#define PG8_MMA(ai, bj, At, Bt) do { __builtin_amdgcn_s_setprio(1); _Pragma("unroll") for (int m = 0; m < 4; ++m) _Pragma("unroll") for (int n = 0; n < 2; ++n) _Pragma("unroll") for (int k = 0; k < 2; ++k) \
        acc[ai][bj][m][n] = __builtin_amdgcn_mfma_f32_16x16x32_bf16(Bt[n][k], At[m][k], acc[ai][bj][m][n], 0, 0, 0); __builtin_amdgcn_s_setprio(0); } while (0)
#define PG8_WAIT_V(n) asm volatile("s_waitcnt vmcnt(" #n ")" ::: "memory")
#define PG8_WAIT_L(n) asm volatile("s_waitcnt lgkmcnt(" #n ")" ::: "memory")
#define PG8_BAR __builtin_amdgcn_s_barrier()
#define PG8_SCHED __builtin_amdgcn_sched_barrier(0)
    Unit cur, nxt; int ui = 0;
    if (!S.next(0, cur)) return;
    f32x4 acc[2][2][4][2];
#pragma unroll
    for (int a = 0; a < 2; ++a)
#pragma unroll
        for (int b = 0; b < 2; ++b)
#pragma unroll
            for (int m = 0; m < 4; ++m)
#pragma unroll
                for (int n = 0; n < 2; ++n) acc[a][b][m][n] = (f32x4){0.f, 0.f, 0.f, 0.f};
    bf16x8 At[4][2], B0[2][2], B1[2][2];
    const char* cA = (const char*)g.A + (size_t)cur.pm * tstep; const char* cB = (const char*)g.Bt + (size_t)cur.pn * tstep;
    S.a_ready(cur);
    if constexpr (SP2) {
        PG8_STAGE(PG8_SB(0, 0), cB, voffB); PG8_STAGE(PG8_SB(0, 1), cB + hstep, voffB); PG8_STAGE(PG8_SA(0, 0), cA, voffA); PG8_STAGE(PG8_SA(0, 1), cA + hstep, voffA);
        if (wr == 1) PG8_BAR;
        PG8_WAIT_V(2); PG8_BAR;
        PG8_STAGE(PG8_SB(1, 0), cB + kstep, voffB); PG8_STAGE(PG8_SA(1, 0), cA + kstep, voffA); PG8_STAGE(PG8_SB(1, 1), cB + hstep + kstep, voffB);
        PG8_WAIT_V(6); PG8_BAR;
    } else {
        PG8_STAGE(PG8_SB(0, 0), cB, voffB); PG8_STAGE(PG8_SA(0, 0), cA, voffA); PG8_STAGE(PG8_SB(0, 1), cB + hstep, voffB); PG8_STAGE(PG8_SA(0, 1), cA + hstep, voffA);
        if (wr == 1) PG8_BAR;
        PG8_WAIT_V(4); PG8_BAR;
        PG8_STAGE(PG8_SB(1, 0), cB + kstep, voffB); PG8_STAGE(PG8_SA(1, 0), cA + kstep, voffA); PG8_STAGE(PG8_SB(1, 1), cB + hstep + kstep, voffB);
        PG8_WAIT_V(6); PG8_BAR;
    }
    for (;;) {
        const bool has_next = S.next(ui + 1, nxt);
        const char* nA = has_next ? (const char*)g.A + (size_t)nxt.pm * tstep : cA; const char* nB = has_next ? (const char*)g.Bt + (size_t)nxt.pn * tstep : cB;
        for (int t = 0; t < nt; t += 2) {
            const bool last = (t == nt - 2);
            const char* a1 = cA + (size_t)(t + 1) * kstep;
            const char* a2 = last ? nA : cA + (size_t)(t + 2) * kstep; const char* b2 = last ? nB : cB + (size_t)(t + 2) * kstep;
            const char* a3 = a2 + kstep; const char* b3 = b2 + kstep;
            if (last && has_next) S.a_ready(nxt);
            if constexpr (SP2) {
            PG8_LDB(B0, 0, 0); PG8_LDB(B1, 0, 1); PG8_SCHED; PG8_LDA(At, 0, 0); PG8_STAGE(PG8_SA(1, 1), a1 + hstep, voffA);
            PG8_WAIT_V(8); PG8_WAIT_L(0); PG8_BAR; PG8_MMA(0, 0, At, B0); PG8_MMA(0, 1, At, B1); PG8_BAR; PG8_SCHED;
            PG8_LDA(At, 0, 1); PG8_STAGE(PG8_SB(0, 0), b2, voffB); PG8_STAGE(PG8_SB(0, 1), b2 + hstep, voffB); PG8_STAGE(PG8_SA(0, 0), a2, voffA);
            PG8_WAIT_V(8); PG8_WAIT_L(0); PG8_BAR; PG8_MMA(1, 0, At, B0); PG8_MMA(1, 1, At, B1); PG8_BAR; PG8_SCHED;
            PG8_LDB(B0, 1, 0); PG8_LDB(B1, 1, 1); PG8_SCHED; PG8_LDA(At, 1, 0); PG8_STAGE(PG8_SA(0, 1), a2 + hstep, voffA);
            PG8_WAIT_V(8); PG8_WAIT_L(0); PG8_BAR; PG8_MMA(0, 0, At, B0); PG8_MMA(0, 1, At, B1); PG8_BAR; PG8_SCHED;
            PG8_LDA(At, 1, 1); PG8_STAGE(PG8_SB(1, 0), b3, voffB); PG8_STAGE(PG8_SB(1, 1), b3 + hstep, voffB); PG8_STAGE(PG8_SA(1, 0), a3, voffA);
            PG8_WAIT_V(8); PG8_WAIT_L(0); PG8_BAR; PG8_MMA(1, 0, At, B0); PG8_MMA(1, 1, At, B1); PG8_BAR; PG8_SCHED;
            } else {
            PG8_LDB(B0, 0, 0); PG8_SCHED; PG8_LDA(At, 0, 0); PG8_STAGE(PG8_SA(1, 1), a1 + hstep, voffA);
            PG8_WAIT_L(8); PG8_BAR; PG8_WAIT_L(0); PG8_MMA(0, 0, At, B0); PG8_BAR; PG8_SCHED;
            PG8_LDB(B1, 0, 1); PG8_STAGE(PG8_SB(0, 0), b2, voffB);
            PG8_BAR; PG8_WAIT_L(0); PG8_MMA(0, 1, At, B1); PG8_BAR;
            PG8_LDA(At, 0, 1); PG8_STAGE(PG8_SA(0, 0), a2, voffA);
            PG8_BAR; PG8_WAIT_L(0); PG8_MMA(1, 0, At, B0); PG8_BAR; PG8_SCHED;
            PG8_STAGE(PG8_SB(0, 1), b2 + hstep, voffB);
            PG8_WAIT_V(6); PG8_BAR; PG8_MMA(1, 1, At, B1); PG8_BAR;
            PG8_LDB(B0, 1, 0); PG8_SCHED; PG8_LDA(At, 1, 0); PG8_STAGE(PG8_SA(0, 1), a2 + hstep, voffA);
            PG8_WAIT_L(8); PG8_BAR; PG8_WAIT_L(0); PG8_MMA(0, 0, At, B0); PG8_BAR; PG8_SCHED;
            PG8_LDB(B1, 1, 1); PG8_STAGE(PG8_SB(1, 0), b3, voffB);
            PG8_BAR; PG8_WAIT_L(0); PG8_MMA(0, 1, At, B1); PG8_BAR;
            PG8_LDA(At, 1, 1); PG8_STAGE(PG8_SA(1, 0), a3, voffA);
            PG8_BAR; PG8_WAIT_L(0); PG8_MMA(1, 0, At, B0); PG8_BAR; PG8_SCHED;
            PG8_STAGE(PG8_SB(1, 1), b3 + hstep, voffB);
            PG8_WAIT_V(6); PG8_BAR; PG8_MMA(1, 1, At, B1); PG8_BAR;
            }
        }
        if constexpr (ALIGN_EPI) { if (wr == 0) PG8_BAR; }
        if constexpr (!Epi::AFTER_DRAIN) { E(acc, cur, wr, wc, fr, fq); S.done(cur); }
        if (!has_next) break;
#pragma unroll
        for (int a = 0; a < 2; ++a)
#pragma unroll
            for (int b = 0; b < 2; ++b)
#pragma unroll
                for (int m = 0; m < 4; ++m)
#pragma unroll
                    for (int n = 0; n < 2; ++n) acc[a][b][m][n] = (f32x4){0.f, 0.f, 0.f, 0.f};
        cur = nxt; cA = nA; cB = nB; ++ui;
        if constexpr (ALIGN_EPI) { if (wr == 1) PG8_BAR; }
    }
    PG8_WAIT_V(0);
    if constexpr (!ALIGN_EPI) { if (wr == 0) PG8_BAR; }
    PG8_BAR;
    if constexpr (Epi::AFTER_DRAIN) { E.fused(acc, cur, wr, wc, fr, fq, lds, wid, lane); S.done(cur); }
#undef PG8_SA
#undef PG8_SB
#undef PG8_STAGE
#undef PG8_LDA
#undef PG8_LDB
#undef PG8_MMA
#undef PG8_WAIT_V
#undef PG8_WAIT_L
#undef PG8_BAR
#undef PG8_SCHED
}
}
namespace pg8 {
struct EpiF32 {
    static constexpr bool PERM = false, AFTER_DRAIN = false;
    float* C; int ldc;
    __device__ __forceinline__ void operator()(const f32x4 (&acc)[2][2][4][2], const Unit& u, int wr, int wc, int fr, int fq) const {
        const int row0 = u.pm * BM + wr * 64 + fr, col0 = u.pn * BM + wc * 32 + 4 * fq;
#pragma unroll
        for (int ai = 0; ai < 2; ++ai)
#pragma unroll
            for (int m = 0; m < 4; ++m) { float* rowp = C + (size_t)(row0 + ai * HALF + m * 16) * ldc + col0;
#pragma unroll
                for (int bj = 0; bj < 2; ++bj)
#pragma unroll
                    for (int n = 0; n < 2; ++n) *(f32x4*)(rowp + bj * HALF + n * 16) = acc[ai][bj][m][n]; }
    }
};
__device__ __forceinline__ float bf_lo(unsigned w) { return __uint_as_float(w << 16); }
__device__ __forceinline__ float bf_hi(unsigned w) { return __uint_as_float(w & 0xffff0000u); }
__device__ __forceinline__ float sigmoidf_(float x) { return 1.0f / (1.0f + __expf(-x)); }
struct EpiMerge {
    static constexpr bool PERM = true, AFTER_DRAIN = false;
    bf16_t* Mg; const bf16_t* glog; int ldg; int SP;
    __device__ __forceinline__ void operator()(const f32x4 (&acc)[2][2][4][2], const Unit& u, int wr, int wc, int fr, int fq) const {
        const int b = u.pn >> 2, pn = u.pn & 3, pm = u.pm - b * SP;
        const int row0 = pm * BM + wr * 64 + fr, col0 = pn * BM + wc * 32 + 8 * fq;
#pragma unroll
        for (int ai = 0; ai < 2; ++ai)
#pragma unroll
            for (int m = 0; m < 4; ++m) { const size_t row = (size_t)(row0 + ai * HALF + m * 16);
#pragma unroll
                for (int bj = 0; bj < 2; ++bj) { const int col = col0 + bj * HALF;
                    const u32x4 g = *(const u32x4*)(glog + row * ldg + b * 1024 + col);
                    f32x4 v0 = acc[ai][bj][m][0], v1 = acc[ai][bj][m][1];
                    v0[0] *= sigmoidf_(bf_lo(g.x)); v0[1] *= sigmoidf_(bf_hi(g.x)); v0[2] *= sigmoidf_(bf_lo(g.y)); v0[3] *= sigmoidf_(bf_hi(g.y));
                    v1[0] *= sigmoidf_(bf_lo(g.z)); v1[1] *= sigmoidf_(bf_hi(g.z)); v1[2] *= sigmoidf_(bf_lo(g.w)); v1[3] *= sigmoidf_(bf_hi(g.w));
                    u32x4* dst = (u32x4*)(Mg + row * 1024 + col);
                    if (b != 0) { const u32x4 o = *dst;
                        v0[0] += bf_lo(o.x); v0[1] += bf_hi(o.x); v0[2] += bf_lo(o.y); v0[3] += bf_hi(o.y);
                        v1[0] += bf_lo(o.z); v1[1] += bf_hi(o.z); v1[2] += bf_lo(o.w); v1[3] += bf_hi(o.w); }
                    u32x4 w; w.x = cvt_pk_bf16(v0[0], v0[1]); w.y = cvt_pk_bf16(v0[2], v0[3]); w.z = cvt_pk_bf16(v1[0], v1[1]); w.w = cvt_pk_bf16(v1[2], v1[3]);
                    *dst = w; } }
    }
};
struct MergeOrder {
    int NP, SP, nwg, G, c;
    __host__ __device__ void init(int NP_, int SP_, int G_, int c_) { NP = NP_; SP = SP_; nwg = NP_ * 4; G = G_; c = c_; }
    __host__ __device__ bool next(int i, Unit& u) const {
        const int ti = i / 3, b = i - 3 * ti;
        const long L = (long)ti * G + c; if (L >= nwg) return false;
        int wgid = (int)L; { const int q = nwg / NXCD, r = nwg % NXCD, xcd = wgid % NXCD, off = wgid / NXCD; wgid = (xcd < r ? xcd * (q + 1) : r * (q + 1) + (xcd - r) * q) + off; }
        const int nN = 4, nig = WGM * nN, gid = wgid / nig, fm = gid * WGM, gsz = (NP - fm) < WGM ? (NP - fm) : WGM;
        const int pm = fm + ((wgid % nig) % gsz), pn = (wgid % nig) / gsz;
        u.pm = b * SP + pm; u.pn = b * 4 + pn; return true;
    }
    __device__ __forceinline__ void a_ready(const Unit&) const {}
    __device__ __forceinline__ void done(const Unit&) const {}
};
}
#include <hip/hip_bf16.h>
#include <cmath>
namespace attn_body {
using bf16=__hip_bfloat16;
using bf16x8=__attribute__((ext_vector_type(8)))short;
using s16x4=__attribute__((ext_vector_type(4)))short;
using f32x16=__attribute__((ext_vector_type(16)))float;
using u32x4=__attribute__((ext_vector_type(4)))unsigned;
constexpr int D=64;
constexpr int NW=8,QBLK=32,QB=QBLK*NW,KVBLK=64;
constexpr int ATTN_UNIT_ROWS=QB;
__device__ __forceinline__ int crow(int r,int hi){return (r&3)+8*(r>>2)+4*hi;}
#define SBAR() __builtin_amdgcn_sched_barrier(0)
constexpr int WIN=128;
__device__ __forceinline__ void wmask(f32x16&p0,f32x16&p1,int kd){
  const float NEG=-INFINITY;
  #pragma unroll
  for(int r=0;r<16;++r){const int d0=kd+(r&3)+8*(r>>2); if(d0>WIN||d0<-WIN)p0[r]=NEG; const int d1=d0+32; if(d1>WIN||d1<-WIN)p1[r]=NEG;}
}
struct AttnJob {
  const bf16* Q; const bf16* K; const bf16* V; bf16* O;
  int qp, kp, op;
  int nt, nt0, row1;
  int qpos0, kpos1;
  float sink2;
};
constexpr int NSLOT=3, SLOTB=8192;
constexpr int LDS_K=0, LDS_V=NSLOT*SLOTB, LDS_WS=2*NSLOT*SLOTB, LDS_OST=LDS_WS+NW*64*4, LDS_BYTES=LDS_OST+NW*4096;
constexpr float C2=0.125f*1.4426950408889634f;
__device__ __forceinline__ void glds16(const void*gsrc,unsigned lds_dst){unsigned keep;
  asm volatile("s_mov_b32 %0, m0\n\ts_mov_b32 m0, %2\n\ts_nop 0\n\tglobal_load_lds_dwordx4 %1, off\n\ts_mov_b32 m0, %0":"=&s"(keep):"v"(gsrc),"s"(lds_dst):"memory");}
__device__ __forceinline__ float max3f(float a,float b,float c){float r;asm("v_max3_f32 %0, %1, %2, %3":"=v"(r):"v"(a),"v"(b),"v"(c));return r;}
__device__ __forceinline__ float max2f(float a,float b){float r;asm("v_max_f32_e32 %0, %1, %2":"=v"(r):"v"(a),"v"(b));return r;}
__device__ __forceinline__ float fadd_s(float a,float b){float r;asm("v_add_f32_e32 %0, %1, %2":"=v"(r):"v"(a),"v"(b));return r;}
__device__ __forceinline__ float fsub_s(float a,float b){float r;asm("v_sub_f32_e32 %0, %1, %2":"=v"(r):"v"(a),"v"(b));return r;}
typedef float f32x2_t __attribute__((ext_vector_type(2))); typedef __bf16 bf16x2_t __attribute__((ext_vector_type(2)));
__device__ __forceinline__ unsigned cvtpk_s(float lo,float hi){f32x2_t v={lo,hi};bf16x2_t b=__builtin_convertvector(v,bf16x2_t);return __builtin_bit_cast(unsigned,b);}
#define WAIT_BAR(N) asm volatile("s_waitcnt vmcnt(" #N ") lgkmcnt(0)\n\ts_barrier":::"memory")

__device__ __forceinline__ void qkt(f32x16&p0,f32x16&p1,const char*Kslot,const bf16x8*qr,const f32x16&negm,int r32,int hi){
  const char*kb=Kslot+hi*1024+r32*16;
  #pragma unroll
  for(int d0=0;d0<4;++d0){
    const bf16x8 b0=*reinterpret_cast<const bf16x8*>(kb+d0*2048);
    const bf16x8 b1=*reinterpret_cast<const bf16x8*>(kb+d0*2048+512);
    if(d0==0){p0=__builtin_amdgcn_mfma_f32_32x32x16_bf16(b0,qr[0],negm,0,0,0);p1=__builtin_amdgcn_mfma_f32_32x32x16_bf16(b1,qr[0],negm,0,0,0);}
    else{p0=__builtin_amdgcn_mfma_f32_32x32x16_bf16(b0,qr[d0],p0,0,0,0);p1=__builtin_amdgcn_mfma_f32_32x32x16_bf16(b1,qr[d0],p1,0,0,0);}}
}
typedef __attribute__((address_space(3))) const char* lds_cptr;
typedef short v4i16_t __attribute__((ext_vector_type(4)));
__device__ __forceinline__ void kload8(bf16x8*kf,lds_cptr kp){
  kf[0]=*(const __attribute__((address_space(3))) bf16x8*)(kp);      kf[1]=*(const __attribute__((address_space(3))) bf16x8*)(kp+512);
  kf[2]=*(const __attribute__((address_space(3))) bf16x8*)(kp+2048); kf[3]=*(const __attribute__((address_space(3))) bf16x8*)(kp+2560);
  kf[4]=*(const __attribute__((address_space(3))) bf16x8*)(kp+4096); kf[5]=*(const __attribute__((address_space(3))) bf16x8*)(kp+4608);
  kf[6]=*(const __attribute__((address_space(3))) bf16x8*)(kp+6144); kf[7]=*(const __attribute__((address_space(3))) bf16x8*)(kp+6656);
}
__device__ __forceinline__ void kload2(bf16x8*kf,lds_cptr kp,int j){ kf[2*j]=*(const __attribute__((address_space(3))) bf16x8*)(kp+j*2048); kf[2*j+1]=*(const __attribute__((address_space(3))) bf16x8*)(kp+j*2048+512); }
__device__ __forceinline__ s16x4 vtr(lds_cptr p){ return __builtin_bit_cast(s16x4,__builtin_amdgcn_ds_read_tr16_b64_v4i16((__attribute__((address_space(3))) v4i16_t*)p)); }
__device__ __forceinline__ float rowmax(const f32x16&p0,const f32x16&p1){
  float a=max3f(p0[0],p0[1],p1[0]),b=max3f(p0[2],p0[3],p1[1]);a=max3f(a,p1[2],p1[3]);
  #pragma unroll
  for(int r=4;r<16;r+=4){a=max3f(a,p0[r],p0[r+1]);b=max3f(b,p0[r+2],p0[r+3]);a=max3f(a,p1[r],p1[r+1]);b=max3f(b,p1[r+2],p1[r+3]);}
  const float m=max2f(a,b);
  auto rr=__builtin_amdgcn_permlane32_swap(__float_as_uint(m),__float_as_uint(m),false,false);
  return max2f(__uint_as_float(rr[0]),__uint_as_float(rr[1]));
}
__device__ __forceinline__ void pv(f32x16*o,int vb,bf16x8 pa0,bf16x8 pa1,bf16x8 pa2,bf16x8 pa3){
  #pragma unroll
  for(int d0=0;d0<2;++d0){s16x4 lo[4],hi[4];
    #pragma unroll
    for(int ks=0;ks<4;++ks){
      asm volatile("ds_read_b64_tr_b16 %0,%1 offset:%c2":"=&v"(lo[ks]):"v"(vb),"i"(d0*4096+ks*1024):"memory");
      asm volatile("ds_read_b64_tr_b16 %0,%1 offset:%c2":"=&v"(hi[ks]):"v"(vb),"i"(d0*4096+ks*1024+512):"memory");}
    asm volatile("s_waitcnt lgkmcnt(0)":::"memory");SBAR();
    #define PK(k) (bf16x8){lo[k][0],lo[k][1],lo[k][2],lo[k][3],hi[k][0],hi[k][1],hi[k][2],hi[k][3]}
    o[d0]=__builtin_amdgcn_mfma_f32_32x32x16_bf16(pa0,PK(0),o[d0],0,0,0);
    o[d0]=__builtin_amdgcn_mfma_f32_32x32x16_bf16(pa1,PK(1),o[d0],0,0,0);
    o[d0]=__builtin_amdgcn_mfma_f32_32x32x16_bf16(pa2,PK(2),o[d0],0,0,0);
    o[d0]=__builtin_amdgcn_mfma_f32_32x32x16_bf16(pa3,PK(3),o[d0],0,0,0);
    #undef PK
  }
}

#ifndef ATTN_STORE16
#define ATTN_STORE16(p,v) (*(u32x4*)(p)=(v))
#endif
template<int THRL,int MODE> __device__ __forceinline__ void attn_unit(const AttnJob&J,char*shm){
  const int QP=J.qp,KP=J.kp,OP=J.op,NT0=J.nt0,ROW1=J.row1;
  const int tid=opq_tid(),lane=tid&63,r32=lane&31,hi=lane>>5; const int wid=__builtin_amdgcn_readfirstlane(tid>>6);
  const bf16*Qw=J.Q+(long)(wid*QBLK)*QP;
  const bf16*Kh=J.K,*Vh=J.V;
  const unsigned lds0=(unsigned)(uintptr_t)shm;
  float*wsf=(float*)(shm+LDS_WS)+wid*64;
  const bf16*ksrc=Kh+(long)lane*KP+wid*8;
  const bf16*vsrc=Vh+(long)(16*(wid&3)+(lane>>2))*KP+(wid>>2)*32+(lane&3)*8;
  const unsigned kdst=lds0+LDS_K+wid*1024, vdst=lds0+LDS_V+wid*1024;
  #define TROW(t) ((t)<NT0?(t)*KVBLK:ROW1+((t)-NT0)*KVBLK)
  #define DMA_K(t,slot) glds16(ksrc+(long)TROW(t)*KP,(unsigned)__builtin_amdgcn_readfirstlane(kdst+(slot)))
  #define DMA_V(t,slot) glds16(vsrc+(long)TROW(t)*KP,(unsigned)__builtin_amdgcn_readfirstlane(vdst+(slot)))
  const int vb0=(int)(lds0+LDS_V)+((lane>>4)&1)*32+(lane&3)*8+(4*hi+((lane&15)>>2))*64;
  const char*Kbase=shm+LDS_K; bf16x8 kf[8];
  const lds_cptr shm3=(lds_cptr)shm; const lds_cptr kp0=shm3+LDS_K+hi*1024+r32*16; const lds_cptr vp0=shm3+LDS_V+((lane>>4)&1)*32+(lane&3)*8+(4*hi+((lane&15)>>2))*64;
  const int NT=J.nt;
  DMA_K(0,0);DMA_V(0,0);DMA_K(1,SLOTB);
  bf16x8 qr[4];
  #pragma unroll
  for(int d0=0;d0<4;++d0)qr[d0]=*reinterpret_cast<const bf16x8*>(&Qw[(long)r32*QP+d0*16+hi*8]);
  float mhat=0.f,l_reg=0.f;f32x16 o[2];o[0]=f32x16{};o[1]=f32x16{};f32x16 negm=f32x16{};if constexpr(MODE==0)asm volatile("":"+v"(negm));
  const int kd0=J.kpos1+4*hi-(J.qpos0+wid*QBLK+r32);
  #define CMASK(P0,P1,t) do{ if constexpr(MODE==1){ if((t)>=NT0) wmask(P0,P1,kd0+((t)-NT0)*KVBLK); } }while(0)
  bool resc=false;
  #define START(P0,P1) do{ const float rm=rowmax(P0,P1); resc=false; \
    { const float dl=rm; mhat=fadd_s(mhat,dl); \
      _Pragma("unroll") for(int r=0;r<16;++r){P0[r]=fsub_s(P0[r],dl);P1[r]=fsub_s(P1[r],dl);} \
      if constexpr(MODE==0){ _Pragma("unroll") for(int r=0;r<16;++r)negm[r]=-mhat; asm volatile("":"+v"(negm)); } } \
    _Pragma("unroll") for(int r=0;r<16;++r)P0[r]=__builtin_amdgcn_exp2f(P0[r]); }while(0)
  #define RESC() do{ if(resc){ asm volatile("s_waitcnt lgkmcnt(0)":::"memory"); \
      _Pragma("unroll") for(int d_=0;d_<2;++d_) _Pragma("unroll") for(int r=0;r<16;++r)o[d_][r]*=wsf[crow(r,hi)]; } }while(0)
  f32x16 pA0,pA1,pB0,pB1;
  int sl_prev=0,sl_cur=0,sl_next=SLOTB;
  #define ROT() do{sl_prev=sl_cur;sl_cur=sl_next;sl_next=(sl_next==(NSLOT-1)*SLOTB)?0:sl_next+SLOTB;}while(0)
  DMA_K(2,2*SLOTB);
  WAIT_BAR(3);
  qkt(pA0,pA1,Kbase,qr,f32x16{},r32,hi);asm volatile("s_nop 15\n\ts_nop 7":"+v"(pA0),"+v"(pA1));CMASK(pA0,pA1,0);
  START(pA0,pA1);
  _Pragma("unroll") for(int r=0;r<16;++r)pA1[r]=__builtin_amdgcn_exp2f(pA1[r]);
  WAIT_BAR(0);
  DMA_K(3,0);DMA_V(1,SLOTB);
  ROT();
  kload8(kf,kp0+sl_cur);
  WAIT_BAR(2);
  s16x4 vlo[8],vhi[8]; u32x4 pw0,pw1,pw2,pw3;
  #define PKW(P,B) cvtpk_s(P[B],P[B+1])
  #define PAF(k) __builtin_bit_cast(bf16x8,pw##k)
  #define VFR(i) (bf16x8){vlo[i][0],vlo[i][1],vlo[i][2],vlo[i][3],vhi[i][0],vhi[i][1],vhi[i][2],vhi[i][3]}
  #define PIN(x) asm volatile("":"+v"(x))
  #define MX3(a,b,c) __builtin_fmaxf(__builtin_fmaxf((a),(b)),(c))
  #define GAPA(MF,A0,A1,A2,A3,W0,W1,PW) do{ MF; sacc+=A0; sacc+=A1; sacc+=A2; sacc+=A3; PIN(sacc); W0; W1; PIN(PW); SBAR(); }while(0)
  #define EX(v) __builtin_amdgcn_exp2f(MODE==1?(v)-mhat:(v))
  #define CINIT (MODE==1?f32x16{}:negm)
  #define GAPB(MF,X,B) do{ MF; X[B]=EX(X[B]); X[B+1]=EX(X[B+1]); X[B+2]=EX(X[B+2]); X[B+3]=EX(X[B+3]); PIN(X); SBAR(); }while(0)
  #define VRD(i) do{ vlo[i]=vtr(vp_+(((i)>>2)*4096+((i)&3)*1024)); vhi[i]=vtr(vp_+(((i)>>2)*4096+((i)&3)*1024+512)); }while(0)
  #define KRD(G,j) do{ if(G){ kload2(kf,kp0+sl_next,j); SBAR(); } }while(0)
  #define STEP(C0,C1,P0,P1,t,GK,GV,GL) do{ SBAR(); \
    const lds_cptr vp_=vp0+sl_prev; \
    VRD(0); SBAR(); float sacc=(P0[0]+P0[1]); \
    GAPA(C0=__builtin_amdgcn_mfma_f32_32x32x16_bf16(kf[0],qr[0],CINIT,0,0,0), P0[2],P0[3],P0[4],P0[5],     pw0[0]=PKW(P0,0), pw0[1]=PKW(P0,2), pw0); \
    VRD(4); SBAR(); GAPA(C1=__builtin_amdgcn_mfma_f32_32x32x16_bf16(kf[1],qr[0],CINIT,0,0,0), P0[6],P0[7],P0[8],P0[9],     pw0[2]=PKW(P0,4), pw0[3]=PKW(P0,6), pw0); \
    VRD(1); SBAR(); GAPA(C0=__builtin_amdgcn_mfma_f32_32x32x16_bf16(kf[2],qr[1],C0,0,0,0),   P0[10],P0[11],P0[12],P0[13], pw1[0]=PKW(P0,8), pw1[1]=PKW(P0,10), pw1); \
    VRD(5); SBAR(); GAPA(C1=__builtin_amdgcn_mfma_f32_32x32x16_bf16(kf[3],qr[1],C1,0,0,0),   P0[14],P0[15],P1[0],P1[1],   pw1[2]=PKW(P0,12),pw1[3]=PKW(P0,14), pw1); \
    VRD(2); SBAR(); GAPA(C0=__builtin_amdgcn_mfma_f32_32x32x16_bf16(kf[4],qr[2],C0,0,0,0),   P1[2],P1[3],P1[4],P1[5],     pw2[0]=PKW(P1,0), pw2[1]=PKW(P1,2), pw2); \
    VRD(6); SBAR(); GAPA(C1=__builtin_amdgcn_mfma_f32_32x32x16_bf16(kf[5],qr[2],C1,0,0,0),   P1[6],P1[7],P1[8],P1[9],     pw2[2]=PKW(P1,4), pw2[3]=PKW(P1,6), pw2); \
    VRD(3); SBAR(); GAPA(C0=__builtin_amdgcn_mfma_f32_32x32x16_bf16(kf[6],qr[3],C0,0,0,0),   P1[10],P1[11],P1[12],P1[13], pw3[0]=PKW(P1,8), pw3[1]=PKW(P1,10), pw3); \
    VRD(7); SBAR(); GAPA(C1=__builtin_amdgcn_mfma_f32_32x32x16_bf16(kf[7],qr[3],C1,0,0,0),   P1[14],P1[15],0.f,0.f,       pw3[2]=PKW(P1,12),pw3[3]=PKW(P1,14), pw3); \
    l_reg+=sacc; \
    if(GK){DMA_K((t)+3,sl_cur);} if(GV){DMA_V((t)+1,sl_next);} \
    CMASK(C0,C1,t); \
    { float a=MX3(C0[0],C0[1],C1[0]),b=MX3(C0[2],C0[3],C1[1]); a=MX3(a,C1[2],C1[3]); \
      _Pragma("unroll") for(int r=4;r<16;r+=4){a=MX3(a,C0[r],C0[r+1]);b=MX3(b,C0[r+2],C0[r+3]);a=MX3(a,C1[r],C1[r+1]);b=MX3(b,C1[r+2],C1[r+3]);} \
      float rm=__builtin_fmaxf(a,b); { auto rr=__builtin_amdgcn_permlane32_swap(__float_as_uint(rm),__float_as_uint(rm),false,false); rm=__builtin_fmaxf(__uint_as_float(rr[0]),__uint_as_float(rr[1])); } \
      if constexpr(MODE==1) rm-=mhat; \
      resc=false; \
      if(__builtin_expect(__any(rm>(float)THRL),0)){ const float dl=__builtin_fmaxf(rm,0.f); mhat+=dl; \
        if constexpr(MODE==0){ _Pragma("unroll") for(int r=0;r<16;++r){C0[r]-=dl;C1[r]-=dl;} \
        _Pragma("unroll") for(int r=0;r<16;++r)negm[r]=-mhat; asm volatile("":"+v"(negm)); } \
        const float f=__builtin_amdgcn_exp2f(-dl); l_reg*=f; if(hi==0)wsf[r32]=f; resc=true; } } \
    SBAR(); \
    GAPB(o[0]=__builtin_amdgcn_mfma_f32_32x32x16_bf16(PAF(0),VFR(0),o[0],0,0,0), C0,0); \
    GAPB(o[1]=__builtin_amdgcn_mfma_f32_32x32x16_bf16(PAF(0),VFR(4),o[1],0,0,0), C0,4); \
    KRD(GL,0); GAPB(o[0]=__builtin_amdgcn_mfma_f32_32x32x16_bf16(PAF(1),VFR(1),o[0],0,0,0), C0,8); \
    KRD(GL,1); GAPB(o[1]=__builtin_amdgcn_mfma_f32_32x32x16_bf16(PAF(1),VFR(5),o[1],0,0,0), C0,12); \
    KRD(GL,2); GAPB(o[0]=__builtin_amdgcn_mfma_f32_32x32x16_bf16(PAF(2),VFR(2),o[0],0,0,0), C1,0); \
    KRD(GL,3); GAPB(o[1]=__builtin_amdgcn_mfma_f32_32x32x16_bf16(PAF(2),VFR(6),o[1],0,0,0), C1,4); \
    GAPB(o[0]=__builtin_amdgcn_mfma_f32_32x32x16_bf16(PAF(3),VFR(3),o[0],0,0,0), C1,8); \
    GAPB(o[1]=__builtin_amdgcn_mfma_f32_32x32x16_bf16(PAF(3),VFR(7),o[1],0,0,0), C1,12); \
    }while(0)
  int t=1;
  for(;t+5<NT;t+=2){
    STEP(pB0,pB1,pA0,pA1,t,true,true,true);     WAIT_BAR(2); RESC(); ROT();
    STEP(pA0,pA1,pB0,pB1,t+1,true,true,true);   WAIT_BAR(2); RESC(); ROT();
  }
  #define ENDW(tt) do{ if((tt)+3<NT){WAIT_BAR(2);} else if((tt)+2<NT){WAIT_BAR(1);} else {WAIT_BAR(0);} }while(0)
  for(;t+1<NT;t+=2){
    STEP(pB0,pB1,pA0,pA1,t,(t+3<NT),(t+1<NT),(t+1<NT));       ENDW(t);   RESC(); ROT();
    STEP(pA0,pA1,pB0,pB1,t+1,(t+4<NT),(t+2<NT),(t+2<NT));     ENDW(t+1); RESC(); ROT();
  }
  STEP(pB0,pB1,pA0,pA1,NT-1,false,false,false); RESC();
  { float sacc=pB0[0]+pB0[1]; _Pragma("unroll") for(int r=2;r<16;++r)sacc+=pB0[r]; _Pragma("unroll") for(int r=0;r<16;++r)sacc+=pB1[r]; l_reg+=sacc;
    pw0=(u32x4){PKW(pB0,0),PKW(pB0,2),PKW(pB0,4),PKW(pB0,6)};pw1=(u32x4){PKW(pB0,8),PKW(pB0,10),PKW(pB0,12),PKW(pB0,14)};pw2=(u32x4){PKW(pB1,0),PKW(pB1,2),PKW(pB1,4),PKW(pB1,6)};pw3=(u32x4){PKW(pB1,8),PKW(pB1,10),PKW(pB1,12),PKW(pB1,14)};
    SBAR(); pv(o,vb0+sl_cur,PAF(0),PAF(1),PAF(2),PAF(3)); }
  #undef PKW
  #undef PAF
  #undef VFR
  #undef PIN
  #undef MX3
  #undef GAPA
  #undef GAPB
  #undef EX
  #undef CINIT
  #undef VRD
  #undef KRD
  #undef STEP
  #undef ENDW
  {auto rr=__builtin_amdgcn_permlane32_swap(__float_as_uint(l_reg),__float_as_uint(l_reg),false,false);l_reg=__uint_as_float(rr[0])+__uint_as_float(rr[1]);}
  l_reg+=__builtin_amdgcn_exp2f(J.sink2-mhat);
  if(hi==0)wsf[32+r32]=l_reg;asm volatile("s_waitcnt lgkmcnt(0)":::"memory");
  float rli[16];
  #pragma unroll
  for(int r=0;r<16;++r)rli[r]=__builtin_amdgcn_rcpf(wsf[32+crow(r,hi)]);
  bf16*Ow=J.O+(long)(wid*QBLK)*OP;
  { bf16*stg=(bf16*)(shm+LDS_OST)+wid*2048;
    #pragma unroll
    for(int r=0;r<16;++r){const int orow=crow(r,hi);
      #pragma unroll
      for(int d0=0;d0<2;++d0)stg[orow*64+d0*32+r32]=__float2bfloat16(o[d0][r]*rli[r]);}
    asm volatile("s_waitcnt lgkmcnt(0)":::"memory");
    #pragma unroll
    for(int i=0;i<4;++i){const int row=i*8+(lane>>3),ch=lane&7; const u32x4 v=*(const u32x4*)(stg+row*64+ch*8); ATTN_STORE16(Ow+(long)row*OP+ch*8,v);} }
  asm volatile("s_waitcnt lgkmcnt(0)\n\ts_barrier":::"memory");
  #undef TROW
  #undef DMA_K
  #undef DMA_V
  #undef CMASK
  #undef START
  #undef RESC
  #undef ROT
}
constexpr int ATTN_LDS_BYTES=LDS_BYTES;
#undef SBAR
#undef WAIT_BAR
}
#define GAS __attribute__((address_space(1)))
#define LAS __attribute__((address_space(3)))
typedef unsigned short bf16;
typedef unsigned v4u __attribute__((ext_vector_type(4)));
typedef float f32x4 __attribute__((ext_vector_type(4)));
typedef short bf16x8 __attribute__((ext_vector_type(8)));
typedef GAS unsigned gu32;
typedef GAS unsigned long long gu64;
#define RLX_AGENT __ATOMIC_RELAXED, __HIP_MEMORY_SCOPE_AGENT
#define LDS_WAIT() asm volatile("s_waitcnt lgkmcnt(0)" ::: "memory")
#define VM_WAIT() asm volatile("s_waitcnt vmcnt(0)" ::: "memory")
__device__ __forceinline__ unsigned long long rt() { return __builtin_amdgcn_s_memrealtime(); }
__device__ __forceinline__ unsigned f2bf(float f) { unsigned u = __builtin_bit_cast(unsigned, f); return (u + 0x7fffu + ((u >> 16) & 1u)) >> 16; }
__device__ __forceinline__ unsigned pk2(float lo, float hi) { return f2bf(lo) | (f2bf(hi) << 16); }

#define XB_TMO      128
#define XB_XCNT(j)  (256  + 64 * (j))
#define XB_XSUB(j)  (1280 + 64 * (j))
#define XB_XGEN(j)  (2304 + 64 * (j))
#define XB_TOP      3328
#define XB_TOPGEN   3392
#define XCD_BAR_WORDS 3456
#define XB_SPIN_CAP (1u << 18)

__device__ __forceinline__ unsigned xb_ld(unsigned* p)              { return __hip_atomic_load(p, __ATOMIC_RELAXED, __HIP_MEMORY_SCOPE_AGENT); }
__device__ __forceinline__ unsigned xb_add(unsigned* p, unsigned v) { return __hip_atomic_fetch_add(p, v, __ATOMIC_RELAXED, __HIP_MEMORY_SCOPE_AGENT); }
__device__ __forceinline__ unsigned xb_xcc_id() { return (unsigned)__builtin_amdgcn_s_getreg((3 << 11) | 20) & 0xFu; }
#define XB_SPIN(cond, bar) do { unsigned _sp = 0; while (cond) { __builtin_amdgcn_s_sleep(1); \
    if ((++_sp & 255u) == 0u) { if (xb_ld(&(bar)[XB_TMO])) break; if (_sp > XB_SPIN_CAP) { atomicAdd(&(bar)[XB_TMO], 1u); break; } } } } while (0)

struct XcdBarrier {
    unsigned* bar; unsigned x;
    volatile LAS unsigned* st;
};

__device__ __forceinline__ XcdBarrier xcd_barrier_post(unsigned* bar, volatile LAS unsigned* st) {
    XcdBarrier b; b.bar = bar; b.x = xb_xcc_id(); b.st = st;
    if (opq_tid() == 0) (void)xb_add(&bar[XB_XCNT(b.x)], 1u);
    return b;
}
__device__ __forceinline__ void xcd_barrier_complete(unsigned* bar, unsigned x, unsigned& nloc, unsigned& nx) {
    const unsigned G = gridDim.x * gridDim.y * gridDim.z;
    unsigned sum, cnt, mine, sp = 0u;
    for (;;) {
        sum = 0u; cnt = 0u; mine = 0u;
#pragma unroll
        for (unsigned j = 0; j < 16; ++j) { const unsigned c = xb_ld(&bar[XB_XCNT(j)]); sum += c; cnt += (c > 0u) ? 1u : 0u; mine = (j == x) ? c : mine; }
        if (sum == G) break;
        __builtin_amdgcn_s_sleep(1);
        if ((++sp & 255u) == 0u) { if (xb_ld(&bar[XB_TMO])) break; if (sp > XB_SPIN_CAP) { atomicAdd(&bar[XB_TMO], 1u); break; } }
    }
    nloc = mine > 0u ? mine : 1u; nx = cnt > 0u ? cnt : 1u;
}

__device__ __forceinline__ void xcd_barrier(const XcdBarrier& b) {
    asm volatile("s_waitcnt vmcnt(0)" ::: "memory");
    __syncthreads();
    if (opq_tid() == 0) {
        GAS unsigned* barg = (GAS unsigned*)b.bar; unsigned bxx = b.x; asm volatile("" : "+s"(barg), "+s"(bxx)); unsigned* bar = (unsigned*)barg;
        __builtin_amdgcn_s_waitcnt(0);
        unsigned nloc = b.st[0], nx = b.st[1];
        if (nloc == 0u) { xcd_barrier_complete(bar, bxx, nloc, nx); b.st[0] = nloc; b.st[1] = nx; }
        const unsigned old = xb_add(&bar[XB_XSUB(bxx)], 1u);
        const unsigned gen = old / nloc;
        if (old + 1u == (gen + 1u) * nloc) {
            __builtin_amdgcn_fence(__ATOMIC_RELEASE, "agent");
            asm volatile("s_waitcnt vmcnt(0)" ::: "memory");
            const unsigned og = xb_add(&bar[XB_TOP], 1u);
            const unsigned tg = og / nx;
            if (og + 1u == (tg + 1u) * nx) xb_add(&bar[XB_TOPGEN], 1u);
            else XB_SPIN(xb_ld(&bar[XB_TOPGEN]) == tg, bar);
            __builtin_amdgcn_fence(__ATOMIC_ACQUIRE, "agent");
            xb_add(&bar[XB_XGEN(bxx)], 1u);
            asm volatile("s_waitcnt vmcnt(0)" ::: "memory");
        } else {
            XB_SPIN(xb_ld(&bar[XB_XGEN(bxx)]) == gen, bar);
            __builtin_amdgcn_fence(__ATOMIC_ACQUIRE, "agent");
            asm volatile("s_waitcnt vmcnt(0)" ::: "memory");
        }
    }
    __syncthreads();
}
namespace cg = cooperative_groups;
constexpr int NWAVES = 8, NTHREADS = 512;
constexpr int R = 16640, NCTX = 256, SEQ = 16384, DM = 1024, INC = 6144, NL = 2, NEXP = 16384, SPAN = 65;
constexpr float ALPHA = 1.41421356237f, LN_EPS = 1e-6f, RMS_EPS = 1e-6f, LOG2E = 1.4426950408889634f;
constexpr float QSCALE = 0.125f * 1.4426950408889634f;
constexpr int C_QA = 0, C_KA = 512, C_VA = 640, C_QC = 768, C_KC = 1280, C_VC = 1408, C_XB = 1536, C_GB = 2048, C_GC = 2560, C_GL = 3072;
enum { I_X = 0, I_C, I_CTX, I_CCTX, I_WMOD, I_BMOD, I_WIN, I_QN, I_KN, I_CONVW, I_SINK, I_WBR, I_WOUT, I_LN1G, I_LN1B, I_WPQ, I_SK, I_UT, I_VT, I_LN2G, I_LN2B, N_IN };
constexpr size_t MiB = 1u << 20;
constexpr size_t WS_CTL = 0, CTL_ZERO_BYTES = 1 * MiB;
constexpr size_t WS_MODP = 1 * MiB;
constexpr size_t WS_MODV = WS_MODP + 1536 * 1024;
constexpr size_t WS_ROPE = WS_MODV + 128 * 1024;
constexpr size_t WS_WSM = 3 * MiB, WSM_L = 22 * MiB;
constexpr size_t OW_IN = 0, OW_BR = 12 * MiB, OW_OUT = 15 * MiB, OW_PQ = 17 * MiB, OW_SK = 21 * MiB;
constexpr size_t WS_U = WS_WSM + 2 * WSM_L, WS_V = WS_U + 32 * MiB;
constexpr size_t WS_X = WS_V + 32 * MiB;
constexpr size_t WS_G1 = WS_X + 65 * MiB;
constexpr size_t WS_YO = WS_G1, WS_PQ = WS_G1 + 65 * MiB, WS_IDX = WS_G1 + 130 * MiB, WS_WGT = WS_G1 + 139 * MiB;
constexpr size_t WS_HA = WS_G1 + 195 * MiB, WS_HB = WS_HA + 33 * MiB;
constexpr size_t WS_Y = WS_HB + 33 * MiB;
constexpr size_t WS_END = WS_Y + 49 * MiB;
static_assert(WS_END <= 512 * MiB, "d_ws map");
constexpr int CW_BAR = 4096;
constexpr int RING_BYTES = 131072, LDSCTL_OFF = RING_BYTES, MISC_OFF = LDSCTL_OFF + 320, LDS_BYTES = 147456;
typedef __bf16 bf16x2_t __attribute__((ext_vector_type(2)));
typedef unsigned u32x2 __attribute__((ext_vector_type(2)));

struct Args { const float* in[N_IN]; float* out; unsigned char* ws; int ph_lo, ph_hi, coop, pad; };

__device__ __forceinline__ float wave_sum(float v) {
#pragma unroll
    for (int o = 1; o < 64; o <<= 1) v += __shfl_xor(v, o);
    return v;
}
__device__ __forceinline__ float bflo(unsigned w) { return __uint_as_float(w << 16); }
__device__ __forceinline__ float bfhi(unsigned w) { return __uint_as_float(w & 0xffff0000u); }
__device__ __forceinline__ float bf1(bf16 h) { return __uint_as_float((unsigned)h << 16); }
__device__ __forceinline__ float dot2bf(unsigned w, unsigned x, float acc) { return __builtin_amdgcn_fdot2_f32_bf16(__builtin_bit_cast(bf16x2_t, w), __builtin_bit_cast(bf16x2_t, x), acc, false); }
__device__ __forceinline__ float silu_f(float x) { return x / (1.0f + __expf(-x)); }
__device__ __forceinline__ float gelu_f(float v) {
    const float av = fabsf(v), t = __builtin_amdgcn_rcpf(av * 0.2316418882f + 1.0f);
    float q = t * 0.5307027145f + (-0.7265760135f); q = q * t + 0.7107068705f; q = q * t + (-0.142248368f); q = q * t + 0.127414796f; q = q * t;
    const float e = __builtin_amdgcn_exp2f((v * v) * (-0.72134752044f));
    const float m = v * (q * e);
    return v < 0.f ? m : v - m;
}
__device__ __forceinline__ float vmaxf(float a, float b) { float r; asm("v_max_f32_e32 %0, %1, %2" : "=v"(r) : "v"(a), "v"(b)); return r; }
__device__ __forceinline__ float vminf(float a, float b) { float r; asm("v_min_f32_e32 %0, %1, %2" : "=v"(r) : "v"(a), "v"(b)); return r; }

typedef const __attribute__((address_space(4))) unsigned long long* kargp_t;
__device__ __forceinline__ const float* ain(int k) { kargp_t p = (kargp_t)__builtin_amdgcn_kernarg_segment_ptr(); return (const float*)(const GAS float*)(*(volatile kargp_t)(p + k)); }
__device__ __forceinline__ float* aout() { kargp_t p = (kargp_t)__builtin_amdgcn_kernarg_segment_ptr(); return (float*)(GAS float*)(*(volatile kargp_t)(p + N_IN)); }
struct Frame {
    LAS unsigned char* lds; unsigned char* lds_g;
    int tid, lane, wave, G, bx, vcu, gw, NGW;
    const float* in[N_IN]; float* out; unsigned char* ws;
};
__device__ __forceinline__ void p0_transpose_item(const float* W, int K, int N, bf16* WT, LAS float* scr, int item, int lane) {
    const int nblk = N / 32, kb = item / nblk, nb = item % nblk, k0 = 64 * kb, n0 = 32 * nb;
#pragma unroll 8
    for (int i = 0; i < 32; ++i) { const int kk = 2 * i + (lane >> 5); scr[kk * 33 + (lane & 31)] = W[(size_t)(k0 + kk) * N + n0 + (lane & 31)]; }
    LDS_WAIT(); asm volatile("" ::: "memory");
    const int c = lane & 7;
#pragma unroll
    for (int j = 0; j < 4; ++j) { const int n = (lane >> 3) + 8 * j; const LAS float* s = scr + (8 * c) * 33 + n;
        v4u o; o.x = pk2(s[0 * 33], s[1 * 33]); o.y = pk2(s[2 * 33], s[3 * 33]); o.z = pk2(s[4 * 33], s[5 * 33]); o.w = pk2(s[6 * 33], s[7 * 33]);
        *(GAS v4u*)(WT + (size_t)(n0 + n) * K + k0 + 8 * c) = o; }
    LDS_WAIT(); asm volatile("" ::: "memory");
}
__device__ __forceinline__ void conv_item(const float* src, bf16* dst, size_t item, int lane) {
    const float* s = src + item * 2048; bf16* d = dst + item * 2048;
    f32x4 a[4][2];
#pragma unroll
    for (int j = 0; j < 4; ++j) { a[j][0] = *(const GAS f32x4*)(s + j * 512 + lane * 8); a[j][1] = *(const GAS f32x4*)(s + j * 512 + lane * 8 + 4); }
#pragma unroll
    for (int j = 0; j < 4; ++j) { v4u o; o.x = pk2(a[j][0].x, a[j][0].y); o.y = pk2(a[j][0].z, a[j][0].w); o.z = pk2(a[j][1].x, a[j][1].y); o.w = pk2(a[j][1].z, a[j][1].w);
        *(GAS v4u*)(d + j * 512 + lane * 8) = o; }
}
__device__ __forceinline__ void convert_uv(const Frame& F, const Args& A, int l) {
    const float* us = ain(I_UT) + (size_t)l * NEXP * DM; const float* vs = ain(I_VT) + (size_t)l * NEXP * DM;
    bf16* ud = (bf16*)(F.ws + WS_U); bf16* vd = (bf16*)(F.ws + WS_V);
    for (int it = F.gw; it < 16384; it += F.NGW) { if (it < 8192) conv_item(us, ud, it, F.lane); else conv_item(vs, vd, it - 8192, F.lane); }
}
__device__ __forceinline__ void sincos_d(double a, float& s, float& c) {
    const double n = __builtin_rint(a * 0.63661977236758134308); const double r = a - n * 1.57079632679489661923; const double r2 = r * r;
    double sp = -2.50521083854417187751e-08; sp = sp * r2 + 2.75573192239858906526e-06; sp = sp * r2 - 1.98412698412698412698e-04; sp = sp * r2 + 8.33333333333333333333e-03; sp = sp * r2 - 1.66666666666666666667e-01; sp = sp * r2 * r + r;
    double cp = 2.08767569878680989792e-09; cp = cp * r2 - 2.75573192239858906526e-07; cp = cp * r2 + 2.48015873015873015873e-05; cp = cp * r2 - 1.38888888888888888889e-03; cp = cp * r2 + 4.16666666666666666667e-02; cp = cp * r2 - 0.5; cp = cp * r2 + 1.0;
    const int q = ((int)n) & 3;
    const double ss = (q == 0) ? sp : (q == 1) ? cp : (q == 2) ? -sp : -cp;
    const double cc = (q == 0) ? cp : (q == 1) ? -sp : (q == 2) ? -cp : sp;
    s = (float)ss; c = (float)cc;
}
__device__ __forceinline__ void p0_prologue(const Frame& F, const Args& A) {
    LAS float* scr = (LAS float*)(F.lds + F.wave * 16384);
    constexpr int I_MOD = 768, I_T = 5376, I_SKN = 128, I_RP = 64;
    constexpr int NIT = I_MOD + 2 * I_T + 2 * I_SKN + I_RP;
    for (int it = F.gw; it < NIT; it += F.NGW) {
        int r = it;
        if (r < I_MOD) {
            const int l = r / 384, jb = (r % 384) / 16, ks = r % 16;
            const float* W = ain(I_WMOD) + (size_t)l * DM * INC + (size_t)(ks * 64) * INC + jb * 256 + F.lane * 4;
            const float* cv = ain(I_C) + ks * 64; const float* xv = ain(I_CCTX) + ks * 64;
            f32x4 ac = {0.f, 0.f, 0.f, 0.f}, ax = {0.f, 0.f, 0.f, 0.f};
#pragma unroll 8
            for (int kk = 0; kk < 64; ++kk) { const f32x4 w = *(const GAS f32x4*)(W + (size_t)kk * INC); const float sc = silu_f(cv[kk]), sx = silu_f(xv[kk]); ac += w * sc; ax += w * sx; }
            float* P = (float*)(F.ws + WS_MODP) + ((size_t)(l * 16 + ks) * 2) * INC + jb * 256 + F.lane * 4;
            *(GAS f32x4*)P = ac; *(GAS f32x4*)(P + INC) = ax;
            continue; }
        r -= I_MOD;
        if (r < 2 * I_T) {
            const int l = r / I_T; int q = r % I_T; bf16* wsm = (bf16*)(F.ws + WS_WSM + (size_t)l * WSM_L);
            if (q < 3072) { p0_transpose_item(ain(I_WIN) + (size_t)l * DM * INC, DM, INC, (bf16*)((unsigned char*)wsm + OW_IN), scr, q, F.lane); continue; } q -= 3072;
            if (q < 768) { const int b = q / 256; p0_transpose_item(ain(I_WBR) + ((size_t)l * 3 + b) * 512 * DM, 512, DM, (bf16*)((unsigned char*)wsm + OW_BR) + (size_t)b * DM * 512, scr, q % 256, F.lane); continue; } q -= 768;
            if (q < 512) { p0_transpose_item(ain(I_WOUT) + (size_t)l * DM * DM, DM, DM, (bf16*)((unsigned char*)wsm + OW_OUT), scr, q, F.lane); continue; } q -= 512;
            p0_transpose_item(ain(I_WPQ) + (size_t)l * DM * 2048, DM, 2048, (bf16*)((unsigned char*)wsm + OW_PQ), scr, q, F.lane); continue; }
        r -= 2 * I_T;
        if (r < 2 * I_SKN) { const int l = r / I_SKN; conv_item(ain(I_SK) + (size_t)l * 262144, (bf16*)(F.ws + WS_WSM + (size_t)l * WSM_L + OW_SK), r % I_SKN, F.lane); continue; }
        r -= 2 * I_SKN;
        {
            const int e = r * 64 + F.lane, pos = e >> 4, i = e & 15;
            const float invf = __builtin_amdgcn_exp2f(-(float)i * (13.287712379549449f / 16.0f));
            const float ang = (float)pos * invf; float s, c; sincos_d((double)ang, s, c);
            float* T = (float*)(F.ws + WS_ROPE) + 2 * e; T[0] = c; T[1] = s; }
    }
    convert_uv(F, A, 0);
}
__device__ __forceinline__ void p1_mod_h0(const Frame& F, const Args& A, bf16* H) {
    LAS float* ml = (LAS float*)F.lds;
    const float* MP = (const float*)(F.ws + WS_MODP);
    for (int o = F.tid; o < 4096; o += NTHREADS) { const int v = o >> 11, j = o & 2047; float s = ain(I_BMOD)[j];
#pragma unroll
        for (int ks = 0; ks < 16; ++ks) s += MP[((size_t)ks * 2 + v) * INC + j];
        ml[o] = s; }
    for (int o = F.bx * NTHREADS + F.tid; o < NL * 2 * INC; o += F.G * NTHREADS) { const int l = o / (2 * INC), v = (o / INC) & 1, j = o % INC; float s = ain(I_BMOD)[l * INC + j];
#pragma unroll
        for (int ks = 0; ks < 16; ++ks) s += MP[((size_t)(l * 16 + ks) * 2 + v) * INC + j];
        ((float*)(F.ws + WS_MODV))[o] = s; }
    __syncthreads();
    for (int r = F.gw; r < R; r += F.NGW) {
        const int v = r < NCTX ? 1 : 0; const float* src = r < NCTX ? ain(I_CTX) + (size_t)r * DM : ain(I_X) + (size_t)(r - NCTX) * DM;
#pragma unroll
        for (int j = 0; j < 4; ++j) { const int c = 4 * F.lane + 256 * j; const f32x4 x = *(const GAS f32x4*)(src + c);
            const f32x4 sh = *(const LAS f32x4*)(ml + v * 2048 + c), sc = *(const LAS f32x4*)(ml + v * 2048 + 1024 + c);
            const f32x4 h = x * (sc + 1.0f) + sh; u32x2 w; w.x = pk2(h.x, h.y); w.y = pk2(h.z, h.w); *(GAS u32x2*)(H + (size_t)r * DM + c) = w; }
    }
}
__device__ __forceinline__ void post1_phase(const Frame& F, const Args& A, int l) {
    bf16* G1 = (bf16*)(F.ws + WS_G1); bf16* Y1 = (bf16*)(F.ws + WS_Y) + (size_t)R * 512;
    const float* rope = (const float*)(F.ws + WS_ROPE);
    const float* qn = ain(I_QN) + l * 64; const float* kn = ain(I_KN) + l * 64; const float* cw = ain(I_CONVW) + l * 3 * 512;
    const int j = F.lane & 7, ja = j >> 2, jb = (j >> 1) & 1, ji = (j & 1) * 8;
    for (int r = F.gw; r < R; r += F.NGW) {
        bf16* row = G1 + (size_t)r * INC;
        float cs[8], sn[8];
        if (r >= NCTX) { const int t = r - NCTX, pos = ja ? (t & 63) : (t >> 6); const float* tp = rope + (pos * 16 + ji) * 2;
#pragma unroll
            for (int q = 0; q < 4; ++q) { const f32x4 v = *(const GAS f32x4*)(tp + 4 * q); cs[2 * q] = v.x; sn[2 * q] = v.y; cs[2 * q + 1] = v.z; sn[2 * q + 1] = v.w; } }
        else {
#pragma unroll
            for (int k = 0; k < 8; ++k) { cs[k] = 1.f; sn[k] = 0.f; } }
#pragma unroll
        for (int p = 0; p < 3; ++p) {
            const int hs = p * 8 + (F.lane >> 3); const bool live = hs < 20; const int hh = live ? hs : 19;
            const int base = (hh < 8 ? C_QA + 64 * hh : hh < 10 ? C_KA + 64 * (hh - 8) : hh < 18 ? C_QC + 64 * (hh - 10) : C_KC + 64 * (hh - 18)) + 8 * j;
            const v4u xv = *(const GAS v4u*)(row + base);
            float e[8] = {bflo(xv.x), bfhi(xv.x), bflo(xv.y), bfhi(xv.y), bflo(xv.z), bfhi(xv.z), bflo(xv.w), bfhi(xv.w)};
            if (p < 2) {
                float ss = 0.f;
#pragma unroll
                for (int k = 0; k < 8; ++k) ss += e[k] * e[k];
                ss += __shfl_xor(ss, 1); ss += __shfl_xor(ss, 2); ss += __shfl_xor(ss, 4);
                if (hh < 10) { const float rs = __builtin_amdgcn_rsqf(ss * (1.0f / 64.0f) + RMS_EPS); const float* gn = (hh < 8 ? qn : kn) + 8 * j;
                    const f32x4 g0 = *(const GAS f32x4*)gn, g1 = *(const GAS f32x4*)(gn + 4);
                    e[0] *= rs * g0.x; e[1] *= rs * g0.y; e[2] *= rs * g0.z; e[3] *= rs * g0.w; e[4] *= rs * g1.x; e[5] *= rs * g1.y; e[6] *= rs * g1.z; e[7] *= rs * g1.w; }
            }
            const float qs = (hh < 8 || (hh >= 10 && hh < 18)) ? QSCALE : 1.0f;
            float o[8];
#pragma unroll
            for (int k = 0; k < 8; ++k) { const float pe = __shfl_xor(e[k], 2); o[k] = (jb ? e[k] * cs[k] + pe * sn[k] : e[k] * cs[k] - pe * sn[k]) * qs; }
            if (live) { v4u w; w.x = pk2(o[0], o[1]); w.y = pk2(o[2], o[3]); w.z = pk2(o[4], o[5]); w.w = pk2(o[6], o[7]); *(GAS v4u*)(row + base) = w; }
        }
        const int lo = r < NCTX ? 0 : NCTX, hi = r < NCTX ? NCTX - 1 : R - 1, ch = 8 * F.lane;
        float acc[8];
#pragma unroll
        for (int k = 0; k < 8; ++k) acc[k] = 0.f;
#pragma unroll
        for (int d = 0; d < 3; ++d) { const int rr = r - 1 + d;
            if (rr >= lo && rr <= hi) { const bf16* nr = G1 + (size_t)rr * INC;
                const v4u xb = *(const GAS v4u*)(nr + C_XB + ch), gc = *(const GAS v4u*)(nr + C_GC + ch);
                const f32x4 w0 = *(const GAS f32x4*)(cw + d * 512 + ch), w1 = *(const GAS f32x4*)(cw + d * 512 + ch + 4);
                acc[0] += w0.x * bflo(xb.x) * bflo(gc.x); acc[1] += w0.y * bfhi(xb.x) * bfhi(gc.x); acc[2] += w0.z * bflo(xb.y) * bflo(gc.y); acc[3] += w0.w * bfhi(xb.y) * bfhi(gc.y);
                acc[4] += w1.x * bflo(xb.z) * bflo(gc.z); acc[5] += w1.y * bfhi(xb.z) * bfhi(gc.z); acc[6] += w1.z * bflo(xb.w) * bflo(gc.w); acc[7] += w1.w * bfhi(xb.w) * bfhi(gc.w); } }
        const v4u gb = *(const GAS v4u*)(row + C_GB + ch);
        v4u o; o.x = pk2(acc[0] * bflo(gb.x), acc[1] * bfhi(gb.x)); o.y = pk2(acc[2] * bflo(gb.y), acc[3] * bfhi(gb.y)); o.z = pk2(acc[4] * bflo(gb.z), acc[5] * bfhi(gb.z)); o.w = pk2(acc[6] * bflo(gb.w), acc[7] * bfhi(gb.w));
        *(GAS v4u*)(Y1 + (size_t)r * 512 + ch) = o;
    }
}
__device__ __forceinline__ void ln1_phase(const Frame& F, const Args& A, int l, int row0, bf16* H2) {
    const float* YO = (const float*)(F.ws + WS_YO); float* X = (float*)(F.ws + WS_X); const float* MV = (const float*)(F.ws + WS_MODV) + (size_t)l * 2 * INC;
    const float* lg = ain(I_LN1G) + l * DM; const float* lb = ain(I_LN1B) + l * DM;
    for (int r = row0 + F.gw; r < R; r += F.NGW) {
        const float* mv = MV + (r < NCTX ? INC : 0);
        const float* xin = l == 0 ? (r < NCTX ? ain(I_CTX) + (size_t)r * DM : ain(I_X) + (size_t)(r - NCTX) * DM) : X + (size_t)r * DM;
        f32x4 v[4]; float s = 0.f;
#pragma unroll
        for (int j = 0; j < 4; ++j) { const int c = 4 * F.lane + 256 * j; const f32x4 x = *(const GAS f32x4*)(xin + c), y = *(const GAS f32x4*)(YO + (size_t)r * DM + c), g = *(const GAS f32x4*)(mv + 2048 + c);
            v[j] = x * ALPHA + g * y; s += (v[j].x + v[j].y) + (v[j].z + v[j].w); }
        const float mean = wave_sum(s) * (1.f / DM); float s2 = 0.f;
#pragma unroll
        for (int j = 0; j < 4; ++j) { v[j] = v[j] - mean; s2 += (v[j].x * v[j].x + v[j].y * v[j].y) + (v[j].z * v[j].z + v[j].w * v[j].w); }
        const float rstd = 1.f / sqrtf(wave_sum(s2) * (1.f / DM) + LN_EPS);
#pragma unroll
        for (int j = 0; j < 4; ++j) { const int c = 4 * F.lane + 256 * j; const f32x4 gg = *(const GAS f32x4*)(lg + c), bb = *(const GAS f32x4*)(lb + c);
            const f32x4 x1 = v[j] * rstd * gg + bb; *(GAS f32x4*)(X + (size_t)r * DM + c) = x1;
            const f32x4 sh = *(const GAS f32x4*)(mv + 3072 + c), sc = *(const GAS f32x4*)(mv + 4096 + c);
            const f32x4 h = x1 * (sc + 1.0f) + sh; u32x2 w; w.x = pk2(h.x, h.y); w.y = pk2(h.z, h.w); *(GAS u32x2*)(H2 + (size_t)r * DM + c) = w; }
    }
}
typedef float f32x16 __attribute__((ext_vector_type(16)));
__device__ __forceinline__ void ins16(float (&L)[16], float x) {
#pragma unroll
    for (int j = 0; j < 16; ++j) { const float h = vmaxf(L[j], x); x = vminf(L[j], x); L[j] = h; }
}
__device__ __forceinline__ void bitonic16_desc(float (&T)[16]) {
#pragma unroll
    for (int s = 8; s >= 1; s >>= 1)
#pragma unroll
        for (int i = 0; i < 16; ++i) if ((i & s) == 0) { const float h = vmaxf(T[i], T[i + s]), lo = vminf(T[i], T[i + s]); T[i] = h; T[i + s] = lo; }
}
__device__ __forceinline__ void subkey_top16(const bf16* qrow  , const bf16* keys  , int r32, int hi, float (&S)[16]) {
    bf16x8 qf[8];
#pragma unroll
    for (int ks = 0; ks < 8; ++ks) qf[ks] = *(const GAS bf16x8*)(qrow + ks * 16 + hi * 8);
    float L[16];
#pragma unroll
    for (int j = 0; j < 16; ++j) L[j] = -INFINITY;
#pragma unroll 1
    for (int nb = 0; nb < 4; ++nb) { f32x16 acc = f32x16{};
#pragma unroll
        for (int ks = 0; ks < 8; ++ks) { const bf16x8 kf = *(const GAS bf16x8*)(keys + (size_t)(nb * 32 + r32) * 128 + ks * 16 + hi * 8);
            acc = __builtin_amdgcn_mfma_f32_32x32x16_bf16(kf, qf[ks], acc, 0, 0, 0); }
#pragma unroll
        for (int rg = 0; rg < 16; ++rg) { const unsigned n = (unsigned)(nb * 32 + (rg & 3) + 8 * (rg >> 2) + 4 * hi);
            ins16(L, __uint_as_float((__float_as_uint(acc[rg]) & ~127u) | n)); } }
#pragma unroll
    for (int j = 0; j < 16; ++j) { const float other = __shfl_xor(L[15 - j], 32); S[j] = vmaxf(L[j], other); }
    bitonic16_desc(S);
}
__device__ __forceinline__ void scores_phase(const Frame& F, const Args& A, int l, int row0) {
    const bf16* PQ = (const bf16*)(F.ws + WS_PQ); const bf16* SK = (const bf16*)(F.ws + WS_WSM + (size_t)l * WSM_L + OW_SK);
    int* IDX = (int*)(F.ws + WS_IDX); float* WGT = (float*)(F.ws + WS_WGT);
    const int r32 = F.lane & 31, hi = F.lane >> 5;
    LAS unsigned* myl = (LAS unsigned*)(F.lds + F.wave * 2048 + F.lane * 32);
    const int nitems = ((R - row0) / 32) * 8;
    for (int it = F.gw; it < nitems; it += F.NGW) {
        const int h = it & 7, rb = row0 + (it >> 3) * 32, row = rb + r32;
        float S1[16], S2[16];
        subkey_top16(PQ + (size_t)row * 2048 + h * 256, SK + (size_t)(h * 2) * 16384, r32, hi, S1);
        subkey_top16(PQ + (size_t)row * 2048 + h * 256 + 128, SK + (size_t)(h * 2 + 1) * 16384, r32, hi, S2);
#pragma unroll
        for (int q = 0; q < 4; ++q) {
            myl[q] = (__float_as_uint(S1[4 * q]) & 127u) | ((__float_as_uint(S1[4 * q + 1]) & 127u) << 8) | ((__float_as_uint(S1[4 * q + 2]) & 127u) << 16) | ((__float_as_uint(S1[4 * q + 3]) & 127u) << 24);
            myl[4 + q] = (__float_as_uint(S2[4 * q]) & 127u) | ((__float_as_uint(S2[4 * q + 1]) & 127u) << 8) | ((__float_as_uint(S2[4 * q + 2]) & 127u) << 16) | ((__float_as_uint(S2[4 * q + 3]) & 127u) << 24); }
        float T[16];
#pragma unroll
        for (int j = 0; j < 16; ++j) T[j] = -INFINITY;
#pragma unroll
        for (int a = 0; a < 16; ++a)
#pragma unroll
            for (int b = 0; b < 16; ++b) if ((a + 1) * (b + 1) <= 16) ins16(T, __uint_as_float((__float_as_uint(S1[a] + S2[b]) & ~255u) | (unsigned)(a * 16 + b)));
        const float m = T[0]; float e[16], sum = 0.f;
#pragma unroll
        for (int j = 0; j < 16; ++j) { e[j] = __expf(T[j] - m); sum += e[j]; }
        const float inv = 1.0f / sum;
        LDS_WAIT();
        if (hi == 0) {
            const LAS unsigned char* lb = (const LAS unsigned char*)myl;
            int ex[16];
#pragma unroll
            for (int j = 0; j < 16; ++j) { const unsigned pid = __float_as_uint(T[j]) & 255u; ex[j] = (int)lb[pid >> 4] * 128 + (int)lb[16 + (pid & 15u)]; }
            int* ip = IDX + (size_t)row * 128 + h * 16; float* wp = WGT + (size_t)row * 128 + h * 16;
#pragma unroll
            for (int q = 0; q < 4; ++q) { *(GAS v4u*)(ip + 4 * q) = (v4u){(unsigned)ex[4 * q], (unsigned)ex[4 * q + 1], (unsigned)ex[4 * q + 2], (unsigned)ex[4 * q + 3]};
                *(GAS f32x4*)(wp + 4 * q) = (f32x4){e[4 * q] * inv, e[4 * q + 1] * inv, e[4 * q + 2] * inv, e[4 * q + 3] * inv}; }
        }
        LDS_WAIT();
    }
}
template <bool LAST> __device__ __forceinline__ void peer_phase(const Frame& F, const Args& A, int l, int row0, const bf16* H2, bf16* Hn) {
    const bf16* U = (const bf16*)(F.ws + WS_U); const bf16* V = (const bf16*)(F.ws + WS_V);
    const int* IDX = (const int*)(F.ws + WS_IDX); const float* WGT = (const float*)(F.ws + WS_WGT);
    float* X = (float*)(F.ws + WS_X); const float* MVl = (const float*)(F.ws + WS_MODV) + (size_t)l * 2 * INC; const float* MVn = (const float*)(F.ws + WS_MODV) + (size_t)(LAST ? l : l + 1) * 2 * INC;
    const float* lg = ain(I_LN2G) + l * DM; const float* lb = ain(I_LN2B) + l * DM;
    const int lane = F.lane, c0 = 8 * lane, c1 = 512 + 8 * lane;
    LAS int* idxL = (LAS int*)(F.lds + F.wave * 2048); LAS float* wL = (LAS float*)(F.lds + F.wave * 2048 + 512); LAS float* aL = (LAS float*)(F.lds + F.wave * 2048 + 1024);
    const int jx = (lane >> 3) & 7;
    for (int r = row0 + F.gw; r < R; r += F.NGW) {
        idxL[lane] = IDX[(size_t)r * 128 + lane]; idxL[64 + lane] = IDX[(size_t)r * 128 + 64 + lane];
        wL[lane] = WGT[(size_t)r * 128 + lane]; wL[64 + lane] = WGT[(size_t)r * 128 + 64 + lane];
        const v4u h0 = *(const GAS v4u*)(H2 + (size_t)r * DM + c0), h1 = *(const GAS v4u*)(H2 + (size_t)r * DM + c1);
#pragma unroll 2
        for (int c = 0; c < 16; ++c) {
            float p[8];
#pragma unroll
            for (int e = 0; e < 8; ++e) { const int ei = idxL[c * 8 + e]; const bf16* ur = U + (size_t)ei * DM;
                const v4u u0 = *(const GAS v4u*)(ur + c0), u1 = *(const GAS v4u*)(ur + c1);
                float a0 = dot2bf(u0.x, h0.x, 0.f), a1 = dot2bf(u0.y, h0.y, 0.f); a0 = dot2bf(u0.z, h0.z, a0); a1 = dot2bf(u0.w, h0.w, a1);
                a0 = dot2bf(u1.x, h1.x, a0); a1 = dot2bf(u1.y, h1.y, a1); a0 = dot2bf(u1.z, h1.z, a0); a1 = dot2bf(u1.w, h1.w, a1); p[e] = a0 + a1; }
            { const bool up = (lane & 32) != 0;
#pragma unroll
              for (int i = 0; i < 4; ++i) { const float a = p[i], b = p[i + 4]; p[i] = (up ? b : a) + __shfl_xor(up ? a : b, 32); } }
            { const bool up = (lane & 16) != 0;
#pragma unroll
              for (int i = 0; i < 2; ++i) { const float a = p[i], b = p[i + 2]; p[i] = (up ? b : a) + __shfl_xor(up ? a : b, 16); } }
            { const bool up = (lane & 8) != 0; const float a = p[0], b = p[1]; p[0] = (up ? b : a) + __shfl_xor(up ? a : b, 8); }
            float t = p[0]; t += __shfl_xor(t, 4); t += __shfl_xor(t, 2); t += __shfl_xor(t, 1);
            const float av = gelu_f(t) * wL[c * 8 + jx];
            if ((lane & 7) == 0) aL[c * 8 + jx] = av;
        }
        float f[16];
#pragma unroll
        for (int k = 0; k < 16; ++k) f[k] = 0.f;
#pragma unroll 2
        for (int c = 0; c < 16; ++c) {
#pragma unroll
            for (int e = 0; e < 8; ++e) { const int ei = idxL[c * 8 + e]; const float ae = aL[c * 8 + e]; const bf16* vr = V + (size_t)ei * DM;
                const v4u v0 = *(const GAS v4u*)(vr + c0), v1 = *(const GAS v4u*)(vr + c1);
                f[0] += ae * bflo(v0.x); f[1] += ae * bfhi(v0.x); f[2] += ae * bflo(v0.y); f[3] += ae * bfhi(v0.y); f[4] += ae * bflo(v0.z); f[5] += ae * bfhi(v0.z); f[6] += ae * bflo(v0.w); f[7] += ae * bfhi(v0.w);
                f[8] += ae * bflo(v1.x); f[9] += ae * bfhi(v1.x); f[10] += ae * bflo(v1.y); f[11] += ae * bfhi(v1.y); f[12] += ae * bflo(v1.z); f[13] += ae * bfhi(v1.z); f[14] += ae * bflo(v1.w); f[15] += ae * bfhi(v1.w); }
        }
        const float* mv = MVl + (r < NCTX ? INC : 0);
        float v[16]; float s = 0.f;
#pragma unroll
        for (int hseg = 0; hseg < 2; ++hseg)
#pragma unroll
            for (int q = 0; q < 2; ++q) { const int c = (hseg ? c1 : c0) + 4 * q; const f32x4 x = *(const GAS f32x4*)(X + (size_t)r * DM + c), g2 = *(const GAS f32x4*)(mv + 5120 + c);
#pragma unroll
                for (int k = 0; k < 4; ++k) { const float t = x[k] * ALPHA + g2[k] * f[hseg * 8 + q * 4 + k]; v[hseg * 8 + q * 4 + k] = t; s += t; } }
        const float mean = wave_sum(s) * (1.f / DM); float s2 = 0.f;
#pragma unroll
        for (int k = 0; k < 16; ++k) { v[k] -= mean; s2 += v[k] * v[k]; }
        const float rstd = 1.f / sqrtf(wave_sum(s2) * (1.f / DM) + LN_EPS);
        const float* mn = MVn + (r < NCTX ? INC : 0);
#pragma unroll
        for (int hseg = 0; hseg < 2; ++hseg)
#pragma unroll
            for (int q = 0; q < 2; ++q) { const int c = (hseg ? c1 : c0) + 4 * q; const f32x4 gg = *(const GAS f32x4*)(lg + c), bb = *(const GAS f32x4*)(lb + c);
                f32x4 x2;
#pragma unroll
                for (int k = 0; k < 4; ++k) x2[k] = v[hseg * 8 + q * 4 + k] * rstd * gg[k] + bb[k];
                if (LAST) { *(GAS f32x4*)(aout() + (size_t)(r - NCTX) * DM + c) = x2; }
                else { *(GAS f32x4*)(X + (size_t)r * DM + c) = x2;
                    const f32x4 sh = *(const GAS f32x4*)(mn + c), sc = *(const GAS f32x4*)(mn + 1024 + c); const f32x4 hh = x2 * (sc + 1.0f) + sh;
                    u32x2 w; w.x = pk2(hh.x, hh.y); w.y = pk2(hh.z, hh.w); *(GAS u32x2*)(Hn + (size_t)r * DM + c) = w; } }
    }
}
__device__ __forceinline__ void attn_phase(const Frame& F, const Args& A, int l) {
    using attn_body::AttnJob; typedef attn_body::bf16 abf;
    abf* G1 = (abf*)(F.ws + WS_G1); abf* Y0 = (abf*)(F.ws + WS_Y); abf* Y2 = Y0 + (size_t)2 * R * 512;
    char* shm = (char*)F.lds_g;
    const float* sink = ain(I_SINK) + l * 8;
#define OPAQUE_S(x) asm volatile("" : "+s"(x))
#pragma unroll 1
    for (int i = 0; i < 2; ++i) {
        int vc = F.vcu; OPAQUE_S(vc);
        const int u = 2 * vc + i, kvh = u >> 8, hq = kvh * 4 + ((u >> 6) & 3), qb = u & 63; const size_t row = NCTX + 256 * qb;
        AttnJob J; J.Q = G1 + row * INC + C_QA + hq * 64; J.K = G1 + C_KA + kvh * 64; J.V = G1 + C_VA + kvh * 64; J.O = Y0 + row * 512 + hq * 64;
        J.qp = INC; J.kp = INC; J.op = 512; J.nt = R / 64; J.nt0 = R / 64; J.row1 = 0; J.qpos0 = 0; J.kpos1 = 0; J.sink2 = -INFINITY;
        attn_body::attn_unit<8, 0>(J, shm);
    }
#ifndef AT_ONLYA
#pragma unroll 1
    for (int i = 0; i < 2; ++i) {
        int vc = F.vcu; OPAQUE_S(vc);
        const int u = 2 * vc + i, kvh = u >> 8, hq = kvh * 4 + ((u >> 6) & 3), qb = u & 63; const size_t row = NCTX + 256 * qb;
        const int q0 = 256 * qb, lo = q0 - 128 < 0 ? 0 : q0 - 128, hi = q0 + 384 > SEQ ? SEQ : q0 + 384;
        AttnJob J; J.Q = G1 + row * INC + C_QC + hq * 64; J.K = G1 + C_KC + kvh * 64; J.V = G1 + C_VC + kvh * 64; J.O = Y2 + row * 512 + hq * 64;
        J.qp = INC; J.kp = INC; J.op = 512; J.nt0 = NCTX / 64; J.nt = NCTX / 64 + (hi - lo) / 64; J.row1 = NCTX + lo; J.qpos0 = q0; J.kpos1 = lo; J.sink2 = sink[hq] * LOG2E;
        attn_body::attn_unit<8, 1>(J, shm);
    }
    int vx = F.vcu; OPAQUE_S(vx);
    if (l == 0 && vx < 16) {
        const int hq = vx & 7, kvh = hq >> 2; const bool isc = vx >= 8;
        AttnJob J; J.Q = G1 + (isc ? C_QC : C_QA) + hq * 64; J.K = G1 + (isc ? C_KC : C_KA) + kvh * 64; J.V = G1 + (isc ? C_VC : C_VA) + kvh * 64; J.O = (isc ? Y2 : Y0) + hq * 64;
        J.qp = INC; J.kp = INC; J.op = 512; J.nt = NCTX / 64; J.nt0 = NCTX / 64; J.row1 = 0; J.qpos0 = 0; J.kpos1 = 0; J.sink2 = isc ? sink[hq] * LOG2E : -INFINITY;
        attn_body::attn_unit<8, 0>(J, shm);
    }
#endif
}
constexpr int N_PHASES = 2 + 9 * NL;
__global__ void __launch_bounds__(NTHREADS, 2) mk_fwd(Args A) {
    extern __shared__ __attribute__((aligned(16))) unsigned char lds[];
    Frame F0;
    F0.lds = (LAS unsigned char*)lds; F0.lds_g = lds;
    F0.tid = threadIdx.x; F0.lane = F0.tid & 63; F0.wave = __builtin_amdgcn_readfirstlane(F0.tid >> 6);
    F0.G = gridDim.x; F0.bx = blockIdx.x; F0.vcu = (F0.G % 8 == 0) ? (F0.bx % 8) * (F0.G / 8) + F0.bx / 8 : F0.bx;
    F0.gw = F0.bx * NWAVES + F0.wave; F0.NGW = F0.G * NWAVES; F0.ws = A.ws;
    volatile LAS unsigned* MISC = (volatile LAS unsigned*)(F0.lds + MISC_OFF);
    for (int u = F0.tid; u < (LDS_BYTES - LDSCTL_OFF) / 4; u += NTHREADS) ((LAS unsigned*)(F0.lds + LDSCTL_OFF))[u] = 0u;
    __syncthreads();
    const int lo = A.ph_lo, hi = A.ph_hi;
    XcdBarrier bar; bar.bar = (unsigned*)(A.ws + WS_CTL) + CW_BAR; bar.x = 0; bar.st = nullptr;
    if (hi - lo > 1) bar = xcd_barrier_post((unsigned*)(A.ws + WS_CTL) + CW_BAR, MISC + 8);
#ifndef MK_ONLY
#define MK_ONLY -1
#endif
#ifndef MK_REP
#define MK_REP 0
#endif
#ifndef MK_MASK
#define MK_MASK 0x7ff
#endif
#define ON(k) ((MK_ONLY < 0 || MK_ONLY == (k)) && ((MK_MASK >> (k)) & 1))
#pragma unroll 1
    for (int ph2 = 2 * lo; ph2 < 2 * hi; ++ph2) {
        const int ph = ph2 >> 1;
        if ((ph2 & 1) && !((MK_REP >> ph) & 1)) continue;
        const int l = ph < 2 ? 0 : (ph - 2) / 9, kind = ph < 2 ? ph : 2 + (ph - 2) % 9;
        Frame F = F0;
        asm volatile("" : "+v"(F.tid), "+v"(F.lane)); asm volatile("" : "+s"(F.wave), "+s"(F.bx), "+s"(F.vcu), "+s"(F.gw));
        { GAS unsigned char* wsg = (GAS unsigned char*)F0.ws; asm volatile("" : "+s"(wsg)); F.ws = (unsigned char*)wsg; }
        bf16* HA = (bf16*)(F.ws + WS_HA); bf16* HB = (bf16*)(F.ws + WS_HB);
        bf16* Hin = (l & 1) ? HB : HA; bf16* Hmg = (l & 1) ? HA : HB;
        const int row0 = (l == NL - 1) ? NCTX : 0;
        const int Mr = R - row0, NPr = Mr / 256;
        unsigned char* wsm = F.ws + WS_WSM + (size_t)l * WSM_L;
        switch (kind) {
        case 0: if (ON(0)) { p0_prologue(F, A); } break;
        case 1: if (ON(1)) { p1_mod_h0(F, A, HA); } break;
        case 2: if (ON(2)) {
            pg8::Gemm g{(const pg8::bf16_t*)Hin, (const pg8::bf16_t*)(wsm + OW_IN), R, INC, DM}; pg8::StaticOrder S; S.init(R, INC, F.G, F.bx);
            pg8::EpiBf16<0> E{(pg8::bf16_t*)(F.ws + WS_G1), INC, nullptr, 0, 0, 1.f};
            pg8::gemm_phase<pg8::EpiBf16<0>, pg8::StaticOrder, true, true>(F.lds, g, S, E);
            if (l > 0) convert_uv(F, A, l);
        } break;
        case 3: if (ON(3)) { post1_phase(F, A, l); } break;
        case 4: if (ON(4)) { attn_phase(F, A, l); } break;
        case 5: if (ON(5)) {
            pg8::Gemm g{(const pg8::bf16_t*)(F.ws + WS_Y) + (size_t)row0 * 512, (const pg8::bf16_t*)(wsm + OW_BR), 3 * R, 3072, 512}; pg8::MergeOrder S; S.init(NPr, SPAN, F.G, F.bx);
            pg8::EpiMerge E{(pg8::bf16_t*)Hmg + (size_t)row0 * DM, (const pg8::bf16_t*)(F.ws + WS_G1) + (size_t)row0 * INC + C_GL, INC, SPAN};
            pg8::gemm_phase<pg8::EpiMerge, pg8::MergeOrder, true, true>(F.lds, g, S, E);
        } break;
        case 6: if (ON(6)) {
            pg8::Gemm g{(const pg8::bf16_t*)Hmg + (size_t)row0 * DM, (const pg8::bf16_t*)(wsm + OW_OUT), Mr, DM, DM}; pg8::StaticOrder S; S.init(Mr, DM, F.G, F.bx);
            pg8::EpiF32 E{(float*)(F.ws + WS_YO) + (size_t)row0 * DM, DM};
            pg8::gemm_phase<pg8::EpiF32, pg8::StaticOrder, true, true>(F.lds, g, S, E);
        } break;
        case 7: if (ON(7)) { ln1_phase(F, A, l, row0, Hin); } break;
        case 8: if (ON(8)) {
            pg8::Gemm g{(const pg8::bf16_t*)Hin + (size_t)row0 * DM, (const pg8::bf16_t*)(wsm + OW_PQ), Mr, 2048, DM}; pg8::StaticOrder S; S.init(Mr, 2048, F.G, F.bx);
            pg8::EpiBf16<0> E{(pg8::bf16_t*)(F.ws + WS_PQ) + (size_t)row0 * 2048, 2048, nullptr, 0, 0, 1.f};
            pg8::gemm_phase<pg8::EpiBf16<0>, pg8::StaticOrder, true, true>(F.lds, g, S, E);
        } break;
        case 9: if (ON(9)) { scores_phase(F, A, l, row0); } break;
        default: if (ON(10)) { if (l == NL - 1) peer_phase<true>(F, A, l, row0, Hin, Hmg); else peer_phase<false>(F, A, l, row0, Hin, Hmg); } break;
        }
        const bool more = (ph2 & 1) ? (ph + 1 < hi) : ((ph + 1 < hi) || ((MK_REP >> ph) & 1));
        if (more) { if (A.coop && ph2 == 2 * lo) { cg::this_grid().sync(); } else { xcd_barrier(bar); } }
    }
#undef ON
}
#ifndef MK_MULTI
#define MK_MULTI 0
#endif
extern "C" void kernel_launch(void* const* d_in, const int* in_sizes, int n_in, void* d_out, int out_size, void* d_ws, size_t ws_size, hipStream_t stream) {
    static int grid = 0;
    if (grid == 0) {
        if (n_in != N_IN || out_size != SEQ * DM || ws_size < WS_END) { fprintf(stderr, "kernel_launch: unexpected shapes (n_in %d, out %d, ws %zu)\n", n_in, out_size, ws_size); grid = -1; return; }
        int dev = 0, cus = 0, per_cu = 0;
        if (hipGetDevice(&dev) != hipSuccess || hipDeviceGetAttribute(&cus, hipDeviceAttributeMultiprocessorCount, dev) != hipSuccess) { grid = -1; return; }
        if (hipFuncSetAttribute((const void*)mk_fwd, hipFuncAttributeMaxDynamicSharedMemorySize, LDS_BYTES) != hipSuccess) { grid = -1; return; }
        if (hipOccupancyMaxActiveBlocksPerMultiprocessor(&per_cu, (const void*)mk_fwd, NTHREADS, LDS_BYTES) != hipSuccess || per_cu < 1) { fprintf(stderr, "kernel_launch: occupancy query says %d\n", per_cu); }
        (void)hipGetLastError();
        grid = cus;
    }
    if (grid < 0) return;
    (void)hipMemsetAsync((char*)d_ws + WS_CTL, 0, CTL_ZERO_BYTES, stream);
    Args a{};
    for (int i = 0; i < N_IN; ++i) a.in[i] = (const float*)d_in[i];
    a.out = (float*)d_out; a.ws = (unsigned char*)d_ws;
#if MK_MULTI
    for (int p = 0; p < N_PHASES; ++p) { a.ph_lo = p; a.ph_hi = p + 1; a.coop = 0; hipLaunchKernelGGL(mk_fwd, dim3(grid), dim3(NTHREADS), LDS_BYTES, stream, a); }
#else
    a.ph_lo = 0; a.ph_hi = N_PHASES; a.coop = 1;
    void* args[] = {&a};
    hipError_t e = hipLaunchCooperativeKernel((void*)mk_fwd, dim3(grid), dim3(NTHREADS), args, LDS_BYTES, stream);
    if (e != hipSuccess) fprintf(stderr, "kernel_launch: cooperative launch failed: %s (grid %d)\n", hipGetErrorString(e), grid);
#endif
}
```

```cpp
#include <hip/hip_runtime.h>
#include <hip/hip_bf16.h>
#include <hip/hip_cooperative_groups.h>
#include <cstdio>
#include <cstdint>
#include <cmath>
__device__ __forceinline__ int opq_tid() { int t = threadIdx.x; asm volatile("" : "+v"(t)); return t; }
namespace pg8 {
#define PG8_LAS __attribute__((address_space(3)))
typedef unsigned short bf16_t;
typedef short bf16x8 __attribute__((ext_vector_type(8)));
typedef float f32x4 __attribute__((ext_vector_type(4)));
typedef unsigned u32x4 __attribute__((ext_vector_type(4)));
constexpr int BM = 256, BK = 64, HALF = 128, HTB = HALF * BK * 2  , STAGE_BYTES = 8 * HTB, NXCD = 8, WGM = 8;

__host__ __device__ __forceinline__ int lds_byte(int r, int c) { const int st = (r >> 4) * 2 + (c >> 5), rr = r & 15, cc = c & 31, ob = rr * 64 + cc * 2; return st * 1024 + (ob ^ (((ob >> 9) & 1) << 5)); }
__host__ __device__ __forceinline__ void stage_rc(int b, int& R, int& C) { const int st = b / 1024, sb = b % 1024, swz = sb ^ (((sb >> 9) & 1) << 5); R = (st >> 1) * 16 + swz / 64; C = (st & 1) * 32 + (swz % 64) / 2; }
__host__ __device__ __forceinline__ int perm32(int rho) { const int n = rho >> 4, i = rho & 15; return 8 * (i >> 2) + 4 * n + (i & 3); }

struct Unit { int pm, pn; };
struct Gemm { const bf16_t* A; const bf16_t* Bt; int M, N, K; };

struct StaticOrder {
    int nM, nN, nwg, G, c;
    __host__ __device__ void init(int M, int N, int G_, int c_) { nM = M / BM; nN = N / BM; nwg = nM * nN; G = G_; c = c_; }
    __host__ __device__ bool next(int i, Unit& u) const {
        const long L = (long)i * G + c; if (L >= nwg) return false;
        int wgid = (int)L; { const int q = nwg / NXCD, r = nwg % NXCD, xcd = wgid % NXCD, off = wgid / NXCD; wgid = (xcd < r ? xcd * (q + 1) : r * (q + 1) + (xcd - r) * q) + off; }
        const int nig = WGM * nN, gid = wgid / nig, fm = gid * WGM, gsz = (nM - fm) < WGM ? (nM - fm) : WGM;
        u.pm = fm + ((wgid % nig) % gsz); u.pn = (wgid % nig) / gsz; return true;
    }
    __device__ __forceinline__ void a_ready(const Unit&) const {}
    __device__ __forceinline__ void done(const Unit&) const {}
};

__device__ __forceinline__ unsigned cvt_pk_bf16(float lo, float hi) { unsigned r; asm volatile("v_cvt_pk_bf16_f32 %0, %1, %2" : "=v"(r) : "v"(lo), "v"(hi)); return r; }
typedef float f32x2 __attribute__((ext_vector_type(2)));
__device__ __forceinline__ f32x2 gelu_pk(f32x2 v) {
    const f32x2 av = __builtin_elementwise_abs(v), d = av * 0.2316418882f + 1.0f;
    f32x2 t; t.x = __builtin_amdgcn_rcpf(d.x); t.y = __builtin_amdgcn_rcpf(d.y);
    f32x2 q = t * 0.5307027145f + (-0.7265760135f); q = q * t + 0.7107068705f; q = q * t + (-0.142248368f); q = q * t + 0.127414796f; q = q * t;
    const f32x2 s = (v * v) * (-0.72134752044f);
    f32x2 e; e.x = __builtin_amdgcn_exp2f(s.x); e.y = __builtin_amdgcn_exp2f(s.y);
    const f32x2 m = v * (q * e), r = v - m;
    f32x2 o; o.x = v.x < 0.f ? m.x : r.x; o.y = v.y < 0.f ? m.y : r.y; return o;
}

template <int ACT  > struct EpiBf16 {
    static constexpr bool PERM = true, AFTER_DRAIN = false; static_assert(ACT == 0 || ACT == 1, "EpiBf16: ACT is 0 (none) or 1 (gelu_pk)");
    bf16_t* O; int ldc; const float* bias; int split_cols; size_t split_stride; float scale0;
    __device__ __forceinline__ void operator()(const f32x4 (&acc)[2][2][4][2], const Unit& u, int wr, int wc, int fr, int fq) const {
        const int row0 = u.pm * BM + wr * 64 + fr; int colt = u.pn * BM; bf16_t* base = O;
        float sc = 1.f; if (split_cols) { const int t = colt / split_cols; base += (size_t)t * split_stride; colt -= t * split_cols; if (t == 0) sc = scale0; }
        const int col0 = colt + wc * 32 + 8 * fq, bcol0 = u.pn * BM + wc * 32 + 8 * fq;
        f32x4 bv[2][2];
#pragma unroll
        for (int bj = 0; bj < 2; ++bj)
#pragma unroll
            for (int n = 0; n < 2; ++n) bv[bj][n] = bias ? *(const f32x4*)(bias + bcol0 + bj * HALF + 4 * n) : (f32x4){0.f, 0.f, 0.f, 0.f};
#pragma unroll
        for (int ai = 0; ai < 2; ++ai)
#pragma unroll
            for (int m = 0; m < 4; ++m) { bf16_t* rowp = base + (size_t)(row0 + ai * HALF + m * 16) * ldc + col0;
#pragma unroll
                for (int bj = 0; bj < 2; ++bj) { f32x4 v0 = acc[ai][bj][m][0] + bv[bj][0], v1 = acc[ai][bj][m][1] + bv[bj][1];
                    if (ACT == 1) { f32x2 a = gelu_pk((f32x2){v0[0], v0[1]}), b = gelu_pk((f32x2){v0[2], v0[3]}), c = gelu_pk((f32x2){v1[0], v1[1]}), d = gelu_pk((f32x2){v1[2], v1[3]});
                        v0 = (f32x4){a.x, a.y, b.x, b.y}; v1 = (f32x4){c.x, c.y, d.x, d.y}; }
                    v0 = v0 * sc; v1 = v1 * sc; u32x4 w; w.x = cvt_pk_bf16(v0[0], v0[1]); w.y = cvt_pk_bf16(v0[2], v0[3]); w.z = cvt_pk_bf16(v1[0], v1[1]); w.w = cvt_pk_bf16(v1[2], v1[3]);
                    *(u32x4*)(rowp + bj * HALF) = w; } }
    }
};

struct PanelStats {
    unsigned* xbuf;
    unsigned* cnt;
    unsigned* tmo;
    int ntn; float eps;
    unsigned code;
    __device__ __forceinline__ bool run(const f32x4 (&v)[2][2][4][2], const Unit& u, int wr, int wc, int fr, int fq, PG8_LAS unsigned char* lds, int wid, int lane) const {
        typedef float f32x2v __attribute__((ext_vector_type(2)));
        PG8_LAS f32x2v* P = (PG8_LAS f32x2v*)lds;
        PG8_LAS f32x2v* S = (PG8_LAS f32x2v*)(lds + 8192);
        PG8_LAS unsigned* flag = (PG8_LAS unsigned*)(lds + 8192 + 2048);
#pragma unroll
        for (int ai = 0; ai < 2; ++ai)
#pragma unroll
            for (int m = 0; m < 4; ++m) {
                float s = 0.f;
#pragma unroll
                for (int bj = 0; bj < 2; ++bj)
#pragma unroll
                    for (int n = 0; n < 2; ++n) { const f32x4 x = v[ai][bj][m][n]; s += (x[0] + x[1]) + (x[2] + x[3]); }
                s += __shfl_xor(s, 16); s += __shfl_xor(s, 32);
                const float mw = s * (1.0f / 64.0f); float q = 0.f;
#pragma unroll
                for (int bj = 0; bj < 2; ++bj)
#pragma unroll
                    for (int n = 0; n < 2; ++n) { const f32x4 d = v[ai][bj][m][n] - mw; q += (d[0] * d[0] + d[1] * d[1]) + (d[2] * d[2] + d[3] * d[3]); }
                q += __shfl_xor(q, 16); q += __shfl_xor(q, 32);
                if (fq == 0) P[(ai * HALF + wr * 64 + m * 16 + fr) * 4 + wc] = (f32x2v){mw, q};
            }
        asm volatile("s_waitcnt lgkmcnt(0)" ::: "memory"); __builtin_amdgcn_s_barrier(); asm volatile("" ::: "memory");
#if defined(BROKEN_EXCHANGE_NO_WAIT)
#warning BROKEN CONTROL BUILD: the row-statistics exchange does not wait; results are wrong by design
        if (blockIdx.x >= 64) { const long long t0_ = clock64(); while (clock64() - t0_ < 60000) __builtin_amdgcn_s_sleep(8); }
#endif
        const int row = wid * 32 + (lane & 31);
        if (lane < 32) {
            const f32x2v a = P[row * 4 + 0], b = P[row * 4 + 1], c = P[row * 4 + 2], d = P[row * 4 + 3];
            const float mt = (a.x + b.x + c.x + d.x) * 0.25f;
            const float da = a.x - mt, db = b.x - mt, dc = c.x - mt, dd = d.x - mt;
            const float m2 = (a.y + b.y) + (c.y + d.y) + 64.0f * ((da * da + db * db) + (dc * dc + dd * dd));
            unsigned long long* slot = (unsigned long long*)xbuf + ((size_t)(u.pm * BM + row) * 4 + u.pn);
            __hip_atomic_store(slot, ((unsigned long long)__float_as_uint(m2) << 32) | __float_as_uint(mt), __ATOMIC_RELAXED, __HIP_MEMORY_SCOPE_AGENT);
        }
        asm volatile("s_waitcnt vmcnt(0)" ::: "memory");
        if (lane == 0) __hip_atomic_fetch_add(cnt + 64 * u.pm, 1u, __ATOMIC_RELAXED, __HIP_MEMORY_SCOPE_AGENT);
        if (wid == 0) {
            bool dead = false; const unsigned long long t0 = __builtin_amdgcn_s_memrealtime(); const unsigned want = 8u * (unsigned)ntn;
            for (;;) {
#if defined(BROKEN_EXCHANGE_NO_WAIT)
                break;
#endif
                if ((unsigned)__builtin_amdgcn_readfirstlane(__hip_atomic_load(cnt + 64 * u.pm, __ATOMIC_RELAXED, __HIP_MEMORY_SCOPE_AGENT)) >= want) break;
                if (__builtin_amdgcn_s_memrealtime() - t0 > 2000000ull) {
                    if (lane == 0) { unsigned expect = 0u; __hip_atomic_compare_exchange_strong(tmo + 1, &expect, code | (unsigned)(u.pm & 0xff), __ATOMIC_RELAXED, __ATOMIC_RELAXED, __HIP_MEMORY_SCOPE_AGENT);
                                     __hip_atomic_store(tmo, 1u, __ATOMIC_RELAXED, __HIP_MEMORY_SCOPE_AGENT); }
                    dead = true; break; }
                __builtin_amdgcn_s_sleep(2);
            }
            __builtin_amdgcn_fence(__ATOMIC_ACQUIRE, "agent");
            if (lane == 0) flag[0] = dead ? 1u : 0u;
        }
        asm volatile("s_waitcnt vmcnt(0) lgkmcnt(0)" ::: "memory"); __builtin_amdgcn_s_barrier(); asm volatile("" ::: "memory");
        const bool bad = flag[0] != 0u;
        if (lane < 32) {
            const unsigned long long* slot = (const unsigned long long*)xbuf + (size_t)(u.pm * BM + row) * 4; float mt[4], m2[4]; float ms = 0.f;
#pragma unroll
            for (int t = 0; t < 4; ++t) { if (t < ntn) { const unsigned long long w = __hip_atomic_load(slot + t, __ATOMIC_RELAXED, __HIP_MEMORY_SCOPE_AGENT); mt[t] = __uint_as_float((unsigned)w); m2[t] = __uint_as_float((unsigned)(w >> 32)); } else { mt[t] = 0.f; m2[t] = 0.f; } ms += mt[t]; }
            const float mean = ms / (float)ntn; float q = 0.f;
#pragma unroll
            for (int t = 0; t < 4; ++t) if (t < ntn) { const float dm = mt[t] - mean; q += m2[t] + 256.0f * dm * dm; }
            S[row] = (f32x2v){mean, 1.0f / sqrtf(q / (256.0f * (float)ntn) + eps)};
        }
        asm volatile("s_waitcnt lgkmcnt(0)" ::: "memory"); __builtin_amdgcn_s_barrier(); asm volatile("" ::: "memory");
        return bad;
    }
};
struct EpiLnRes {
    static constexpr bool PERM = false, AFTER_DRAIN = true;
    const float* base; float* out; int ldc; const float* bias; PanelStats st; unsigned poison;
    __device__ __forceinline__ void fused(f32x4 (&acc)[2][2][4][2], const Unit& u, int wr, int wc, int fr, int fq, PG8_LAS unsigned char* lds, int wid, int lane) const {
        typedef float f32x2v __attribute__((ext_vector_type(2)));
        const PG8_LAS f32x2v* S = (const PG8_LAS f32x2v*)(lds + 8192);
        const int col0 = u.pn * BM + wc * 32 + 4 * fq;
#pragma unroll
        for (int bj = 0; bj < 2; ++bj)
#pragma unroll
            for (int n = 0; n < 2; ++n) { const f32x4 bv = bias ? *(const f32x4*)(bias + col0 + bj * HALF + n * 16) : (f32x4){0.f, 0.f, 0.f, 0.f};
#pragma unroll
                for (int ai = 0; ai < 2; ++ai)
#pragma unroll
                    for (int m = 0; m < 4; ++m) acc[ai][bj][m][n] += bv; }
        f32x4 pre[4][2][2];
#pragma unroll
        for (int m = 0; m < 4; ++m) { const size_t off = (size_t)(u.pm * BM + wr * 64 + m * 16 + fr) * ldc + col0;
#pragma unroll
            for (int bj = 0; bj < 2; ++bj)
#pragma unroll
                for (int n = 0; n < 2; ++n) pre[m][bj][n] = *(const f32x4*)(base + off + bj * HALF + n * 16); }
        const bool bad = st.run(acc, u, wr, wc, fr, fq, lds, wid, lane) || poison != 0u;
        const float qnan = __builtin_nanf("");
#pragma unroll
        for (int ai = 0; ai < 2; ++ai)
#pragma unroll
            for (int m = 0; m < 4; ++m) { const int r = ai * HALF + wr * 64 + m * 16 + fr; const f32x2v sr = S[r]; const size_t off = (size_t)(u.pm * BM + r) * ldc + col0;
#pragma unroll
                for (int bj = 0; bj < 2; ++bj)
#pragma unroll
                    for (int n = 0; n < 2; ++n) { const f32x4 bs = ai == 0 ? pre[m][bj][n] : *(const f32x4*)(base + off + bj * HALF + n * 16); f32x4 o = bs + (acc[ai][bj][m][n] - sr.x) * sr.y;
                        if (bad) o = (f32x4){qnan, qnan, qnan, qnan}; *(f32x4*)(out + off + bj * HALF + n * 16) = o; }
                if (m & 1) asm volatile("" ::: "memory"); }
    }
};
struct EpiLnResLn {
    static constexpr bool PERM = false, AFTER_DRAIN = true;
    const float* base; float* out; bf16_t* xn; int ldc; const float* bias; PanelStats st1, st2; unsigned poison;
    __device__ __forceinline__ void fused(f32x4 (&acc)[2][2][4][2], const Unit& u, int wr, int wc, int fr, int fq, PG8_LAS unsigned char* lds, int wid, int lane) const {
        typedef float f32x2v __attribute__((ext_vector_type(2))); typedef unsigned u32x2v __attribute__((ext_vector_type(2)));
        const PG8_LAS f32x2v* S = (const PG8_LAS f32x2v*)(lds + 8192);
        const int col0 = u.pn * BM + wc * 32 + 4 * fq;
#pragma unroll
        for (int bj = 0; bj < 2; ++bj)
#pragma unroll
            for (int n = 0; n < 2; ++n) { const f32x4 bv = bias ? *(const f32x4*)(bias + col0 + bj * HALF + n * 16) : (f32x4){0.f, 0.f, 0.f, 0.f};
#pragma unroll
                for (int ai = 0; ai < 2; ++ai)
#pragma unroll
                    for (int m = 0; m < 4; ++m) acc[ai][bj][m][n] += bv; }
        bool bad = st1.run(acc, u, wr, wc, fr, fq, lds, wid, lane) || poison != 0u;
        const float qnan = __builtin_nanf("");
#pragma unroll
        for (int ai = 0; ai < 2; ++ai)
#pragma unroll
            for (int m = 0; m < 4; ++m) { const int r = ai * HALF + wr * 64 + m * 16 + fr; const f32x2v sr = S[r]; const size_t off = (size_t)(u.pm * BM + r) * ldc + col0;
#pragma unroll
                for (int bj = 0; bj < 2; ++bj)
#pragma unroll
                    for (int n = 0; n < 2; ++n) { const f32x4 bs = *(const f32x4*)(base + off + bj * HALF + n * 16); acc[ai][bj][m][n] = bs + (acc[ai][bj][m][n] - sr.x) * sr.y; }
                asm volatile("" : "+v"(acc[ai][0][m][0]), "+v"(acc[ai][0][m][1]), "+v"(acc[ai][1][m][0]), "+v"(acc[ai][1][m][1]));
                if (m & 1) asm volatile("" ::: "memory"); }
        const bool bad1 = bad;
        bad = st2.run(acc, u, wr, wc, fr, fq, lds, wid, lane) || bad;
#pragma unroll
        for (int ai = 0; ai < 2; ++ai)
#pragma unroll
            for (int m = 0; m < 4; ++m) { const int r = ai * HALF + wr * 64 + m * 16 + fr; const f32x2v sr = S[r]; const size_t off = (size_t)(u.pm * BM + r) * ldc + col0;
#pragma unroll
                for (int bj = 0; bj < 2; ++bj)
#pragma unroll
                    for (int n = 0; n < 2; ++n) { const f32x4 x1 = acc[ai][bj][m][n]; *(f32x4*)(out + off + bj * HALF + n * 16) = bad1 ? (f32x4){qnan, qnan, qnan, qnan} : x1;
                        const f32x4 o = (x1 - sr.x) * sr.y; u32x2v w; w.x = cvt_pk_bf16(o[0], o[1]); w.y = cvt_pk_bf16(o[2], o[3]);
                        if (bad) { w.x = 0x7fc07fc0u; w.y = 0x7fc07fc0u; } *(u32x2v*)(xn + off + bj * HALF + n * 16) = w; }
                asm volatile("" ::: "memory"); }
    }
};

template <class Epi, class Sched, bool ALIGN_EPI = false, bool SP2 = false>
__device__ __forceinline__ void gemm_phase(PG8_LAS unsigned char* lds, const Gemm g, const Sched& S, const Epi& E) {
    const int tid = opq_tid(), wid = __builtin_amdgcn_readfirstlane(tid >> 6), lane = tid & 63, wr = wid >> 2, wc = wid & 3, fr = lane & 15, fq = lane >> 4;
    const int K = g.K, nt = K / BK;
    unsigned voffA[2], voffB[2];
#pragma unroll
    for (int i = 0; i < 2; ++i) { int R, C; stage_rc(tid * 16 + i * 8192, R, C); const int Rb = Epi::PERM ? ((R & ~31) + perm32(R & 31)) : R;
        voffA[i] = (unsigned)(R * K + C) * 2u; voffB[i] = (unsigned)(Rb * K + C) * 2u; }
    const size_t kstep = (size_t)(BK * 2);
    const size_t hstep = (size_t)HALF * K * 2;
    const size_t tstep = 2 * hstep;
    const unsigned ldsw = (unsigned)wid * 1024u;
    const int aoff = lds_byte(wr * 64 + fr, fq * 8), boff = lds_byte(wc * 32 + fr, fq * 8);
#define PG8_SA(b, h) (((b) * 2 + (h)) * HTB)
#define PG8_SB(b, h) ((4 + (b) * 2 + (h)) * HTB)
#define PG8_STAGE(bufoff, gbase, voff) do { _Pragma("unroll") for (int _i = 0; _i < 2; ++_i) \
        __builtin_amdgcn_global_load_lds((const unsigned*)((const char*)(gbase) + (voff)[_i]), (PG8_LAS unsigned*)(lds + (bufoff) + ldsw + _i * 8192), 16, 0, 0); } while (0)
#define PG8_LDA(dst, b, h) do { _Pragma("unroll") for (int m = 0; m < 4; ++m) _Pragma("unroll") for (int k = 0; k < 2; ++k) dst[m][k] = *(const PG8_LAS bf16x8*)(lds + PG8_SA(b, h) + aoff + m * 2048 + k * 1024); } while (0)
#define PG8_LDB(dst, b, h) do { _Pragma("unroll") for (int n = 0; n < 2; ++n) _Pragma("unroll") for (int k = 0; k < 2; ++k) dst[n][k] = *(const PG8_LAS bf16x8*)(lds + PG8_SB(b, h) + boff + n * 2048 + k * 1024); } while (0)
#define PG8_MMA(ai, bj, At, Bt) do { __builtin_amdgcn_s_setprio(1); _Pragma("unroll") for (int m = 0; m < 4; ++m) _Pragma("unroll") for (int n = 0; n < 2; ++n) _Pragma("unroll") for (int k = 0; k < 2; ++k) \
        acc[ai][bj][m][n] = __builtin_amdgcn_mfma_f32_16x16x32_bf16(Bt[n][k], At[m][k], acc[ai][bj][m][n], 0, 0, 0); __builtin_amdgcn_s_setprio(0); } while (0)
#define PG8_WAIT_V(n) asm volatile("s_waitcnt vmcnt(" #n ")" ::: "memory")
#define PG8_WAIT_L(n) asm volatile("s_waitcnt lgkmcnt(" #n ")" ::: "memory")
#define PG8_BAR __builtin_amdgcn_s_barrier()
#define PG8_SCHED __builtin_amdgcn_sched_barrier(0)
    Unit cur, nxt; int ui = 0;
    if (!S.next(0, cur)) return;
    f32x4 acc[2][2][4][2];
#pragma unroll
    for (int a = 0; a < 2; ++a)
#pragma unroll
        for (int b = 0; b < 2; ++b)
#pragma unroll
            for (int m = 0; m < 4; ++m)
#pragma unroll
                for (int n = 0; n < 2; ++n) acc[a][b][m][n] = (f32x4){0.f, 0.f, 0.f, 0.f};
    bf16x8 At[4][2], B0[2][2], B1[2][2];
    const char* cA = (const char*)g.A + (size_t)cur.pm * tstep; const char* cB = (const char*)g.Bt + (size_t)cur.pn * tstep;
    S.a_ready(cur);
    if constexpr (SP2) {
        PG8_STAGE(PG8_SB(0, 0), cB, voffB); PG8_STAGE(PG8_SB(0, 1), cB + hstep, voffB); PG8_STAGE(PG8_SA(0, 0), cA, voffA); PG8_STAGE(PG8_SA(0, 1), cA + hstep, voffA);
        if (wr == 1) PG8_BAR;
        PG8_WAIT_V(2); PG8_BAR;
        PG8_STAGE(PG8_SB(1, 0), cB + kstep, voffB); PG8_STAGE(PG8_SA(1, 0), cA + kstep, voffA); PG8_STAGE(PG8_SB(1, 1), cB + hstep + kstep, voffB);
        PG8_WAIT_V(6); PG8_BAR;
    } else {
        PG8_STAGE(PG8_SB(0, 0), cB, voffB); PG8_STAGE(PG8_SA(0, 0), cA, voffA); PG8_STAGE(PG8_SB(0, 1), cB + hstep, voffB); PG8_STAGE(PG8_SA(0, 1), cA + hstep, voffA);
        if (wr == 1) PG8_BAR;
        PG8_WAIT_V(4); PG8_BAR;
        PG8_STAGE(PG8_SB(1, 0), cB + kstep, voffB); PG8_STAGE(PG8_SA(1, 0), cA + kstep, voffA); PG8_STAGE(PG8_SB(1, 1), cB + hstep + kstep, voffB);
        PG8_WAIT_V(6); PG8_BAR;
    }
    for (;;) {
        const bool has_next = S.next(ui + 1, nxt);
        const char* nA = has_next ? (const char*)g.A + (size_t)nxt.pm * tstep : cA; const char* nB = has_next ? (const char*)g.Bt + (size_t)nxt.pn * tstep : cB;
        for (int t = 0; t < nt; t += 2) {
            const bool last = (t == nt - 2);
            const char* a1 = cA + (size_t)(t + 1) * kstep;
            const char* a2 = last ? nA : cA + (size_t)(t + 2) * kstep; const char* b2 = last ? nB : cB + (size_t)(t + 2) * kstep;
            const char* a3 = a2 + kstep; const char* b3 = b2 + kstep;
            if (last && has_next) S.a_ready(nxt);
            if constexpr (SP2) {
            PG8_LDB(B0, 0, 0); PG8_LDB(B1, 0, 1); PG8_SCHED; PG8_LDA(At, 0, 0); PG8_STAGE(PG8_SA(1, 1), a1 + hstep, voffA);
            PG8_WAIT_V(8); PG8_WAIT_L(0); PG8_BAR; PG8_MMA(0, 0, At, B0); PG8_MMA(0, 1, At, B1); PG8_BAR; PG8_SCHED;
            PG8_LDA(At, 0, 1); PG8_STAGE(PG8_SB(0, 0), b2, voffB); PG8_STAGE(PG8_SB(0, 1), b2 + hstep, voffB); PG8_STAGE(PG8_SA(0, 0), a2, voffA);
            PG8_WAIT_V(8); PG8_WAIT_L(0); PG8_BAR; PG8_MMA(1, 0, At, B0); PG8_MMA(1, 1, At, B1); PG8_BAR; PG8_SCHED;
            PG8_LDB(B0, 1, 0); PG8_LDB(B1, 1, 1); PG8_SCHED; PG8_LDA(At, 1, 0); PG8_STAGE(PG8_SA(0, 1), a2 + hstep, voffA);
            PG8_WAIT_V(8); PG8_WAIT_L(0); PG8_BAR; PG8_MMA(0, 0, At, B0); PG8_MMA(0, 1, At, B1); PG8_BAR; PG8_SCHED;
            PG8_LDA(At, 1, 1); PG8_STAGE(PG8_SB(1, 0), b3, voffB); PG8_STAGE(PG8_SB(1, 1), b3 + hstep, voffB); PG8_STAGE(PG8_SA(1, 0), a3, voffA);
            PG8_WAIT_V(8); PG8_WAIT_L(0); PG8_BAR; PG8_MMA(1, 0, At, B0); PG8_MMA(1, 1, At, B1); PG8_BAR; PG8_SCHED;
            } else {
            PG8_LDB(B0, 0, 0); PG8_SCHED; PG8_LDA(At, 0, 0); PG8_STAGE(PG8_SA(1, 1), a1 + hstep, voffA);
            PG8_WAIT_L(8); PG8_BAR; PG8_WAIT_L(0); PG8_MMA(0, 0, At, B0); PG8_BAR; PG8_SCHED;
            PG8_LDB(B1, 0, 1); PG8_STAGE(PG8_SB(0, 0), b2, voffB);
            PG8_BAR; PG8_WAIT_L(0); PG8_MMA(0, 1, At, B1); PG8_BAR;
            PG8_LDA(At, 0, 1); PG8_STAGE(PG8_SA(0, 0), a2, voffA);
            PG8_BAR; PG8_WAIT_L(0); PG8_MMA(1, 0, At, B0); PG8_BAR; PG8_SCHED;
            PG8_STAGE(PG8_SB(0, 1), b2 + hstep, voffB);
            PG8_WAIT_V(6); PG8_BAR; PG8_MMA(1, 1, At, B1); PG8_BAR;
            PG8_LDB(B0, 1, 0); PG8_SCHED; PG8_LDA(At, 1, 0); PG8_STAGE(PG8_SA(0, 1), a2 + hstep, voffA);
            PG8_WAIT_L(8); PG8_BAR; PG8_WAIT_L(0); PG8_MMA(0, 0, At, B0); PG8_BAR; PG8_SCHED;
            PG8_LDB(B1, 1, 1); PG8_STAGE(PG8_SB(1, 0), b3, voffB);
            PG8_BAR; PG8_WAIT_L(0); PG8_MMA(0, 1, At, B1); PG8_BAR;
            PG8_LDA(At, 1, 1); PG8_STAGE(PG8_SA(1, 0), a3, voffA);
            PG8_BAR; PG8_WAIT_L(0); PG8_MMA(1, 0, At, B0); PG8_BAR; PG8_SCHED;
            PG8_STAGE(PG8_SB(1, 1), b3 + hstep, voffB);
            PG8_WAIT_V(6); PG8_BAR; PG8_MMA(1, 1, At, B1); PG8_BAR;
            }
        }
        if constexpr (ALIGN_EPI) { if (wr == 0) PG8_BAR; }
        if constexpr (!Epi::AFTER_DRAIN) { E(acc, cur, wr, wc, fr, fq); S.done(cur); }
        if (!has_next) break;
#pragma unroll
        for (int a = 0; a < 2; ++a)
#pragma unroll
            for (int b = 0; b < 2; ++b)
#pragma unroll
                for (int m = 0; m < 4; ++m)
#pragma unroll
                    for (int n = 0; n < 2; ++n) acc[a][b][m][n] = (f32x4){0.f, 0.f, 0.f, 0.f};
        cur = nxt; cA = nA; cB = nB; ++ui;
        if constexpr (ALIGN_EPI) { if (wr == 1) PG8_BAR; }
    }
    PG8_WAIT_V(0);
    if constexpr (!ALIGN_EPI) { if (wr == 0) PG8_BAR; }
    PG8_BAR;
    if constexpr (Epi::AFTER_DRAIN) { E.fused(acc, cur, wr, wc, fr, fq, lds, wid, lane); S.done(cur); }
#undef PG8_SA
#undef PG8_SB
#undef PG8_STAGE
#undef PG8_LDA
#undef PG8_LDB
#undef PG8_MMA
#undef PG8_WAIT_V
#undef PG8_WAIT_L
#undef PG8_BAR
#undef PG8_SCHED
}
}
namespace pg8 {
struct EpiF32 {
    static constexpr bool PERM = false, AFTER_DRAIN = false;
    float* C; int ldc;
    __device__ __forceinline__ void operator()(const f32x4 (&acc)[2][2][4][2], const Unit& u, int wr, int wc, int fr, int fq) const {
        const int row0 = u.pm * BM + wr * 64 + fr, col0 = u.pn * BM + wc * 32 + 4 * fq;
#pragma unroll
        for (int ai = 0; ai < 2; ++ai)
#pragma unroll
            for (int m = 0; m < 4; ++m) { float* rowp = C + (size_t)(row0 + ai * HALF + m * 16) * ldc + col0;
#pragma unroll
                for (int bj = 0; bj < 2; ++bj)
#pragma unroll
                    for (int n = 0; n < 2; ++n) *(f32x4*)(rowp + bj * HALF + n * 16) = acc[ai][bj][m][n]; }
    }
};
__device__ __forceinline__ float bf_lo(unsigned w) { return __uint_as_float(w << 16); }
__device__ __forceinline__ float bf_hi(unsigned w) { return __uint_as_float(w & 0xffff0000u); }
__device__ __forceinline__ float sigmoidf_(float x) { return 1.0f / (1.0f + __expf(-x)); }
struct EpiMerge {
    static constexpr bool PERM = true, AFTER_DRAIN = false;
    bf16_t* Mg; const bf16_t* glog; int ldg; int SP;
    __device__ __forceinline__ void operator()(const f32x4 (&acc)[2][2][4][2], const Unit& u, int wr, int wc, int fr, int fq) const {
        const int b = u.pn >> 2, pn = u.pn & 3, pm = u.pm - b * SP;
        const int row0 = pm * BM + wr * 64 + fr, col0 = pn * BM + wc * 32 + 8 * fq;
#pragma unroll
        for (int ai = 0; ai < 2; ++ai)
#pragma unroll
            for (int m = 0; m < 4; ++m) { const size_t row = (size_t)(row0 + ai * HALF + m * 16);
#pragma unroll
                for (int bj = 0; bj < 2; ++bj) { const int col = col0 + bj * HALF;
                    const u32x4 g = *(const u32x4*)(glog + row * ldg + b * 1024 + col);
                    f32x4 v0 = acc[ai][bj][m][0], v1 = acc[ai][bj][m][1];
                    v0[0] *= sigmoidf_(bf_lo(g.x)); v0[1] *= sigmoidf_(bf_hi(g.x)); v0[2] *= sigmoidf_(bf_lo(g.y)); v0[3] *= sigmoidf_(bf_hi(g.y));
                    v1[0] *= sigmoidf_(bf_lo(g.z)); v1[1] *= sigmoidf_(bf_hi(g.z)); v1[2] *= sigmoidf_(bf_lo(g.w)); v1[3] *= sigmoidf_(bf_hi(g.w));
                    u32x4* dst = (u32x4*)(Mg + row * 1024 + col);
                    if (b != 0) { const u32x4 o = *dst;
                        v0[0] += bf_lo(o.x); v0[1] += bf_hi(o.x); v0[2] += bf_lo(o.y); v0[3] += bf_hi(o.y);
                        v1[0] += bf_lo(o.z); v1[1] += bf_hi(o.z); v1[2] += bf_lo(o.w); v1[3] += bf_hi(o.w); }
                    u32x4 w; w.x = cvt_pk_bf16(v0[0], v0[1]); w.y = cvt_pk_bf16(v0[2], v0[3]); w.z = cvt_pk_bf16(v1[0], v1[1]); w.w = cvt_pk_bf16(v1[2], v1[3]);
                    *dst = w; } }
    }
};
struct MergeOrder {
    int NP, SP, nwg, G, c;
    __host__ __device__ void init(int NP_, int SP_, int G_, int c_) { NP = NP_; SP = SP_; nwg = NP_ * 4; G = G_; c = c_; }
    __host__ __device__ bool next(int i, Unit& u) const {
        const int ti = i / 3, b = i - 3 * ti;
        const long L = (long)ti * G + c; if (L >= nwg) return false;
        int wgid = (int)L; { const int q = nwg / NXCD, r = nwg % NXCD, xcd = wgid % NXCD, off = wgid / NXCD; wgid = (xcd < r ? xcd * (q + 1) : r * (q + 1) + (xcd - r) * q) + off; }
        const int nN = 4, nig = WGM * nN, gid = wgid / nig, fm = gid * WGM, gsz = (NP - fm) < WGM ? (NP - fm) : WGM;
        const int pm = fm + ((wgid % nig) % gsz), pn = (wgid % nig) / gsz;
        u.pm = b * SP + pm; u.pn = b * 4 + pn; return true;
    }
    __device__ __forceinline__ void a_ready(const Unit&) const {}
    __device__ __forceinline__ void done(const Unit&) const {}
};
}
#include <hip/hip_bf16.h>
#include <cmath>
namespace attn_body {
using bf16=__hip_bfloat16;
using bf16x8=__attribute__((ext_vector_type(8)))short;
using s16x4=__attribute__((ext_vector_type(4)))short;
using f32x16=__attribute__((ext_vector_type(16)))float;
using u32x4=__attribute__((ext_vector_type(4)))unsigned;
constexpr int D=64;
constexpr int NW=8,QBLK=32,QB=QBLK*NW,KVBLK=64;
constexpr int ATTN_UNIT_ROWS=QB;
__device__ __forceinline__ int crow(int r,int hi){return (r&3)+8*(r>>2)+4*hi;}
#define SBAR() __builtin_amdgcn_sched_barrier(0)
constexpr int WIN=128;
__device__ __forceinline__ void wmask(f32x16&p0,f32x16&p1,int kd){
  const float NEG=-INFINITY;
  #pragma unroll
  for(int r=0;r<16;++r){const int d0=kd+(r&3)+8*(r>>2); if(d0>WIN||d0<-WIN)p0[r]=NEG; const int d1=d0+32; if(d1>WIN||d1<-WIN)p1[r]=NEG;}
}
struct AttnJob {
  const bf16* Q; const bf16* K; const bf16* V; bf16* O;
  int qp, kp, op;
  int nt, nt0, row1;
  int qpos0, kpos1;
  float sink2;
};
constexpr int NSLOT=3, SLOTB=8192;
constexpr int LDS_K=0, LDS_V=NSLOT*SLOTB, LDS_WS=2*NSLOT*SLOTB, LDS_OST=LDS_WS+NW*64*4, LDS_BYTES=LDS_OST+NW*4096;
constexpr float C2=0.125f*1.4426950408889634f;
__device__ __forceinline__ void glds16(const void*gsrc,unsigned lds_dst){unsigned keep;
  asm volatile("s_mov_b32 %0, m0\n\ts_mov_b32 m0, %2\n\ts_nop 0\n\tglobal_load_lds_dwordx4 %1, off\n\ts_mov_b32 m0, %0":"=&s"(keep):"v"(gsrc),"s"(lds_dst):"memory");}
__device__ __forceinline__ float max3f(float a,float b,float c){float r;asm("v_max3_f32 %0, %1, %2, %3":"=v"(r):"v"(a),"v"(b),"v"(c));return r;}
__device__ __forceinline__ float max2f(float a,float b){float r;asm("v_max_f32_e32 %0, %1, %2":"=v"(r):"v"(a),"v"(b));return r;}
__device__ __forceinline__ float fadd_s(float a,float b){float r;asm("v_add_f32_e32 %0, %1, %2":"=v"(r):"v"(a),"v"(b));return r;}
__device__ __forceinline__ float fsub_s(float a,float b){float r;asm("v_sub_f32_e32 %0, %1, %2":"=v"(r):"v"(a),"v"(b));return r;}
typedef float f32x2_t __attribute__((ext_vector_type(2))); typedef __bf16 bf16x2_t __attribute__((ext_vector_type(2)));
__device__ __forceinline__ unsigned cvtpk_s(float lo,float hi){f32x2_t v={lo,hi};bf16x2_t b=__builtin_convertvector(v,bf16x2_t);return __builtin_bit_cast(unsigned,b);}
#define WAIT_BAR(N) asm volatile("s_waitcnt vmcnt(" #N ") lgkmcnt(0)\n\ts_barrier":::"memory")

__device__ __forceinline__ void qkt(f32x16&p0,f32x16&p1,const char*Kslot,const bf16x8*qr,const f32x16&negm,int r32,int hi){
  const char*kb=Kslot+hi*1024+r32*16;
  #pragma unroll
  for(int d0=0;d0<4;++d0){
    const bf16x8 b0=*reinterpret_cast<const bf16x8*>(kb+d0*2048);
    const bf16x8 b1=*reinterpret_cast<const bf16x8*>(kb+d0*2048+512);
    if(d0==0){p0=__builtin_amdgcn_mfma_f32_32x32x16_bf16(b0,qr[0],negm,0,0,0);p1=__builtin_amdgcn_mfma_f32_32x32x16_bf16(b1,qr[0],negm,0,0,0);}
    else{p0=__builtin_amdgcn_mfma_f32_32x32x16_bf16(b0,qr[d0],p0,0,0,0);p1=__builtin_amdgcn_mfma_f32_32x32x16_bf16(b1,qr[d0],p1,0,0,0);}}
}
typedef __attribute__((address_space(3))) const char* lds_cptr;
typedef short v4i16_t __attribute__((ext_vector_type(4)));
__device__ __forceinline__ void kload8(bf16x8*kf,lds_cptr kp){
  kf[0]=*(const __attribute__((address_space(3))) bf16x8*)(kp);      kf[1]=*(const __attribute__((address_space(3))) bf16x8*)(kp+512);
  kf[2]=*(const __attribute__((address_space(3))) bf16x8*)(kp+2048); kf[3]=*(const __attribute__((address_space(3))) bf16x8*)(kp+2560);
  kf[4]=*(const __attribute__((address_space(3))) bf16x8*)(kp+4096); kf[5]=*(const __attribute__((address_space(3))) bf16x8*)(kp+4608);
  kf[6]=*(const __attribute__((address_space(3))) bf16x8*)(kp+6144); kf[7]=*(const __attribute__((address_space(3))) bf16x8*)(kp+6656);
}
__device__ __forceinline__ void kload2(bf16x8*kf,lds_cptr kp,int j){ kf[2*j]=*(const __attribute__((address_space(3))) bf16x8*)(kp+j*2048); kf[2*j+1]=*(const __attribute__((address_space(3))) bf16x8*)(kp+j*2048+512); }
__device__ __forceinline__ s16x4 vtr(lds_cptr p){ return __builtin_bit_cast(s16x4,__builtin_amdgcn_ds_read_tr16_b64_v4i16((__attribute__((address_space(3))) v4i16_t*)p)); }
__device__ __forceinline__ float rowmax(const f32x16&p0,const f32x16&p1){
  float a=max3f(p0[0],p0[1],p1[0]),b=max3f(p0[2],p0[3],p1[1]);a=max3f(a,p1[2],p1[3]);
  #pragma unroll
  for(int r=4;r<16;r+=4){a=max3f(a,p0[r],p0[r+1]);b=max3f(b,p0[r+2],p0[r+3]);a=max3f(a,p1[r],p1[r+1]);b=max3f(b,p1[r+2],p1[r+3]);}
  const float m=max2f(a,b);
  auto rr=__builtin_amdgcn_permlane32_swap(__float_as_uint(m),__float_as_uint(m),false,false);
  return max2f(__uint_as_float(rr[0]),__uint_as_float(rr[1]));
}
__device__ __forceinline__ void pv(f32x16*o,int vb,bf16x8 pa0,bf16x8 pa1,bf16x8 pa2,bf16x8 pa3){
  #pragma unroll
  for(int d0=0;d0<2;++d0){s16x4 lo[4],hi[4];
    #pragma unroll
    for(int ks=0;ks<4;++ks){
      asm volatile("ds_read_b64_tr_b16 %0,%1 offset:%c2":"=&v"(lo[ks]):"v"(vb),"i"(d0*4096+ks*1024):"memory");
      asm volatile("ds_read_b64_tr_b16 %0,%1 offset:%c2":"=&v"(hi[ks]):"v"(vb),"i"(d0*4096+ks*1024+512):"memory");}
    asm volatile("s_waitcnt lgkmcnt(0)":::"memory");SBAR();
    #define PK(k) (bf16x8){lo[k][0],lo[k][1],lo[k][2],lo[k][3],hi[k][0],hi[k][1],hi[k][2],hi[k][3]}
    o[d0]=__builtin_amdgcn_mfma_f32_32x32x16_bf16(pa0,PK(0),o[d0],0,0,0);
    o[d0]=__builtin_amdgcn_mfma_f32_32x32x16_bf16(pa1,PK(1),o[d0],0,0,0);
    o[d0]=__builtin_amdgcn_mfma_f32_32x32x16_bf16(pa2,PK(2),o[d0],0,0,0);
    o[d0]=__builtin_amdgcn_mfma_f32_32x32x16_bf16(pa3,PK(3),o[d0],0,0,0);
    #undef PK
  }
}

#ifndef ATTN_STORE16
#define ATTN_STORE16(p,v) (*(u32x4*)(p)=(v))
#endif
template<int THRL,int MODE> __device__ __forceinline__ void attn_unit(const AttnJob&J,char*shm){
  const int QP=J.qp,KP=J.kp,OP=J.op,NT0=J.nt0,ROW1=J.row1;
  const int tid=opq_tid(),lane=tid&63,r32=lane&31,hi=lane>>5; const int wid=__builtin_amdgcn_readfirstlane(tid>>6);
  const bf16*Qw=J.Q+(long)(wid*QBLK)*QP;
  const bf16*Kh=J.K,*Vh=J.V;
  const unsigned lds0=(unsigned)(uintptr_t)shm;
  float*wsf=(float*)(shm+LDS_WS)+wid*64;
  const bf16*ksrc=Kh+(long)lane*KP+wid*8;
  const bf16*vsrc=Vh+(long)(16*(wid&3)+(lane>>2))*KP+(wid>>2)*32+(lane&3)*8;
  const unsigned kdst=lds0+LDS_K+wid*1024, vdst=lds0+LDS_V+wid*1024;
  #define TROW(t) ((t)<NT0?(t)*KVBLK:ROW1+((t)-NT0)*KVBLK)
  #define DMA_K(t,slot) glds16(ksrc+(long)TROW(t)*KP,(unsigned)__builtin_amdgcn_readfirstlane(kdst+(slot)))
  #define DMA_V(t,slot) glds16(vsrc+(long)TROW(t)*KP,(unsigned)__builtin_amdgcn_readfirstlane(vdst+(slot)))
  const int vb0=(int)(lds0+LDS_V)+((lane>>4)&1)*32+(lane&3)*8+(4*hi+((lane&15)>>2))*64;
  const char*Kbase=shm+LDS_K; bf16x8 kf[8];
  const lds_cptr shm3=(lds_cptr)shm; const lds_cptr kp0=shm3+LDS_K+hi*1024+r32*16; const lds_cptr vp0=shm3+LDS_V+((lane>>4)&1)*32+(lane&3)*8+(4*hi+((lane&15)>>2))*64;
  const int NT=J.nt;
  DMA_K(0,0);DMA_V(0,0);DMA_K(1,SLOTB);
  bf16x8 qr[4];
  #pragma unroll
  for(int d0=0;d0<4;++d0)qr[d0]=*reinterpret_cast<const bf16x8*>(&Qw[(long)r32*QP+d0*16+hi*8]);
  float mhat=0.f,l_reg=0.f;f32x16 o[2];o[0]=f32x16{};o[1]=f32x16{};f32x16 negm=f32x16{};if constexpr(MODE==0)asm volatile("":"+v"(negm));
  const int kd0=J.kpos1+4*hi-(J.qpos0+wid*QBLK+r32);
  #define CMASK(P0,P1,t) do{ if constexpr(MODE==1){ if((t)>=NT0) wmask(P0,P1,kd0+((t)-NT0)*KVBLK); } }while(0)
  bool resc=false;
  #define START(P0,P1) do{ const float rm=rowmax(P0,P1); resc=false; \
    { const float dl=rm; mhat=fadd_s(mhat,dl); \
      _Pragma("unroll") for(int r=0;r<16;++r){P0[r]=fsub_s(P0[r],dl);P1[r]=fsub_s(P1[r],dl);} \
      if constexpr(MODE==0){ _Pragma("unroll") for(int r=0;r<16;++r)negm[r]=-mhat; asm volatile("":"+v"(negm)); } } \
    _Pragma("unroll") for(int r=0;r<16;++r)P0[r]=__builtin_amdgcn_exp2f(P0[r]); }while(0)
  #define RESC() do{ if(resc){ asm volatile("s_waitcnt lgkmcnt(0)":::"memory"); \
      _Pragma("unroll") for(int d_=0;d_<2;++d_) _Pragma("unroll") for(int r=0;r<16;++r)o[d_][r]*=wsf[crow(r,hi)]; } }while(0)
  f32x16 pA0,pA1,pB0,pB1;
  int sl_prev=0,sl_cur=0,sl_next=SLOTB;
  #define ROT() do{sl_prev=sl_cur;sl_cur=sl_next;sl_next=(sl_next==(NSLOT-1)*SLOTB)?0:sl_next+SLOTB;}while(0)
  DMA_K(2,2*SLOTB);
  WAIT_BAR(3);
  qkt(pA0,pA1,Kbase,qr,f32x16{},r32,hi);asm volatile("s_nop 15\n\ts_nop 7":"+v"(pA0),"+v"(pA1));CMASK(pA0,pA1,0);
  START(pA0,pA1);
  _Pragma("unroll") for(int r=0;r<16;++r)pA1[r]=__builtin_amdgcn_exp2f(pA1[r]);
  WAIT_BAR(0);
  DMA_K(3,0);DMA_V(1,SLOTB);
  ROT();
  kload8(kf,kp0+sl_cur);
  WAIT_BAR(2);
  s16x4 vlo[8],vhi[8]; u32x4 pw0,pw1,pw2,pw3;
  #define PKW(P,B) cvtpk_s(P[B],P[B+1])
  #define PAF(k) __builtin_bit_cast(bf16x8,pw##k)
  #define VFR(i) (bf16x8){vlo[i][0],vlo[i][1],vlo[i][2],vlo[i][3],vhi[i][0],vhi[i][1],vhi[i][2],vhi[i][3]}
  #define PIN(x) asm volatile("":"+v"(x))
  #define MX3(a,b,c) __builtin_fmaxf(__builtin_fmaxf((a),(b)),(c))
  #define GAPA(MF,A0,A1,A2,A3,W0,W1,PW) do{ MF; sacc+=A0; sacc+=A1; sacc+=A2; sacc+=A3; PIN(sacc); W0; W1; PIN(PW); SBAR(); }while(0)
  #define EX(v) __builtin_amdgcn_exp2f(MODE==1?(v)-mhat:(v))
  #define CINIT (MODE==1?f32x16{}:negm)
  #define GAPB(MF,X,B) do{ MF; X[B]=EX(X[B]); X[B+1]=EX(X[B+1]); X[B+2]=EX(X[B+2]); X[B+3]=EX(X[B+3]); PIN(X); SBAR(); }while(0)
  #define VRD(i) do{ vlo[i]=vtr(vp_+(((i)>>2)*4096+((i)&3)*1024)); vhi[i]=vtr(vp_+(((i)>>2)*4096+((i)&3)*1024+512)); }while(0)
  #define KRD(G,j) do{ if(G){ kload2(kf,kp0+sl_next,j); SBAR(); } }while(0)
  #define STEP(C0,C1,P0,P1,t,GK,GV,GL) do{ SBAR(); \
    const lds_cptr vp_=vp0+sl_prev; \
    VRD(0); SBAR(); float sacc=(P0[0]+P0[1]); \
    GAPA(C0=__builtin_amdgcn_mfma_f32_32x32x16_bf16(kf[0],qr[0],CINIT,0,0,0), P0[2],P0[3],P0[4],P0[5],     pw0[0]=PKW(P0,0), pw0[1]=PKW(P0,2), pw0); \
    VRD(4); SBAR(); GAPA(C1=__builtin_amdgcn_mfma_f32_32x32x16_bf16(kf[1],qr[0],CINIT,0,0,0), P0[6],P0[7],P0[8],P0[9],     pw0[2]=PKW(P0,4), pw0[3]=PKW(P0,6), pw0); \
    VRD(1); SBAR(); GAPA(C0=__builtin_amdgcn_mfma_f32_32x32x16_bf16(kf[2],qr[1],C0,0,0,0),   P0[10],P0[11],P0[12],P0[13], pw1[0]=PKW(P0,8), pw1[1]=PKW(P0,10), pw1); \
    VRD(5); SBAR(); GAPA(C1=__builtin_amdgcn_mfma_f32_32x32x16_bf16(kf[3],qr[1],C1,0,0,0),   P0[14],P0[15],P1[0],P1[1],   pw1[2]=PKW(P0,12),pw1[3]=PKW(P0,14), pw1); \
    VRD(2); SBAR(); GAPA(C0=__builtin_amdgcn_mfma_f32_32x32x16_bf16(kf[4],qr[2],C0,0,0,0),   P1[2],P1[3],P1[4],P1[5],     pw2[0]=PKW(P1,0), pw2[1]=PKW(P1,2), pw2); \
    VRD(6); SBAR(); GAPA(C1=__builtin_amdgcn_mfma_f32_32x32x16_bf16(kf[5],qr[2],C1,0,0,0),   P1[6],P1[7],P1[8],P1[9],     pw2[2]=PKW(P1,4), pw2[3]=PKW(P1,6), pw2); \
    VRD(3); SBAR(); GAPA(C0=__builtin_amdgcn_mfma_f32_32x32x16_bf16(kf[6],qr[3],C0,0,0,0),   P1[10],P1[11],P1[12],P1[13], pw3[0]=PKW(P1,8), pw3[1]=PKW(P1,10), pw3); \
    VRD(7); SBAR(); GAPA(C1=__builtin_amdgcn_mfma_f32_32x32x16_bf16(kf[7],qr[3],C1,0,0,0),   P1[14],P1[15],0.f,0.f,       pw3[2]=PKW(P1,12),pw3[3]=PKW(P1,14), pw3); \
    l_reg+=sacc; \
    if(GK){DMA_K((t)+3,sl_cur);} if(GV){DMA_V((t)+1,sl_next);} \
    CMASK(C0,C1,t); \
    { float a=MX3(C0[0],C0[1],C1[0]),b=MX3(C0[2],C0[3],C1[1]); a=MX3(a,C1[2],C1[3]); \
      _Pragma("unroll") for(int r=4;r<16;r+=4){a=MX3(a,C0[r],C0[r+1]);b=MX3(b,C0[r+2],C0[r+3]);a=MX3(a,C1[r],C1[r+1]);b=MX3(b,C1[r+2],C1[r+3]);} \
      float rm=__builtin_fmaxf(a,b); { auto rr=__builtin_amdgcn_permlane32_swap(__float_as_uint(rm),__float_as_uint(rm),false,false); rm=__builtin_fmaxf(__uint_as_float(rr[0]),__uint_as_float(rr[1])); } \
      if constexpr(MODE==1) rm-=mhat; \
      resc=false; \
      if(__builtin_expect(__any(rm>(float)THRL),0)){ const float dl=__builtin_fmaxf(rm,0.f); mhat+=dl; \
        if constexpr(MODE==0){ _Pragma("unroll") for(int r=0;r<16;++r){C0[r]-=dl;C1[r]-=dl;} \
        _Pragma("unroll") for(int r=0;r<16;++r)negm[r]=-mhat; asm volatile("":"+v"(negm)); } \
        const float f=__builtin_amdgcn_exp2f(-dl); l_reg*=f; if(hi==0)wsf[r32]=f; resc=true; } } \
    SBAR(); \
    GAPB(o[0]=__builtin_amdgcn_mfma_f32_32x32x16_bf16(PAF(0),VFR(0),o[0],0,0,0), C0,0); \
    GAPB(o[1]=__builtin_amdgcn_mfma_f32_32x32x16_bf16(PAF(0),VFR(4),o[1],0,0,0), C0,4); \
    KRD(GL,0); GAPB(o[0]=__builtin_amdgcn_mfma_f32_32x32x16_bf16(PAF(1),VFR(1),o[0],0,0,0), C0,8); \
    KRD(GL,1); GAPB(o[1]=__builtin_amdgcn_mfma_f32_32x32x16_bf16(PAF(1),VFR(5),o[1],0,0,0), C0,12); \
    KRD(GL,2); GAPB(o[0]=__builtin_amdgcn_mfma_f32_32x32x16_bf16(PAF(2),VFR(2),o[0],0,0,0), C1,0); \
    KRD(GL,3); GAPB(o[1]=__builtin_amdgcn_mfma_f32_32x32x16_bf16(PAF(2),VFR(6),o[1],0,0,0), C1,4); \
    GAPB(o[0]=__builtin_amdgcn_mfma_f32_32x32x16_bf16(PAF(3),VFR(3),o[0],0,0,0), C1,8); \
    GAPB(o[1]=__builtin_amdgcn_mfma_f32_32x32x16_bf16(PAF(3),VFR(7),o[1],0,0,0), C1,12); \
    }while(0)
  int t=1;
  for(;t+5<NT;t+=2){
    STEP(pB0,pB1,pA0,pA1,t,true,true,true);     WAIT_BAR(2); RESC(); ROT();
    STEP(pA0,pA1,pB0,pB1,t+1,true,true,true);   WAIT_BAR(2); RESC(); ROT();
  }
  #define ENDW(tt) do{ if((tt)+3<NT){WAIT_BAR(2);} else if((tt)+2<NT){WAIT_BAR(1);} else {WAIT_BAR(0);} }while(0)
  for(;t+1<NT;t+=2){
    STEP(pB0,pB1,pA0,pA1,t,(t+3<NT),(t+1<NT),(t+1<NT));       ENDW(t);   RESC(); ROT();
    STEP(pA0,pA1,pB0,pB1,t+1,(t+4<NT),(t+2<NT),(t+2<NT));     ENDW(t+1); RESC(); ROT();
  }
  STEP(pB0,pB1,pA0,pA1,NT-1,false,false,false); RESC();
  { float sacc=pB0[0]+pB0[1]; _Pragma("unroll") for(int r=2;r<16;++r)sacc+=pB0[r]; _Pragma("unroll") for(int r=0;r<16;++r)sacc+=pB1[r]; l_reg+=sacc;
    pw0=(u32x4){PKW(pB0,0),PKW(pB0,2),PKW(pB0,4),PKW(pB0,6)};pw1=(u32x4){PKW(pB0,8),PKW(pB0,10),PKW(pB0,12),PKW(pB0,14)};pw2=(u32x4){PKW(pB1,0),PKW(pB1,2),PKW(pB1,4),PKW(pB1,6)};pw3=(u32x4){PKW(pB1,8),PKW(pB1,10),PKW(pB1,12),PKW(pB1,14)};
    SBAR(); pv(o,vb0+sl_cur,PAF(0),PAF(1),PAF(2),PAF(3)); }
  #undef PKW
  #undef PAF
  #undef VFR
  #undef PIN
  #undef MX3
  #undef GAPA
  #undef GAPB
  #undef EX
  #undef CINIT
  #undef VRD
  #undef KRD
  #undef STEP
  #undef ENDW
  {auto rr=__builtin_amdgcn_permlane32_swap(__float_as_uint(l_reg),__float_as_uint(l_reg),false,false);l_reg=__uint_as_float(rr[0])+__uint_as_float(rr[1]);}
  l_reg+=__builtin_amdgcn_exp2f(J.sink2-mhat);
  if(hi==0)wsf[32+r32]=l_reg;asm volatile("s_waitcnt lgkmcnt(0)":::"memory");
  float rli[16];
  #pragma unroll
  for(int r=0;r<16;++r)rli[r]=__builtin_amdgcn_rcpf(wsf[32+crow(r,hi)]);
  bf16*Ow=J.O+(long)(wid*QBLK)*OP;
  { bf16*stg=(bf16*)(shm+LDS_OST)+wid*2048;
    #pragma unroll
    for(int r=0;r<16;++r){const int orow=crow(r,hi);
      #pragma unroll
      for(int d0=0;d0<2;++d0)stg[orow*64+d0*32+r32]=__float2bfloat16(o[d0][r]*rli[r]);}
    asm volatile("s_waitcnt lgkmcnt(0)":::"memory");
    #pragma unroll
    for(int i=0;i<4;++i){const int row=i*8+(lane>>3),ch=lane&7; const u32x4 v=*(const u32x4*)(stg+row*64+ch*8); ATTN_STORE16(Ow+(long)row*OP+ch*8,v);} }
  asm volatile("s_waitcnt lgkmcnt(0)\n\ts_barrier":::"memory");
  #undef TROW
  #undef DMA_K
  #undef DMA_V
  #undef CMASK
  #undef START
  #undef RESC
  #undef ROT
}
constexpr int ATTN_LDS_BYTES=LDS_BYTES;
#undef SBAR
#undef WAIT_BAR
}
#define GAS __attribute__((address_space(1)))
#define LAS __attribute__((address_space(3)))
typedef unsigned short bf16;
typedef unsigned v4u __attribute__((ext_vector_type(4)));
typedef float f32x4 __attribute__((ext_vector_type(4)));
typedef short bf16x8 __attribute__((ext_vector_type(8)));
typedef GAS unsigned gu32;
typedef GAS unsigned long long gu64;
#define RLX_AGENT __ATOMIC_RELAXED, __HIP_MEMORY_SCOPE_AGENT
#define LDS_WAIT() asm volatile("s_waitcnt lgkmcnt(0)" ::: "memory")
#define VM_WAIT() asm volatile("s_waitcnt vmcnt(0)" ::: "memory")
__device__ __forceinline__ unsigned long long rt() { return __builtin_amdgcn_s_memrealtime(); }
__device__ __forceinline__ unsigned f2bf(float f) { unsigned u = __builtin_bit_cast(unsigned, f); return (u + 0x7fffu + ((u >> 16) & 1u)) >> 16; }
__device__ __forceinline__ unsigned pk2(float lo, float hi) { return f2bf(lo) | (f2bf(hi) << 16); }

#define XB_TMO      128
#define XB_XCNT(j)  (256  + 64 * (j))
#define XB_XSUB(j)  (1280 + 64 * (j))
#define XB_XGEN(j)  (2304 + 64 * (j))
#define XB_TOP      3328
#define XB_TOPGEN   3392
#define XCD_BAR_WORDS 3456
#define XB_SPIN_CAP (1u << 18)

__device__ __forceinline__ unsigned xb_ld(unsigned* p)              { return __hip_atomic_load(p, __ATOMIC_RELAXED, __HIP_MEMORY_SCOPE_AGENT); }
__device__ __forceinline__ unsigned xb_add(unsigned* p, unsigned v) { return __hip_atomic_fetch_add(p, v, __ATOMIC_RELAXED, __HIP_MEMORY_SCOPE_AGENT); }
__device__ __forceinline__ unsigned xb_xcc_id() { return (unsigned)__builtin_amdgcn_s_getreg((3 << 11) | 20) & 0xFu; }
#define XB_SPIN(cond, bar) do { unsigned _sp = 0; while (cond) { __builtin_amdgcn_s_sleep(1); \
    if ((++_sp & 255u) == 0u) { if (xb_ld(&(bar)[XB_TMO])) break; if (_sp > XB_SPIN_CAP) { atomicAdd(&(bar)[XB_TMO], 1u); break; } } } } while (0)

struct XcdBarrier {
    unsigned* bar; unsigned x;
    volatile LAS unsigned* st;
};

__device__ __forceinline__ XcdBarrier xcd_barrier_post(unsigned* bar, volatile LAS unsigned* st) {
    XcdBarrier b; b.bar = bar; b.x = xb_xcc_id(); b.st = st;
    if (opq_tid() == 0) (void)xb_add(&bar[XB_XCNT(b.x)], 1u);
    return b;
}
__device__ __forceinline__ void xcd_barrier_complete(unsigned* bar, unsigned x, unsigned& nloc, unsigned& nx) {
    const unsigned G = gridDim.x * gridDim.y * gridDim.z;
    unsigned sum, cnt, mine, sp = 0u;
    for (;;) {
        sum = 0u; cnt = 0u; mine = 0u;
#pragma unroll
        for (unsigned j = 0; j < 16; ++j) { const unsigned c = xb_ld(&bar[XB_XCNT(j)]); sum += c; cnt += (c > 0u) ? 1u : 0u; mine = (j == x) ? c : mine; }
        if (sum == G) break;
        __builtin_amdgcn_s_sleep(1);
        if ((++sp & 255u) == 0u) { if (xb_ld(&bar[XB_TMO])) break; if (sp > XB_SPIN_CAP) { atomicAdd(&bar[XB_TMO], 1u); break; } }
    }
    nloc = mine > 0u ? mine : 1u; nx = cnt > 0u ? cnt : 1u;
}

__device__ __forceinline__ void xcd_barrier(const XcdBarrier& b) {
    asm volatile("s_waitcnt vmcnt(0)" ::: "memory");
    __syncthreads();
    if (opq_tid() == 0) {
        GAS unsigned* barg = (GAS unsigned*)b.bar; unsigned bxx = b.x; asm volatile("" : "+s"(barg), "+s"(bxx)); unsigned* bar = (unsigned*)barg;
        __builtin_amdgcn_s_waitcnt(0);
        unsigned nloc = b.st[0], nx = b.st[1];
        if (nloc == 0u) { xcd_barrier_complete(bar, bxx, nloc, nx); b.st[0] = nloc; b.st[1] = nx; }
        const unsigned old = xb_add(&bar[XB_XSUB(bxx)], 1u);
        const unsigned gen = old / nloc;
        if (old + 1u == (gen + 1u) * nloc) {
            __builtin_amdgcn_fence(__ATOMIC_RELEASE, "agent");
            asm volatile("s_waitcnt vmcnt(0)" ::: "memory");
            const unsigned og = xb_add(&bar[XB_TOP], 1u);
            const unsigned tg = og / nx;
            if (og + 1u == (tg + 1u) * nx) xb_add(&bar[XB_TOPGEN], 1u);
            else XB_SPIN(xb_ld(&bar[XB_TOPGEN]) == tg, bar);
            __builtin_amdgcn_fence(__ATOMIC_ACQUIRE, "agent");
            xb_add(&bar[XB_XGEN(bxx)], 1u);
            asm volatile("s_waitcnt vmcnt(0)" ::: "memory");
        } else {
            XB_SPIN(xb_ld(&bar[XB_XGEN(bxx)]) == gen, bar);
            __builtin_amdgcn_fence(__ATOMIC_ACQUIRE, "agent");
            asm volatile("s_waitcnt vmcnt(0)" ::: "memory");
        }
    }
    __syncthreads();
}
namespace cg = cooperative_groups;
constexpr int NWAVES = 8, NTHREADS = 512;
constexpr int R = 16640, NCTX = 256, SEQ = 16384, DM = 1024, INC = 6144, NL = 2, NEXP = 16384, SPAN = 65;
constexpr float ALPHA = 1.41421356237f, LN_EPS = 1e-6f, RMS_EPS = 1e-6f, LOG2E = 1.4426950408889634f;
constexpr float QSCALE = 0.125f * 1.4426950408889634f;
constexpr int C_QA = 0, C_KA = 512, C_VA = 640, C_QC = 768, C_KC = 1280, C_VC = 1408, C_XB = 1536, C_GB = 2048, C_GC = 2560, C_GL = 3072;
enum { I_X = 0, I_C, I_CTX, I_CCTX, I_WMOD, I_BMOD, I_WIN, I_QN, I_KN, I_CONVW, I_SINK, I_WBR, I_WOUT, I_LN1G, I_LN1B, I_WPQ, I_SK, I_UT, I_VT, I_LN2G, I_LN2B, N_IN };
constexpr size_t MiB = 1u << 20;
constexpr size_t WS_CTL = 0, CTL_ZERO_BYTES = 1 * MiB;
constexpr size_t WS_MODP = 1 * MiB;
constexpr size_t WS_MODV = WS_MODP + 1536 * 1024;
constexpr size_t WS_ROPE = WS_MODV + 128 * 1024;
constexpr size_t WS_WSM = 3 * MiB, WSM_L = 22 * MiB;
constexpr size_t OW_IN = 0, OW_BR = 12 * MiB, OW_OUT = 15 * MiB, OW_PQ = 17 * MiB, OW_SK = 21 * MiB;
constexpr size_t WS_U = WS_WSM + 2 * WSM_L, WS_V = WS_U + 32 * MiB;
constexpr size_t WS_X = WS_V + 32 * MiB;
constexpr size_t WS_G1 = WS_X + 65 * MiB;
constexpr size_t WS_YO = WS_G1, WS_PQ = WS_G1 + 65 * MiB, WS_IDX = WS_G1 + 130 * MiB, WS_WGT = WS_G1 + 139 * MiB;
constexpr size_t WS_HA = WS_G1 + 195 * MiB, WS_HB = WS_HA + 33 * MiB;
constexpr size_t WS_Y = WS_HB + 33 * MiB;
constexpr size_t WS_END = WS_Y + 49 * MiB;
static_assert(WS_END <= 512 * MiB, "d_ws map");
constexpr int CW_BAR = 4096;
constexpr int RING_BYTES = 131072, LDSCTL_OFF = RING_BYTES, MISC_OFF = LDSCTL_OFF + 320, LDS_BYTES = 147456;
typedef __bf16 bf16x2_t __attribute__((ext_vector_type(2)));
typedef unsigned u32x2 __attribute__((ext_vector_type(2)));

struct Args { const float* in[N_IN]; float* out; unsigned char* ws; int ph_lo, ph_hi, coop, pad; };

__device__ __forceinline__ float wave_sum(float v) {
#pragma unroll
    for (int o = 1; o < 64; o <<= 1) v += __shfl_xor(v, o);
    return v;
}
__device__ __forceinline__ float bflo(unsigned w) { return __uint_as_float(w << 16); }
__device__ __forceinline__ float bfhi(unsigned w) { return __uint_as_float(w & 0xffff0000u); }
__device__ __forceinline__ float bf1(bf16 h) { return __uint_as_float((unsigned)h << 16); }
__device__ __forceinline__ float dot2bf(unsigned w, unsigned x, float acc) { return __builtin_amdgcn_fdot2_f32_bf16(__builtin_bit_cast(bf16x2_t, w), __builtin_bit_cast(bf16x2_t, x), acc, false); }
typedef float f32x2 __attribute__((ext_vector_type(2)));
__device__ __forceinline__ unsigned fp8lo(unsigned w) { return __builtin_bit_cast(unsigned, __builtin_amdgcn_cvt_scalef32_pk_bf16_fp8((int)w, 1.0f, false)); }
__device__ __forceinline__ unsigned fp8hi(unsigned w) { return __builtin_bit_cast(unsigned, __builtin_amdgcn_cvt_scalef32_pk_bf16_fp8((int)w, 1.0f, true)); }
__device__ __forceinline__ float silu_f(float x) { return x / (1.0f + __expf(-x)); }
__device__ __forceinline__ float gelu_f(float v) {
    const float av = fabsf(v), t = __builtin_amdgcn_rcpf(av * 0.2316418882f + 1.0f);
    float q = t * 0.5307027145f + (-0.7265760135f); q = q * t + 0.7107068705f; q = q * t + (-0.142248368f); q = q * t + 0.127414796f; q = q * t;
    const float e = __builtin_amdgcn_exp2f((v * v) * (-0.72134752044f));
    const float m = v * (q * e);
    return v < 0.f ? m : v - m;
}
__device__ __forceinline__ float vmaxf(float a, float b) { float r; asm("v_max_f32_e32 %0, %1, %2" : "=v"(r) : "v"(a), "v"(b)); return r; }
__device__ __forceinline__ float vminf(float a, float b) { float r; asm("v_min_f32_e32 %0, %1, %2" : "=v"(r) : "v"(a), "v"(b)); return r; }

typedef const __attribute__((address_space(4))) unsigned long long* kargp_t;
__device__ __forceinline__ const float* ain(int k) { kargp_t p = (kargp_t)__builtin_amdgcn_kernarg_segment_ptr(); return (const float*)(const GAS float*)(*(volatile kargp_t)(p + k)); }
__device__ __forceinline__ float* aout() { kargp_t p = (kargp_t)__builtin_amdgcn_kernarg_segment_ptr(); return (float*)(GAS float*)(*(volatile kargp_t)(p + N_IN)); }
struct Frame {
    LAS unsigned char* lds; unsigned char* lds_g;
    int tid, lane, wave, G, bx, vcu, gw, NGW;
    const float* in[N_IN]; float* out; unsigned char* ws;
};
__device__ __forceinline__ void p0_transpose_item(const float* W, int K, int N, bf16* WT, LAS float* scr, int item, int lane) {
    const int nblk = N / 32, kb = item / nblk, nb = item % nblk, k0 = 64 * kb, n0 = 32 * nb;
#pragma unroll 8
    for (int i = 0; i < 32; ++i) { const int kk = 2 * i + (lane >> 5); scr[kk * 33 + (lane & 31)] = W[(size_t)(k0 + kk) * N + n0 + (lane & 31)]; }
    LDS_WAIT(); asm volatile("" ::: "memory");
    const int c = lane & 7;
#pragma unroll
    for (int j = 0; j < 4; ++j) { const int n = (lane >> 3) + 8 * j; const LAS float* s = scr + (8 * c) * 33 + n;
        v4u o; o.x = pk2(s[0 * 33], s[1 * 33]); o.y = pk2(s[2 * 33], s[3 * 33]); o.z = pk2(s[4 * 33], s[5 * 33]); o.w = pk2(s[6 * 33], s[7 * 33]);
        *(GAS v4u*)(WT + (size_t)(n0 + n) * K + k0 + 8 * c) = o; }
    LDS_WAIT(); asm volatile("" ::: "memory");
}
__device__ __forceinline__ void conv_item(const float* src, bf16* dst, size_t item, int lane) {
    const float* s = src + item * 2048; bf16* d = dst + item * 2048;
    f32x4 a[4][2];
#pragma unroll
    for (int j = 0; j < 4; ++j) { a[j][0] = *(const GAS f32x4*)(s + j * 512 + lane * 8); a[j][1] = *(const GAS f32x4*)(s + j * 512 + lane * 8 + 4); }
#pragma unroll
    for (int j = 0; j < 4; ++j) { v4u o; o.x = pk2(a[j][0].x, a[j][0].y); o.y = pk2(a[j][0].z, a[j][0].w); o.z = pk2(a[j][1].x, a[j][1].y); o.w = pk2(a[j][1].z, a[j][1].w);
        *(GAS v4u*)(d + j * 512 + lane * 8) = o; }
}
__device__ __forceinline__ void convert_uv(const Frame& F, const Args& A, int l) {
    const float* us = ain(I_UT) + (size_t)l * NEXP * DM; const float* vs = ain(I_VT) + (size_t)l * NEXP * DM;
    for (int it = F.gw; it < 2 * NEXP; it += F.NGW) {
        const bool isv = it >= NEXP; const int row = isv ? it - NEXP : it;
        const float* src = (isv ? vs : us) + (size_t)row * DM + 16 * F.lane; unsigned char* tab = F.ws + (isv ? WS_V : WS_U);
        f32x4 x[4]; float am = 0.f;
#pragma unroll
        for (int q = 0; q < 4; ++q) { x[q] = *(const GAS f32x4*)(src + 4 * q); am = fmaxf(am, fmaxf(fmaxf(fabsf(x[q].x), fabsf(x[q].y)), fmaxf(fabsf(x[q].z), fabsf(x[q].w)))); }
#pragma unroll
        for (int o = 1; o < 64; o <<= 1) am = fmaxf(am, __shfl_xor(am, o));
        const int E = (int)((__float_as_uint(am) >> 23) & 255u) - 127;
        const int se = am > 0.f ? 7 - E : 0;
        const int sec = se > 120 ? 120 : (se < -120 ? -120 : se);
        const float sc = __uint_as_float((unsigned)(127 + sec) << 23), isc = __uint_as_float((unsigned)(127 - sec) << 23);
        v4u o; unsigned* op = (unsigned*)&o;
#pragma unroll
        for (int q = 0; q < 4; ++q) { int w = __builtin_amdgcn_cvt_pk_fp8_f32(x[q].x * sc, x[q].y * sc, 0, false); w = __builtin_amdgcn_cvt_pk_fp8_f32(x[q].z * sc, x[q].w * sc, w, true); op[q] = (unsigned)w; }
        *(GAS v4u*)(tab + (size_t)row * DM + 16 * F.lane) = o;
        if (F.lane == 0) ((float*)(tab + 16 * MiB))[row] = isc;
    }
}
__device__ __forceinline__ void sincos_f(float a, float& s, float& c) {
    const float n = __builtin_rintf(a * 0.636619772367581343f);
    float r = __builtin_fmaf(n, -1.5703125f, a); r = __builtin_fmaf(n, -4.837512969970703125e-4f, r); r = __builtin_fmaf(n, -7.54978995489188216e-8f, r);
    const float r2 = r * r;
    float sp = 2.75573192e-6f; sp = __builtin_fmaf(sp, r2, -1.98412698e-4f); sp = __builtin_fmaf(sp, r2, 8.33333333e-3f); sp = __builtin_fmaf(sp, r2, -1.66666667e-1f); sp = __builtin_fmaf(sp * r2, r, r);
    float cp = -2.75573192e-7f; cp = __builtin_fmaf(cp, r2, 2.48015873e-5f); cp = __builtin_fmaf(cp, r2, -1.38888889e-3f); cp = __builtin_fmaf(cp, r2, 4.16666667e-2f); cp = __builtin_fmaf(cp, r2, -0.5f); cp = __builtin_fmaf(cp, r2, 1.0f);
    const int q = ((int)n) & 3;
    s = (q == 0) ? sp : (q == 1) ? cp : (q == 2) ? -sp : -cp;
    c = (q == 0) ? cp : (q == 1) ? -sp : (q == 2) ? -cp : sp;
}
__device__ __forceinline__ void p0_prologue(const Frame& F, const Args& A) {
    LAS float* scr = (LAS float*)(F.lds + F.wave * 16384);
    constexpr int I_MOD = 768, I_T = 5376, I_SKN = 128, I_RP = 64;
    constexpr int NIT = I_MOD + 2 * I_T + 2 * I_SKN + I_RP;
    for (int it = F.gw; it < NIT; it += F.NGW) {
        int r = it;
        if (r < I_MOD) {
            const int l = r / 384, jb = (r % 384) / 16, ks = r % 16;
            const float* W = ain(I_WMOD) + (size_t)l * DM * INC + (size_t)(ks * 64) * INC + jb * 256 + F.lane * 4;
            const float* cv = ain(I_C) + ks * 64; const float* xv = ain(I_CCTX) + ks * 64;
            f32x4 ac = {0.f, 0.f, 0.f, 0.f}, ax = {0.f, 0.f, 0.f, 0.f};
#pragma unroll 8
            for (int kk = 0; kk < 64; ++kk) { const f32x4 w = *(const GAS f32x4*)(W + (size_t)kk * INC); const float sc = silu_f(cv[kk]), sx = silu_f(xv[kk]); ac += w * sc; ax += w * sx; }
            float* P = (float*)(F.ws + WS_MODP) + ((size_t)(l * 16 + ks) * 2) * INC + jb * 256 + F.lane * 4;
            *(GAS f32x4*)P = ac; *(GAS f32x4*)(P + INC) = ax;
            continue; }
        r -= I_MOD;
        if (r < 2 * I_T) {
            const int l = r / I_T; int q = r % I_T; bf16* wsm = (bf16*)(F.ws + WS_WSM + (size_t)l * WSM_L);
            if (q < 3072) { p0_transpose_item(ain(I_WIN) + (size_t)l * DM * INC, DM, INC, (bf16*)((unsigned char*)wsm + OW_IN), scr, q, F.lane); continue; } q -= 3072;
            if (q < 768) { const int b = q / 256; p0_transpose_item(ain(I_WBR) + ((size_t)l * 3 + b) * 512 * DM, 512, DM, (bf16*)((unsigned char*)wsm + OW_BR) + (size_t)b * DM * 512, scr, q % 256, F.lane); continue; } q -= 768;
            if (q < 512) { p0_transpose_item(ain(I_WOUT) + (size_t)l * DM * DM, DM, DM, (bf16*)((unsigned char*)wsm + OW_OUT), scr, q, F.lane); continue; } q -= 512;
            p0_transpose_item(ain(I_WPQ) + (size_t)l * DM * 2048, DM, 2048, (bf16*)((unsigned char*)wsm + OW_PQ), scr, q, F.lane); continue; }
        r -= 2 * I_T;
        if (r < 2 * I_SKN) { const int l = r / I_SKN; conv_item(ain(I_SK) + (size_t)l * 262144, (bf16*)(F.ws + WS_WSM + (size_t)l * WSM_L + OW_SK), r % I_SKN, F.lane); continue; }
        r -= 2 * I_SKN;
        {
            const int e = r * 64 + F.lane, pos = e >> 4, i = e & 15;
            const float invf = __builtin_amdgcn_exp2f(-(float)i * (13.287712379549449f / 16.0f));
            const float ang = (float)pos * invf; float s, c; sincos_f(ang, s, c);
            float* T = (float*)(F.ws + WS_ROPE) + 2 * e; T[0] = c; T[1] = s; }
    }
    convert_uv(F, A, 0);
}
__device__ __forceinline__ void p1_mod_h0(const Frame& F, const Args& A, bf16* H) {
    LAS float* ml = (LAS float*)F.lds;
    const float* MP = (const float*)(F.ws + WS_MODP);
    for (int o = F.tid; o < 4096; o += NTHREADS) { const int v = o >> 11, j = o & 2047; float s = ain(I_BMOD)[j];
#pragma unroll
        for (int ks = 0; ks < 16; ++ks) s += MP[((size_t)ks * 2 + v) * INC + j];
        ml[o] = s; }
    for (int o = F.bx * NTHREADS + F.tid; o < NL * 2 * INC; o += F.G * NTHREADS) { const int l = o / (2 * INC), v = (o / INC) & 1, j = o % INC; float s = ain(I_BMOD)[l * INC + j];
#pragma unroll
        for (int ks = 0; ks < 16; ++ks) s += MP[((size_t)(l * 16 + ks) * 2 + v) * INC + j];
        ((float*)(F.ws + WS_MODV))[o] = s; }
    __syncthreads();
    for (int r = F.gw; r < R; r += F.NGW) {
        const int v = r < NCTX ? 1 : 0; const float* src = r < NCTX ? ain(I_CTX) + (size_t)r * DM : ain(I_X) + (size_t)(r - NCTX) * DM;
#pragma unroll
        for (int j = 0; j < 4; ++j) { const int c = 4 * F.lane + 256 * j; const f32x4 x = *(const GAS f32x4*)(src + c);
            const f32x4 sh = *(const LAS f32x4*)(ml + v * 2048 + c), sc = *(const LAS f32x4*)(ml + v * 2048 + 1024 + c);
            const f32x4 h = x * (sc + 1.0f) + sh; u32x2 w; w.x = pk2(h.x, h.y); w.y = pk2(h.z, h.w); *(GAS u32x2*)(H + (size_t)r * DM + c) = w; }
    }
}
__device__ __forceinline__ void post1_phase(const Frame& F, const Args& A, int l, bool wr) {
    bf16* G1 = (bf16*)(F.ws + WS_G1); bf16* Y1 = (bf16*)(F.ws + WS_Y) + (size_t)R * 512;
    const float* rope = (const float*)(F.ws + WS_ROPE);
    const float* qn = ain(I_QN) + l * 64; const float* kn = ain(I_KN) + l * 64; const float* cw = ain(I_CONVW) + l * 3 * 512;
    const int j = F.lane & 7, ja = j >> 2, jb = (j >> 1) & 1, ji = (j & 1) * 8;
    for (int r = F.gw; r < R; r += F.NGW) {
        bf16* row = G1 + (size_t)r * INC;
        float cs[8], sn[8];
        if (r >= NCTX) { const int t = r - NCTX, pos = ja ? (t & 63) : (t >> 6); const float* tp = rope + (pos * 16 + ji) * 2;
#pragma unroll
            for (int q = 0; q < 4; ++q) { const f32x4 v = *(const GAS f32x4*)(tp + 4 * q); cs[2 * q] = v.x; sn[2 * q] = v.y; cs[2 * q + 1] = v.z; sn[2 * q + 1] = v.w; } }
        else {
#pragma unroll
            for (int k = 0; k < 8; ++k) { cs[k] = 1.f; sn[k] = 0.f; } }
#pragma unroll
        for (int p = 0; p < 3; ++p) {
            const int hs = p * 8 + (F.lane >> 3); const bool live = hs < 20; const int hh = live ? hs : 19;
            const int base = (hh < 8 ? C_QA + 64 * hh : hh < 10 ? C_KA + 64 * (hh - 8) : hh < 18 ? C_QC + 64 * (hh - 10) : C_KC + 64 * (hh - 18)) + 8 * j;
            const v4u xv = *(const GAS v4u*)(row + base);
            float e[8] = {bflo(xv.x), bfhi(xv.x), bflo(xv.y), bfhi(xv.y), bflo(xv.z), bfhi(xv.z), bflo(xv.w), bfhi(xv.w)};
            if (p < 2) {
                float ss = 0.f;
#pragma unroll
                for (int k = 0; k < 8; ++k) ss += e[k] * e[k];
                ss += __shfl_xor(ss, 1); ss += __shfl_xor(ss, 2); ss += __shfl_xor(ss, 4);
                if (hh < 10) { const float rs = __builtin_amdgcn_rsqf(ss * (1.0f / 64.0f) + RMS_EPS); const float* gn = (hh < 8 ? qn : kn) + 8 * j;
                    const f32x4 g0 = *(const GAS f32x4*)gn, g1 = *(const GAS f32x4*)(gn + 4);
                    e[0] *= rs * g0.x; e[1] *= rs * g0.y; e[2] *= rs * g0.z; e[3] *= rs * g0.w; e[4] *= rs * g1.x; e[5] *= rs * g1.y; e[6] *= rs * g1.z; e[7] *= rs * g1.w; }
            }
            const float qs = (hh < 8 || (hh >= 10 && hh < 18)) ? QSCALE : 1.0f;
            float o[8];
#pragma unroll
            for (int k = 0; k < 8; ++k) { const float pe = __shfl_xor(e[k], 2); o[k] = (jb ? e[k] * cs[k] + pe * sn[k] : e[k] * cs[k] - pe * sn[k]) * qs; }
            if (live && wr) { v4u w; w.x = pk2(o[0], o[1]); w.y = pk2(o[2], o[3]); w.z = pk2(o[4], o[5]); w.w = pk2(o[6], o[7]); *(GAS v4u*)(row + base) = w; }
        }
        const int lo = r < NCTX ? 0 : NCTX, hi = r < NCTX ? NCTX - 1 : R - 1, ch = 8 * F.lane;
        float acc[8];
#pragma unroll
        for (int k = 0; k < 8; ++k) acc[k] = 0.f;
#pragma unroll
        for (int d = 0; d < 3; ++d) { const int rr = r - 1 + d;
            if (rr >= lo && rr <= hi) { const bf16* nr = G1 + (size_t)rr * INC;
                const v4u xb = *(const GAS v4u*)(nr + C_XB + ch), gc = *(const GAS v4u*)(nr + C_GC + ch);
                const f32x4 w0 = *(const GAS f32x4*)(cw + d * 512 + ch), w1 = *(const GAS f32x4*)(cw + d * 512 + ch + 4);
                acc[0] += w0.x * bflo(xb.x) * bflo(gc.x); acc[1] += w0.y * bfhi(xb.x) * bfhi(gc.x); acc[2] += w0.z * bflo(xb.y) * bflo(gc.y); acc[3] += w0.w * bfhi(xb.y) * bfhi(gc.y);
                acc[4] += w1.x * bflo(xb.z) * bflo(gc.z); acc[5] += w1.y * bfhi(xb.z) * bfhi(gc.z); acc[6] += w1.z * bflo(xb.w) * bflo(gc.w); acc[7] += w1.w * bfhi(xb.w) * bfhi(gc.w); } }
        const v4u gb = *(const GAS v4u*)(row + C_GB + ch);
        v4u o; o.x = pk2(acc[0] * bflo(gb.x), acc[1] * bfhi(gb.x)); o.y = pk2(acc[2] * bflo(gb.y), acc[3] * bfhi(gb.y)); o.z = pk2(acc[4] * bflo(gb.z), acc[5] * bfhi(gb.z)); o.w = pk2(acc[6] * bflo(gb.w), acc[7] * bfhi(gb.w));
        if (wr) *(GAS v4u*)(Y1 + (size_t)r * 512 + ch) = o;
    }
}
__device__ __forceinline__ void ln1_phase(const Frame& F, const Args& A, int l, int row0, bf16* H2) {
    const float* YO = (const float*)(F.ws + WS_YO); float* X = (float*)(F.ws + WS_X); const float* MV = (const float*)(F.ws + WS_MODV) + (size_t)l * 2 * INC;
    const float* lg = ain(I_LN1G) + l * DM; const float* lb = ain(I_LN1B) + l * DM;
    for (int r = row0 + F.gw; r < R; r += F.NGW) {
        const float* mv = MV + (r < NCTX ? INC : 0);
        const float* xin = l == 0 ? (r < NCTX ? ain(I_CTX) + (size_t)r * DM : ain(I_X) + (size_t)(r - NCTX) * DM) : X + (size_t)r * DM;
        f32x4 v[4]; float s = 0.f;
#pragma unroll
        for (int j = 0; j < 4; ++j) { const int c = 4 * F.lane + 256 * j; const f32x4 x = *(const GAS f32x4*)(xin + c), y = *(const GAS f32x4*)(YO + (size_t)r * DM + c), g = *(const GAS f32x4*)(mv + 2048 + c);
            v[j] = x * ALPHA + g * y; s += (v[j].x + v[j].y) + (v[j].z + v[j].w); }
        const float mean = wave_sum(s) * (1.f / DM); float s2 = 0.f;
#pragma unroll
        for (int j = 0; j < 4; ++j) { v[j] = v[j] - mean; s2 += (v[j].x * v[j].x + v[j].y * v[j].y) + (v[j].z * v[j].z + v[j].w * v[j].w); }
        const float rstd = 1.f / sqrtf(wave_sum(s2) * (1.f / DM) + LN_EPS);
#pragma unroll
        for (int j = 0; j < 4; ++j) { const int c = 4 * F.lane + 256 * j; const f32x4 gg = *(const GAS f32x4*)(lg + c), bb = *(const GAS f32x4*)(lb + c);
            const f32x4 x1 = v[j] * rstd * gg + bb; *(GAS f32x4*)(X + (size_t)r * DM + c) = x1;
            const f32x4 sh = *(const GAS f32x4*)(mv + 3072 + c), sc = *(const GAS f32x4*)(mv + 4096 + c);
            const f32x4 h = x1 * (sc + 1.0f) + sh; u32x2 w; w.x = pk2(h.x, h.y); w.y = pk2(h.z, h.w); *(GAS u32x2*)(H2 + (size_t)r * DM + c) = w; }
    }
}
typedef float f32x16 __attribute__((ext_vector_type(16)));
__device__ __forceinline__ void ins16(float (&L)[16], float x) {
#pragma unroll
    for (int j = 0; j < 16; ++j) { const float h = vmaxf(L[j], x); x = vminf(L[j], x); L[j] = h; }
}
__device__ __forceinline__ void bitonic16_desc(float (&T)[16]) {
#pragma unroll
    for (int s = 8; s >= 1; s >>= 1)
#pragma unroll
        for (int i = 0; i < 16; ++i) if ((i & s) == 0) { const float h = vmaxf(T[i], T[i + s]), lo = vminf(T[i], T[i + s]); T[i] = h; T[i + s] = lo; }
}
__device__ __forceinline__ void subkey_top16(const bf16* qrow  , const bf16* keys  , int r32, int hi, float (&S)[16]) {
    bf16x8 qf[8];
#pragma unroll
    for (int ks = 0; ks < 8; ++ks) qf[ks] = *(const GAS bf16x8*)(qrow + ks * 16 + hi * 8);
    float L[16];
#pragma unroll
    for (int j = 0; j < 16; ++j) L[j] = -INFINITY;
#pragma unroll 1
    for (int nb = 0; nb < 4; ++nb) { f32x16 acc = f32x16{};
#pragma unroll
        for (int ks = 0; ks < 8; ++ks) { const bf16x8 kf = *(const GAS bf16x8*)(keys + (size_t)(nb * 32 + r32) * 128 + ks * 16 + hi * 8);
            acc = __builtin_amdgcn_mfma_f32_32x32x16_bf16(kf, qf[ks], acc, 0, 0, 0); }
#pragma unroll
        for (int rg = 0; rg < 16; ++rg) { const unsigned n = (unsigned)(nb * 32 + (rg & 3) + 8 * (rg >> 2) + 4 * hi);
            ins16(L, __uint_as_float((__float_as_uint(acc[rg]) & ~127u) | n)); } }
#pragma unroll
    for (int j = 0; j < 16; ++j) { const float other = __shfl_xor(L[15 - j], 32); S[j] = vmaxf(L[j], other); }
    bitonic16_desc(S);
}
__device__ __forceinline__ void scores_phase(const Frame& F, const Args& A, int l, int row0) {
    const bf16* PQ = (const bf16*)(F.ws + WS_PQ); const bf16* SK = (const bf16*)(F.ws + WS_WSM + (size_t)l * WSM_L + OW_SK);
    int* IDX = (int*)(F.ws + WS_IDX); float* WGT = (float*)(F.ws + WS_WGT);
    const int r32 = F.lane & 31, hi = F.lane >> 5;
    LAS unsigned* myl = (LAS unsigned*)(F.lds + F.wave * 2048 + F.lane * 32);
    const int nitems = ((R - row0) / 32) * 8;
    for (int it = F.gw; it < nitems; it += F.NGW) {
        const int h = it & 7, rb = row0 + (it >> 3) * 32, row = rb + r32;
        float S1[16], S2[16];
        subkey_top16(PQ + (size_t)row * 2048 + h * 256, SK + (size_t)(h * 2) * 16384, r32, hi, S1);
        subkey_top16(PQ + (size_t)row * 2048 + h * 256 + 128, SK + (size_t)(h * 2 + 1) * 16384, r32, hi, S2);
#pragma unroll
        for (int q = 0; q < 4; ++q) {
            myl[q] = (__float_as_uint(S1[4 * q]) & 127u) | ((__float_as_uint(S1[4 * q + 1]) & 127u) << 8) | ((__float_as_uint(S1[4 * q + 2]) & 127u) << 16) | ((__float_as_uint(S1[4 * q + 3]) & 127u) << 24);
            myl[4 + q] = (__float_as_uint(S2[4 * q]) & 127u) | ((__float_as_uint(S2[4 * q + 1]) & 127u) << 8) | ((__float_as_uint(S2[4 * q + 2]) & 127u) << 16) | ((__float_as_uint(S2[4 * q + 3]) & 127u) << 24); }
        float T[16];
#pragma unroll
        for (int j = 0; j < 16; ++j) T[j] = -INFINITY;
#pragma unroll
        for (int a = 0; a < 16; ++a)
#pragma unroll
            for (int b = 0; b < 16; ++b) if ((a + 1) * (b + 1) <= 16) ins16(T, __uint_as_float((__float_as_uint(S1[a] + S2[b]) & ~255u) | (unsigned)(a * 16 + b)));
        const float m = T[0]; float e[16], sum = 0.f;
#pragma unroll
        for (int j = 0; j < 16; ++j) { e[j] = __expf(T[j] - m); sum += e[j]; }
        const float inv = 1.0f / sum;
        LDS_WAIT();
        if (hi == 0) {
            const LAS unsigned char* lb = (const LAS unsigned char*)myl;
            int ex[16];
#pragma unroll
            for (int j = 0; j < 16; ++j) { const unsigned pid = __float_as_uint(T[j]) & 255u; ex[j] = (int)lb[pid >> 4] * 128 + (int)lb[16 + (pid & 15u)]; }
            int* ip = IDX + (size_t)row * 128 + h * 16; float* wp = WGT + (size_t)row * 128 + h * 16;
#pragma unroll
            for (int q = 0; q < 4; ++q) { *(GAS v4u*)(ip + 4 * q) = (v4u){(unsigned)ex[4 * q], (unsigned)ex[4 * q + 1], (unsigned)ex[4 * q + 2], (unsigned)ex[4 * q + 3]};
                *(GAS f32x4*)(wp + 4 * q) = (f32x4){e[4 * q] * inv, e[4 * q + 1] * inv, e[4 * q + 2] * inv, e[4 * q + 3] * inv}; }
        }
        LDS_WAIT();
    }
}
template <bool LAST> __device__ __forceinline__ void peer_phase(const Frame& F, const Args& A, int l, int row0, const bf16* H2, bf16* Hn) {
    const unsigned char* U = F.ws + WS_U; const unsigned char* V = F.ws + WS_V; const float* SU = (const float*)(F.ws + WS_U + 16 * MiB); const float* SV = (const float*)(F.ws + WS_V + 16 * MiB);
    const int* IDX = (const int*)(F.ws + WS_IDX); const float* WGT = (const float*)(F.ws + WS_WGT);
    float* X = (float*)(F.ws + WS_X); const float* MVl = (const float*)(F.ws + WS_MODV) + (size_t)l * 2 * INC; const float* MVn = (const float*)(F.ws + WS_MODV) + (size_t)(LAST ? l : l + 1) * 2 * INC;
    const float* lg = ain(I_LN2G) + l * DM; const float* lb = ain(I_LN2B) + l * DM;
    const int lane = F.lane, c0 = 16 * lane;
    LAS int* idxL = (LAS int*)(F.lds + F.wave * 2048); LAS float* wL = (LAS float*)(F.lds + F.wave * 2048 + 512); LAS float* aL = (LAS float*)(F.lds + F.wave * 2048 + 1024);
    const int jx = (lane >> 3) & 7;
    for (int r = row0 + F.gw; r < R; r += F.NGW) {
        idxL[lane] = IDX[(size_t)r * 128 + lane]; idxL[64 + lane] = IDX[(size_t)r * 128 + 64 + lane];
        wL[lane] = WGT[(size_t)r * 128 + lane]; wL[64 + lane] = WGT[(size_t)r * 128 + 64 + lane];
        const v4u h0 = *(const GAS v4u*)(H2 + (size_t)r * DM + c0), h1 = *(const GAS v4u*)(H2 + (size_t)r * DM + c0 + 8);
#pragma unroll 2
        for (int c = 0; c < 16; ++c) {
            float p[8];
#pragma unroll
            for (int e = 0; e < 8; ++e) { const int ei = idxL[c * 8 + e]; const v4u u = *(const GAS v4u*)(U + (size_t)ei * DM + c0);
                float a0 = dot2bf(fp8lo(u.x), h0.x, 0.f), a1 = dot2bf(fp8hi(u.x), h0.y, 0.f); a0 = dot2bf(fp8lo(u.y), h0.z, a0); a1 = dot2bf(fp8hi(u.y), h0.w, a1);
                a0 = dot2bf(fp8lo(u.z), h1.x, a0); a1 = dot2bf(fp8hi(u.z), h1.y, a1); a0 = dot2bf(fp8lo(u.w), h1.z, a0); a1 = dot2bf(fp8hi(u.w), h1.w, a1); p[e] = a0 + a1; }
            { const bool up = (lane & 32) != 0;
#pragma unroll
              for (int i = 0; i < 4; ++i) { const float a = p[i], b = p[i + 4]; p[i] = (up ? b : a) + __shfl_xor(up ? a : b, 32); } }
            { const bool up = (lane & 16) != 0;
#pragma unroll
              for (int i = 0; i < 2; ++i) { const float a = p[i], b = p[i + 2]; p[i] = (up ? b : a) + __shfl_xor(up ? a : b, 16); } }
            { const bool up = (lane & 8) != 0; const float a = p[0], b = p[1]; p[0] = (up ? b : a) + __shfl_xor(up ? a : b, 8); }
            float t = p[0]; t += __shfl_xor(t, 4); t += __shfl_xor(t, 2); t += __shfl_xor(t, 1);
            const int ej = idxL[c * 8 + jx]; const float av = gelu_f(t * SU[ej]) * wL[c * 8 + jx] * SV[ej];
            if ((lane & 7) == 0) aL[c * 8 + jx] = av;
        }
        float f[16];
#pragma unroll
        for (int k = 0; k < 16; ++k) f[k] = 0.f;
#pragma unroll 2
        for (int c = 0; c < 16; ++c) {
#pragma unroll
            for (int e = 0; e < 8; ++e) { const int ei = idxL[c * 8 + e]; const float ae = aL[c * 8 + e]; const v4u v = *(const GAS v4u*)(V + (size_t)ei * DM + c0);
                const unsigned vv[4] = {v.x, v.y, v.z, v.w};
#pragma unroll
                for (int q = 0; q < 4; ++q) { const f32x2 lo = __builtin_amdgcn_cvt_pk_f32_fp8((int)vv[q], false), hi = __builtin_amdgcn_cvt_pk_f32_fp8((int)vv[q], true);
                    f[4 * q] += ae * lo.x; f[4 * q + 1] += ae * lo.y; f[4 * q + 2] += ae * hi.x; f[4 * q + 3] += ae * hi.y; } }
        }
        const float* mv = MVl + (r < NCTX ? INC : 0);
        float v[16]; float s = 0.f;
#pragma unroll
        for (int q = 0; q < 4; ++q) { const int c = c0 + 4 * q; const f32x4 x = *(const GAS f32x4*)(X + (size_t)r * DM + c), g2 = *(const GAS f32x4*)(mv + 5120 + c);
#pragma unroll
            for (int k = 0; k < 4; ++k) { const float t = x[k] * ALPHA + g2[k] * f[q * 4 + k]; v[q * 4 + k] = t; s += t; } }
        const float mean = wave_sum(s) * (1.f / DM); float s2 = 0.f;
#pragma unroll
        for (int k = 0; k < 16; ++k) { v[k] -= mean; s2 += v[k] * v[k]; }
        const float rstd = 1.f / sqrtf(wave_sum(s2) * (1.f / DM) + LN_EPS);
        const float* mn = MVn + (r < NCTX ? INC : 0);
#pragma unroll
        for (int q = 0; q < 4; ++q) { const int c = c0 + 4 * q; const f32x4 gg = *(const GAS f32x4*)(lg + c), bb = *(const GAS f32x4*)(lb + c);
            f32x4 x2;
#pragma unroll
            for (int k = 0; k < 4; ++k) x2[k] = v[q * 4 + k] * rstd * gg[k] + bb[k];
            if (LAST) { *(GAS f32x4*)(aout() + (size_t)(r - NCTX) * DM + c) = x2; }
            else { *(GAS f32x4*)(X + (size_t)r * DM + c) = x2;
                const f32x4 sh = *(const GAS f32x4*)(mn + c), sc = *(const GAS f32x4*)(mn + 1024 + c); const f32x4 hh = x2 * (sc + 1.0f) + sh;
                u32x2 w; w.x = pk2(hh.x, hh.y); w.y = pk2(hh.z, hh.w); *(GAS u32x2*)(Hn + (size_t)r * DM + c) = w; } }
    }
}
__device__ __forceinline__ void attn_phase(const Frame& F, const Args& A, int l) {
    using attn_body::AttnJob; typedef attn_body::bf16 abf;
    abf* G1 = (abf*)(F.ws + WS_G1); abf* Y0 = (abf*)(F.ws + WS_Y); abf* Y2 = Y0 + (size_t)2 * R * 512;
    char* shm = (char*)F.lds_g;
    const float* sink = ain(I_SINK) + l * 8;
#define OPAQUE_S(x) asm volatile("" : "+s"(x))
#pragma unroll 1
    for (int i = 0; i < 2; ++i) {
        int vc = F.vcu; OPAQUE_S(vc);
        const int u = 2 * vc + i, kvh = u >> 8, hq = kvh * 4 + ((u >> 6) & 3), qb = u & 63; const size_t row = NCTX + 256 * qb;
        AttnJob J; J.Q = G1 + row * INC + C_QA + hq * 64; J.K = G1 + C_KA + kvh * 64; J.V = G1 + C_VA + kvh * 64; J.O = Y0 + row * 512 + hq * 64;
        J.qp = INC; J.kp = INC; J.op = 512; J.nt = R / 64; J.nt0 = R / 64; J.row1 = 0; J.qpos0 = 0; J.kpos1 = 0; J.sink2 = -INFINITY;
        attn_body::attn_unit<8, 0>(J, shm);
    }
#ifndef AT_ONLYA
#pragma unroll 1
    for (int i = 0; i < 2; ++i) {
        int vc = F.vcu; OPAQUE_S(vc);
        const int u = 2 * vc + i, kvh = u >> 8, hq = kvh * 4 + ((u >> 6) & 3), qb = u & 63; const size_t row = NCTX + 256 * qb;
        const int q0 = 256 * qb, lo = q0 - 128 < 0 ? 0 : q0 - 128, hi = q0 + 384 > SEQ ? SEQ : q0 + 384;
        AttnJob J; J.Q = G1 + row * INC + C_QC + hq * 64; J.K = G1 + C_KC + kvh * 64; J.V = G1 + C_VC + kvh * 64; J.O = Y2 + row * 512 + hq * 64;
        J.qp = INC; J.kp = INC; J.op = 512; J.nt0 = NCTX / 64; J.nt = NCTX / 64 + (hi - lo) / 64; J.row1 = NCTX + lo; J.qpos0 = q0; J.kpos1 = lo; J.sink2 = sink[hq] * LOG2E;
        attn_body::attn_unit<8, 1>(J, shm);
    }
    int vx = F.vcu; OPAQUE_S(vx);
    if (l == 0 && vx < 16) {
        const int hq = vx & 7, kvh = hq >> 2; const bool isc = vx >= 8;
        AttnJob J; J.Q = G1 + (isc ? C_QC : C_QA) + hq * 64; J.K = G1 + (isc ? C_KC : C_KA) + kvh * 64; J.V = G1 + (isc ? C_VC : C_VA) + kvh * 64; J.O = (isc ? Y2 : Y0) + hq * 64;
        J.qp = INC; J.kp = INC; J.op = 512; J.nt = NCTX / 64; J.nt0 = NCTX / 64; J.row1 = 0; J.qpos0 = 0; J.kpos1 = 0; J.sink2 = isc ? sink[hq] * LOG2E : -INFINITY;
        attn_body::attn_unit<8, 0>(J, shm);
    }
#endif
}
constexpr int N_PHASES = 2 + 9 * NL;
__global__ void __launch_bounds__(NTHREADS, 2) mk_fwd(Args A) {
    extern __shared__ __attribute__((aligned(16))) unsigned char lds[];
    Frame F0;
    F0.lds = (LAS unsigned char*)lds; F0.lds_g = lds;
    F0.tid = threadIdx.x; F0.lane = F0.tid & 63; F0.wave = __builtin_amdgcn_readfirstlane(F0.tid >> 6);
    F0.G = gridDim.x; F0.bx = blockIdx.x; F0.vcu = (F0.G % 8 == 0) ? (F0.bx % 8) * (F0.G / 8) + F0.bx / 8 : F0.bx;
    F0.gw = F0.bx * NWAVES + F0.wave; F0.NGW = F0.G * NWAVES; F0.ws = A.ws;
    volatile LAS unsigned* MISC = (volatile LAS unsigned*)(F0.lds + MISC_OFF);
    for (int u = F0.tid; u < (LDS_BYTES - LDSCTL_OFF) / 4; u += NTHREADS) ((LAS unsigned*)(F0.lds + LDSCTL_OFF))[u] = 0u;
    __syncthreads();
    const int lo = A.ph_lo, hi = A.ph_hi;
    XcdBarrier bar; bar.bar = (unsigned*)(A.ws + WS_CTL) + CW_BAR; bar.x = 0; bar.st = nullptr;
    if (hi - lo > 1) bar = xcd_barrier_post((unsigned*)(A.ws + WS_CTL) + CW_BAR, MISC + 8);
#ifndef MK_ONLY
#define MK_ONLY -1
#endif
#ifndef MK_REP
#define MK_REP 0
#endif
#ifndef MK_MASK
#define MK_MASK 0x7ff
#endif
#define ON(k) ((MK_ONLY < 0 || MK_ONLY == (k)) && ((MK_MASK >> (k)) & 1))
#pragma unroll 1
    for (int ph2 = 2 * lo; ph2 < 2 * hi; ++ph2) {
        const int ph = ph2 >> 1;
        if ((ph2 & 1) && !((MK_REP >> ph) & 1)) continue;
        const int l = ph < 2 ? 0 : (ph - 2) / 9, kind = ph < 2 ? ph : 2 + (ph - 2) % 9;
        Frame F;
        F.lds = (LAS unsigned char*)lds; F.lds_g = lds;
        F.tid = opq_tid(); F.lane = F.tid & 63; F.wave = __builtin_amdgcn_readfirstlane(F.tid >> 6);
        { int bx = blockIdx.x, g = gridDim.x; asm volatile("" : "+s"(bx), "+s"(g)); F.bx = bx; F.G = g; }
        F.vcu = (F.G % 8 == 0) ? (F.bx % 8) * (F.G / 8) + F.bx / 8 : F.bx; F.gw = F.bx * NWAVES + F.wave; F.NGW = F.G * NWAVES;
        { GAS unsigned char* wsg = (GAS unsigned char*)A.ws; asm volatile("" : "+s"(wsg)); F.ws = (unsigned char*)wsg; }
        bf16* HA = (bf16*)(F.ws + WS_HA); bf16* HB = (bf16*)(F.ws + WS_HB);
        bf16* Hin = (l & 1) ? HB : HA; bf16* Hmg = (l & 1) ? HA : HB;
        const int row0 = (l == NL - 1) ? NCTX : 0;
        const int Mr = R - row0, NPr = Mr / 256;
        unsigned char* wsm = F.ws + WS_WSM + (size_t)l * WSM_L;
        switch (kind) {
        case 0: if (ON(0)) { p0_prologue(F, A); } break;
        case 1: if (ON(1)) { p1_mod_h0(F, A, HA); } break;
        case 2: if (ON(2)) {
            pg8::Gemm g{(const pg8::bf16_t*)Hin, (const pg8::bf16_t*)(wsm + OW_IN), R, INC, DM}; pg8::StaticOrder S; S.init(R, INC, F.G, F.bx);
            pg8::EpiBf16<0> E{(pg8::bf16_t*)(F.ws + WS_G1), INC, nullptr, 0, 0, 1.f};
            pg8::gemm_phase<pg8::EpiBf16<0>, pg8::StaticOrder, true, true>(F.lds, g, S, E);
            if (l > 0) convert_uv(F, A, l);
        } break;
        case 3: if (ON(3)) { post1_phase(F, A, l, !(ph2 & 1) || F.G == 12345); } break;
        case 4: if (ON(4)) { attn_phase(F, A, l); } break;
        case 5: if (ON(5)) {
            pg8::Gemm g{(const pg8::bf16_t*)(F.ws + WS_Y) + (size_t)row0 * 512, (const pg8::bf16_t*)(wsm + OW_BR), 3 * R, 3072, 512}; pg8::MergeOrder S; S.init(NPr, SPAN, F.G, F.bx);
            pg8::EpiMerge E{(pg8::bf16_t*)Hmg + (size_t)row0 * DM, (const pg8::bf16_t*)(F.ws + WS_G1) + (size_t)row0 * INC + C_GL, INC, SPAN};
            pg8::gemm_phase<pg8::EpiMerge, pg8::MergeOrder, true, true>(F.lds, g, S, E);
        } break;
        case 6: if (ON(6)) {
            pg8::Gemm g{(const pg8::bf16_t*)Hmg + (size_t)row0 * DM, (const pg8::bf16_t*)(wsm + OW_OUT), Mr, DM, DM}; pg8::StaticOrder S; S.init(Mr, DM, F.G, F.bx);
            pg8::EpiF32 E{(float*)(F.ws + WS_YO) + (size_t)row0 * DM, DM};
            pg8::gemm_phase<pg8::EpiF32, pg8::StaticOrder, true, true>(F.lds, g, S, E);
        } break;
        case 7: if (ON(7)) { ln1_phase(F, A, l, row0, Hin); } break;
        case 8: if (ON(8)) {
            pg8::Gemm g{(const pg8::bf16_t*)Hin + (size_t)row0 * DM, (const pg8::bf16_t*)(wsm + OW_PQ), Mr, 2048, DM}; pg8::StaticOrder S; S.init(Mr, 2048, F.G, F.bx);
            pg8::EpiBf16<0> E{(pg8::bf16_t*)(F.ws + WS_PQ) + (size_t)row0 * 2048, 2048, nullptr, 0, 0, 1.f};
            pg8::gemm_phase<pg8::EpiBf16<0>, pg8::StaticOrder, true, true>(F.lds, g, S, E);
        } break;
        case 9: if (ON(9)) { scores_phase(F, A, l, row0); } break;
        default: if (ON(10)) { if (l == NL - 1) peer_phase<true>(F, A, l, row0, Hin, Hmg); else peer_phase<false>(F, A, l, row0, Hin, Hmg); } break;
        }
#if defined(MK_XBAR)
        if (ph == 5 && !(ph2 & 1)) { for (int q = 0; q < MK_XBAR; ++q) xcd_barrier(bar); }
#endif
        const bool more = (ph2 & 1) ? (ph + 1 < hi) : ((ph + 1 < hi) || ((MK_REP >> ph) & 1));
        if (more) { if (A.coop && ph2 == 2 * lo) { cg::this_grid().sync(); } else { xcd_barrier(bar); } }
    }
#undef ON
}
#ifndef MK_MULTI
#define MK_MULTI 0
#endif
extern "C" void kernel_launch(void* const* d_in, const int* in_sizes, int n_in, void* d_out, int out_size, void* d_ws, size_t ws_size, hipStream_t stream) {
    static int grid = 0;
    if (grid == 0) {
        if (n_in != N_IN || out_size != SEQ * DM || ws_size < WS_END) { fprintf(stderr, "kernel_launch: unexpected shapes (n_in %d, out %d, ws %zu)\n", n_in, out_size, ws_size); grid = -1; return; }
        int dev = 0, cus = 0, per_cu = 0;
        if (hipGetDevice(&dev) != hipSuccess || hipDeviceGetAttribute(&cus, hipDeviceAttributeMultiprocessorCount, dev) != hipSuccess) { grid = -1; return; }
        if (hipFuncSetAttribute((const void*)mk_fwd, hipFuncAttributeMaxDynamicSharedMemorySize, LDS_BYTES) != hipSuccess) { grid = -1; return; }
        if (hipOccupancyMaxActiveBlocksPerMultiprocessor(&per_cu, (const void*)mk_fwd, NTHREADS, LDS_BYTES) != hipSuccess || per_cu < 1) { fprintf(stderr, "kernel_launch: occupancy query says %d\n", per_cu); }
        (void)hipGetLastError();
        grid = cus;
    }
    if (grid < 0) return;
    (void)hipMemsetAsync((char*)d_ws + WS_CTL, 0, CTL_ZERO_BYTES, stream);
    Args a{};
    for (int i = 0; i < N_IN; ++i) a.in[i] = (const float*)d_in[i];
    a.out = (float*)d_out; a.ws = (unsigned char*)d_ws;
#if MK_MULTI
    for (int p = 0; p < N_PHASES; ++p) { a.ph_lo = p; a.ph_hi = p + 1; a.coop = 0; hipLaunchKernelGGL(mk_fwd, dim3(grid), dim3(NTHREADS), LDS_BYTES, stream, a); }
#else
    a.ph_lo = 0; a.ph_hi = N_PHASES; a.coop = 1;
    void* args[] = {&a};
    hipError_t e = hipLaunchCooperativeKernel((void*)mk_fwd, dim3(grid), dim3(NTHREADS), args, LDS_BYTES, stream);
    if (e != hipSuccess) fprintf(stderr, "kernel_launch: cooperative launch failed: %s (grid %d)\n", hipGetErrorString(e), grid);
#endif
}
```

```cpp
#include <hip/hip_runtime.h>
#include <hip/hip_bf16.h>
#include <hip/hip_cooperative_groups.h>
#include <cstdio>
#include <cstdint>
#include <cmath>
__device__ __forceinline__ int opq_tid() { int t = threadIdx.x; asm volatile("" : "+v"(t)); return t; }
namespace pg8 {
#define PG8_LAS __attribute__((address_space(3)))
typedef unsigned short bf16_t;
typedef short bf16x8 __attribute__((ext_vector_type(8)));
typedef float f32x4 __attribute__((ext_vector_type(4)));
typedef unsigned u32x4 __attribute__((ext_vector_type(4)));
constexpr int BM = 256, BK = 64, HALF = 128, HTB = HALF * BK * 2  , STAGE_BYTES = 8 * HTB, NXCD = 8, WGM = 8;

__host__ __device__ __forceinline__ int lds_byte(int r, int c) { const int st = (r >> 4) * 2 + (c >> 5), rr = r & 15, cc = c & 31, ob = rr * 64 + cc * 2; return st * 1024 + (ob ^ (((ob >> 9) & 1) << 5)); }
__host__ __device__ __forceinline__ void stage_rc(int b, int& R, int& C) { const int st = b / 1024, sb = b % 1024, swz = sb ^ (((sb >> 9) & 1) << 5); R = (st >> 1) * 16 + swz / 64; C = (st & 1) * 32 + (swz % 64) / 2; }
__host__ __device__ __forceinline__ int perm32(int rho) { const int n = rho >> 4, i = rho & 15; return 8 * (i >> 2) + 4 * n + (i & 3); }

struct Unit { int pm, pn; };
struct Gemm { const bf16_t* A; const bf16_t* Bt; int M, N, K; };

struct StaticOrder {
    int nM, nN, nwg, G, c;
    __host__ __device__ void init(int M, int N, int G_, int c_) { nM = M / BM; nN = N / BM; nwg = nM * nN; G = G_; c = c_; }
    __host__ __device__ bool next(int i, Unit& u) const {
        const long L = (long)i * G + c; if (L >= nwg) return false;
        int wgid = (int)L; { const int q = nwg / NXCD, r = nwg % NXCD, xcd = wgid % NXCD, off = wgid / NXCD; wgid = (xcd < r ? xcd * (q + 1) : r * (q + 1) + (xcd - r) * q) + off; }
        const int nig = WGM * nN, gid = wgid / nig, fm = gid * WGM, gsz = (nM - fm) < WGM ? (nM - fm) : WGM;
        u.pm = fm + ((wgid % nig) % gsz); u.pn = (wgid % nig) / gsz; return true;
    }
    __device__ __forceinline__ void a_ready(const Unit&) const {}
    __device__ __forceinline__ void done(const Unit&) const {}
};

__device__ __forceinline__ unsigned cvt_pk_bf16(float lo, float hi) { unsigned r; asm volatile("v_cvt_pk_bf16_f32 %0, %1, %2" : "=v"(r) : "v"(lo), "v"(hi)); return r; }
typedef float f32x2 __attribute__((ext_vector_type(2)));
__device__ __forceinline__ f32x2 gelu_pk(f32x2 v) {
    const f32x2 av = __builtin_elementwise_abs(v), d = av * 0.2316418882f + 1.0f;
    f32x2 t; t.x = __builtin_amdgcn_rcpf(d.x); t.y = __builtin_amdgcn_rcpf(d.y);
    f32x2 q = t * 0.5307027145f + (-0.7265760135f); q = q * t + 0.7107068705f; q = q * t + (-0.142248368f); q = q * t + 0.127414796f; q = q * t;
    const f32x2 s = (v * v) * (-0.72134752044f);
    f32x2 e; e.x = __builtin_amdgcn_exp2f(s.x); e.y = __builtin_amdgcn_exp2f(s.y);
    const f32x2 m = v * (q * e), r = v - m;
    f32x2 o; o.x = v.x < 0.f ? m.x : r.x; o.y = v.y < 0.f ? m.y : r.y; return o;
}

template <int ACT  > struct EpiBf16 {
    static constexpr bool PERM = true, AFTER_DRAIN = false; static_assert(ACT == 0 || ACT == 1, "EpiBf16: ACT is 0 (none) or 1 (gelu_pk)");
    bf16_t* O; int ldc; const float* bias; int split_cols; size_t split_stride; float scale0;
    __device__ __forceinline__ void operator()(const f32x4 (&acc)[2][2][4][2], const Unit& u, int wr, int wc, int fr, int fq) const {
        const int row0 = u.pm * BM + wr * 64 + fr; int colt = u.pn * BM; bf16_t* base = O;
        float sc = 1.f; if (split_cols) { const int t = colt / split_cols; base += (size_t)t * split_stride; colt -= t * split_cols; if (t == 0) sc = scale0; }
        const int col0 = colt + wc * 32 + 8 * fq, bcol0 = u.pn * BM + wc * 32 + 8 * fq;
        f32x4 bv[2][2];
#pragma unroll
        for (int bj = 0; bj < 2; ++bj)
#pragma unroll
            for (int n = 0; n < 2; ++n) bv[bj][n] = bias ? *(const f32x4*)(bias + bcol0 + bj * HALF + 4 * n) : (f32x4){0.f, 0.f, 0.f, 0.f};
#pragma unroll
        for (int ai = 0; ai < 2; ++ai)
#pragma unroll
            for (int m = 0; m < 4; ++m) { bf16_t* rowp = base + (size_t)(row0 + ai * HALF + m * 16) * ldc + col0;
#pragma unroll
                for (int bj = 0; bj < 2; ++bj) { f32x4 v0 = acc[ai][bj][m][0] + bv[bj][0], v1 = acc[ai][bj][m][1] + bv[bj][1];
                    if (ACT == 1) { f32x2 a = gelu_pk((f32x2){v0[0], v0[1]}), b = gelu_pk((f32x2){v0[2], v0[3]}), c = gelu_pk((f32x2){v1[0], v1[1]}), d = gelu_pk((f32x2){v1[2], v1[3]});
                        v0 = (f32x4){a.x, a.y, b.x, b.y}; v1 = (f32x4){c.x, c.y, d.x, d.y}; }
                    v0 = v0 * sc; v1 = v1 * sc; u32x4 w; w.x = cvt_pk_bf16(v0[0], v0[1]); w.y = cvt_pk_bf16(v0[2], v0[3]); w.z = cvt_pk_bf16(v1[0], v1[1]); w.w = cvt_pk_bf16(v1[2], v1[3]);
                    *(u32x4*)(rowp + bj * HALF) = w; } }
    }
};

struct PanelStats {
    unsigned* xbuf;
    unsigned* cnt;
    unsigned* tmo;
    int ntn; float eps;
    unsigned code;
    __device__ __forceinline__ bool run(const f32x4 (&v)[2][2][4][2], const Unit& u, int wr, int wc, int fr, int fq, PG8_LAS unsigned char* lds, int wid, int lane) const {
        typedef float f32x2v __attribute__((ext_vector_type(2)));
        PG8_LAS f32x2v* P = (PG8_LAS f32x2v*)lds;
        PG8_LAS f32x2v* S = (PG8_LAS f32x2v*)(lds + 8192);
        PG8_LAS unsigned* flag = (PG8_LAS unsigned*)(lds + 8192 + 2048);
#pragma unroll
        for (int ai = 0; ai < 2; ++ai)
#pragma unroll
            for (int m = 0; m < 4; ++m) {
                float s = 0.f;
#pragma unroll
                for (int bj = 0; bj < 2; ++bj)
#pragma unroll
                    for (int n = 0; n < 2; ++n) { const f32x4 x = v[ai][bj][m][n]; s += (x[0] + x[1]) + (x[2] + x[3]); }
                s += __shfl_xor(s, 16); s += __shfl_xor(s, 32);
                const float mw = s * (1.0f / 64.0f); float q = 0.f;
#pragma unroll
                for (int bj = 0; bj < 2; ++bj)
#pragma unroll
                    for (int n = 0; n < 2; ++n) { const f32x4 d = v[ai][bj][m][n] - mw; q += (d[0] * d[0] + d[1] * d[1]) + (d[2] * d[2] + d[3] * d[3]); }
                q += __shfl_xor(q, 16); q += __shfl_xor(q, 32);
                if (fq == 0) P[(ai * HALF + wr * 64 + m * 16 + fr) * 4 + wc] = (f32x2v){mw, q};
            }
        asm volatile("s_waitcnt lgkmcnt(0)" ::: "memory"); __builtin_amdgcn_s_barrier(); asm volatile("" ::: "memory");
#if defined(BROKEN_EXCHANGE_NO_WAIT)
#warning BROKEN CONTROL BUILD: the row-statistics exchange does not wait; results are wrong by design
        if (blockIdx.x >= 64) { const long long t0_ = clock64(); while (clock64() - t0_ < 60000) __builtin_amdgcn_s_sleep(8); }
#endif
        const int row = wid * 32 + (lane & 31);
        if (lane < 32) {
            const f32x2v a = P[row * 4 + 0], b = P[row * 4 + 1], c = P[row * 4 + 2], d = P[row * 4 + 3];
            const float mt = (a.x + b.x + c.x + d.x) * 0.25f;
            const float da = a.x - mt, db = b.x - mt, dc = c.x - mt, dd = d.x - mt;
            const float m2 = (a.y + b.y) + (c.y + d.y) + 64.0f * ((da * da + db * db) + (dc * dc + dd * dd));
            unsigned long long* slot = (unsigned long long*)xbuf + ((size_t)(u.pm * BM + row) * 4 + u.pn);
            __hip_atomic_store(slot, ((unsigned long long)__float_as_uint(m2) << 32) | __float_as_uint(mt), __ATOMIC_RELAXED, __HIP_MEMORY_SCOPE_AGENT);
        }
        asm volatile("s_waitcnt vmcnt(0)" ::: "memory");
        if (lane == 0) __hip_atomic_fetch_add(cnt + 64 * u.pm, 1u, __ATOMIC_RELAXED, __HIP_MEMORY_SCOPE_AGENT);
        if (wid == 0) {
            bool dead = false; const unsigned long long t0 = __builtin_amdgcn_s_memrealtime(); const unsigned want = 8u * (unsigned)ntn;
            for (;;) {
#if defined(BROKEN_EXCHANGE_NO_WAIT)
                break;
#endif
                if ((unsigned)__builtin_amdgcn_readfirstlane(__hip_atomic_load(cnt + 64 * u.pm, __ATOMIC_RELAXED, __HIP_MEMORY_SCOPE_AGENT)) >= want) break;
                if (__builtin_amdgcn_s_memrealtime() - t0 > 2000000ull) {
                    if (lane == 0) { unsigned expect = 0u; __hip_atomic_compare_exchange_strong(tmo + 1, &expect, code | (unsigned)(u.pm & 0xff), __ATOMIC_RELAXED, __ATOMIC_RELAXED, __HIP_MEMORY_SCOPE_AGENT);
                                     __hip_atomic_store(tmo, 1u, __ATOMIC_RELAXED, __HIP_MEMORY_SCOPE_AGENT); }
                    dead = true; break; }
                __builtin_amdgcn_s_sleep(2);
            }
            __builtin_amdgcn_fence(__ATOMIC_ACQUIRE, "agent");
            if (lane == 0) flag[0] = dead ? 1u : 0u;
        }
        asm volatile("s_waitcnt vmcnt(0) lgkmcnt(0)" ::: "memory"); __builtin_amdgcn_s_barrier(); asm volatile("" ::: "memory");
        const bool bad = flag[0] != 0u;
        if (lane < 32) {
            const unsigned long long* slot = (const unsigned long long*)xbuf + (size_t)(u.pm * BM + row) * 4; float mt[4], m2[4]; float ms = 0.f;
#pragma unroll
            for (int t = 0; t < 4; ++t) { if (t < ntn) { const unsigned long long w = __hip_atomic_load(slot + t, __ATOMIC_RELAXED, __HIP_MEMORY_SCOPE_AGENT); mt[t] = __uint_as_float((unsigned)w); m2[t] = __uint_as_float((unsigned)(w >> 32)); } else { mt[t] = 0.f; m2[t] = 0.f; } ms += mt[t]; }
            const float mean = ms / (float)ntn; float q = 0.f;
#pragma unroll
            for (int t = 0; t < 4; ++t) if (t < ntn) { const float dm = mt[t] - mean; q += m2[t] + 256.0f * dm * dm; }
            S[row] = (f32x2v){mean, 1.0f / sqrtf(q / (256.0f * (float)ntn) + eps)};
        }
        asm volatile("s_waitcnt lgkmcnt(0)" ::: "memory"); __builtin_amdgcn_s_barrier(); asm volatile("" ::: "memory");
        return bad;
    }
};
struct EpiLnRes {
    static constexpr bool PERM = false, AFTER_DRAIN = true;
    const float* base; float* out; int ldc; const float* bias; PanelStats st; unsigned poison;
    __device__ __forceinline__ void fused(f32x4 (&acc)[2][2][4][2], const Unit& u, int wr, int wc, int fr, int fq, PG8_LAS unsigned char* lds, int wid, int lane) const {
        typedef float f32x2v __attribute__((ext_vector_type(2)));
        const PG8_LAS f32x2v* S = (const PG8_LAS f32x2v*)(lds + 8192);
        const int col0 = u.pn * BM + wc * 32 + 4 * fq;
#pragma unroll
        for (int bj = 0; bj < 2; ++bj)
#pragma unroll
            for (int n = 0; n < 2; ++n) { const f32x4 bv = bias ? *(const f32x4*)(bias + col0 + bj * HALF + n * 16) : (f32x4){0.f, 0.f, 0.f, 0.f};
#pragma unroll
                for (int ai = 0; ai < 2; ++ai)
#pragma unroll
                    for (int m = 0; m < 4; ++m) acc[ai][bj][m][n] += bv; }
        f32x4 pre[4][2][2];
#pragma unroll
        for (int m = 0; m < 4; ++m) { const size_t off = (size_t)(u.pm * BM + wr * 64 + m * 16 + fr) * ldc + col0;
#pragma unroll
            for (int bj = 0; bj < 2; ++bj)
#pragma unroll
                for (int n = 0; n < 2; ++n) pre[m][bj][n] = *(const f32x4*)(base + off + bj * HALF + n * 16); }
        const bool bad = st.run(acc, u, wr, wc, fr, fq, lds, wid, lane) || poison != 0u;
        const float qnan = __builtin_nanf("");
#pragma unroll
        for (int ai = 0; ai < 2; ++ai)
#pragma unroll
            for (int m = 0; m < 4; ++m) { const int r = ai * HALF + wr * 64 + m * 16 + fr; const f32x2v sr = S[r]; const size_t off = (size_t)(u.pm * BM + r) * ldc + col0;
#pragma unroll
                for (int bj = 0; bj < 2; ++bj)
#pragma unroll
                    for (int n = 0; n < 2; ++n) { const f32x4 bs = ai == 0 ? pre[m][bj][n] : *(const f32x4*)(base + off + bj * HALF + n * 16); f32x4 o = bs + (acc[ai][bj][m][n] - sr.x) * sr.y;
                        if (bad) o = (f32x4){qnan, qnan, qnan, qnan}; *(f32x4*)(out + off + bj * HALF + n * 16) = o; }
                if (m & 1) asm volatile("" ::: "memory"); }
    }
};
struct EpiLnResLn {
    static constexpr bool PERM = false, AFTER_DRAIN = true;
    const float* base; float* out; bf16_t* xn; int ldc; const float* bias; PanelStats st1, st2; unsigned poison;
    __device__ __forceinline__ void fused(f32x4 (&acc)[2][2][4][2], const Unit& u, int wr, int wc, int fr, int fq, PG8_LAS unsigned char* lds, int wid, int lane) const {
        typedef float f32x2v __attribute__((ext_vector_type(2))); typedef unsigned u32x2v __attribute__((ext_vector_type(2)));
        const PG8_LAS f32x2v* S = (const PG8_LAS f32x2v*)(lds + 8192);
        const int col0 = u.pn * BM + wc * 32 + 4 * fq;
#pragma unroll
        for (int bj = 0; bj < 2; ++bj)
#pragma unroll
            for (int n = 0; n < 2; ++n) { const f32x4 bv = bias ? *(const f32x4*)(bias + col0 + bj * HALF + n * 16) : (f32x4){0.f, 0.f, 0.f, 0.f};
#pragma unroll
                for (int ai = 0; ai < 2; ++ai)
#pragma unroll
                    for (int m = 0; m < 4; ++m) acc[ai][bj][m][n] += bv; }
        bool bad = st1.run(acc, u, wr, wc, fr, fq, lds, wid, lane) || poison != 0u;
        const float qnan = __builtin_nanf("");
#pragma unroll
        for (int ai = 0; ai < 2; ++ai)
#pragma unroll
            for (int m = 0; m < 4; ++m) { const int r = ai * HALF + wr * 64 + m * 16 + fr; const f32x2v sr = S[r]; const size_t off = (size_t)(u.pm * BM + r) * ldc + col0;
#pragma unroll
                for (int bj = 0; bj < 2; ++bj)
#pragma unroll
                    for (int n = 0; n < 2; ++n) { const f32x4 bs = *(const f32x4*)(base + off + bj * HALF + n * 16); acc[ai][bj][m][n] = bs + (acc[ai][bj][m][n] - sr.x) * sr.y; }
                asm volatile("" : "+v"(acc[ai][0][m][0]), "+v"(acc[ai][0][m][1]), "+v"(acc[ai][1][m][0]), "+v"(acc[ai][1][m][1]));
                if (m & 1) asm volatile("" ::: "memory"); }
        const bool bad1 = bad;
        bad = st2.run(acc, u, wr, wc, fr, fq, lds, wid, lane) || bad;
#pragma unroll
        for (int ai = 0; ai < 2; ++ai)
#pragma unroll
            for (int m = 0; m < 4; ++m) { const int r = ai * HALF + wr * 64 + m * 16 + fr; const f32x2v sr = S[r]; const size_t off = (size_t)(u.pm * BM + r) * ldc + col0;
#pragma unroll
                for (int bj = 0; bj < 2; ++bj)
#pragma unroll
                    for (int n = 0; n < 2; ++n) { const f32x4 x1 = acc[ai][bj][m][n]; *(f32x4*)(out + off + bj * HALF + n * 16) = bad1 ? (f32x4){qnan, qnan, qnan, qnan} : x1;
                        const f32x4 o = (x1 - sr.x) * sr.y; u32x2v w; w.x = cvt_pk_bf16(o[0], o[1]); w.y = cvt_pk_bf16(o[2], o[3]);
                        if (bad) { w.x = 0x7fc07fc0u; w.y = 0x7fc07fc0u; } *(u32x2v*)(xn + off + bj * HALF + n * 16) = w; }
                asm volatile("" ::: "memory"); }
    }
};

template <class Epi, class Sched, bool ALIGN_EPI = false, bool SP2 = false>
__device__ __forceinline__ void gemm_phase(PG8_LAS unsigned char* lds, const Gemm g, const Sched& S, const Epi& E) {
    const int tid = opq_tid(), wid = __builtin_amdgcn_readfirstlane(tid >> 6), lane = tid & 63, wr = wid >> 2, wc = wid & 3, fr = lane & 15, fq = lane >> 4;
    const int K = g.K, nt = K / BK;
    unsigned voffA[2], voffB[2];
#pragma unroll
    for (int i = 0; i < 2; ++i) { int R, C; stage_rc(tid * 16 + i * 8192, R, C); const int Rb = Epi::PERM ? ((R & ~31) + perm32(R & 31)) : R;
        voffA[i] = (unsigned)(R * K + C) * 2u; voffB[i] = (unsigned)(Rb * K + C) * 2u; }
    const size_t kstep = (size_t)(BK * 2);
    const size_t hstep = (size_t)HALF * K * 2;
    const size_t tstep = 2 * hstep;
    const unsigned ldsw = (unsigned)wid * 1024u;
    const int aoff = lds_byte(wr * 64 + fr, fq * 8), boff = lds_byte(wc * 32 + fr, fq * 8);
#define PG8_SA(b, h) (((b) * 2 + (h)) * HTB)
#define PG8_SB(b, h) ((4 + (b) * 2 + (h)) * HTB)
#define PG8_STAGE(bufoff, gbase, voff) do { _Pragma("unroll") for (int _i = 0; _i < 2; ++_i) \
        __builtin_amdgcn_global_load_lds((const unsigned*)((const char*)(gbase) + (voff)[_i]), (PG8_LAS unsigned*)(lds + (bufoff) + ldsw + _i * 8192), 16, 0, 0); } while (0)
#define PG8_LDA(dst, b, h) do { _Pragma("unroll") for (int m = 0; m < 4; ++m) _Pragma("unroll") for (int k = 0; k < 2; ++k) dst[m][k] = *(const PG8_LAS bf16x8*)(lds + PG8_SA(b, h) + aoff + m * 2048 + k * 1024); } while (0)
#define PG8_LDB(dst, b, h) do { _Pragma("unroll") for (int n = 0; n < 2; ++n) _Pragma("unroll") for (int k = 0; k < 2; ++k) dst[n][k] = *(const PG8_LAS bf16x8*)(lds + PG8_SB(b, h) + boff + n * 2048 + k * 1024); } while (0)
#define PG8_MMA(ai, bj, At, Bt) do { __builtin_amdgcn_s_setprio(1); _Pragma("unroll") for (int m = 0; m < 4; ++m) _Pragma("unroll") for (int n = 0; n < 2; ++n) _Pragma("unroll") for (int k = 0; k < 2; ++k) \
        acc[ai][bj][m][n] = __builtin_amdgcn_mfma_f32_16x16x32_bf16(Bt[n][k], At[m][k], acc[ai][bj][m][n], 0, 0, 0); __builtin_amdgcn_s_setprio(0); } while (0)
#define PG8_WAIT_V(n) asm volatile("s_waitcnt vmcnt(" #n ")" ::: "memory")
#define PG8_WAIT_L(n) asm volatile("s_waitcnt lgkmcnt(" #n ")" ::: "memory")
#define PG8_BAR __builtin_amdgcn_s_barrier()
#define PG8_SCHED __builtin_amdgcn_sched_barrier(0)
    Unit cur, nxt; int ui = 0;
    if (!S.next(0, cur)) return;
    f32x4 acc[2][2][4][2];
#pragma unroll
    for (int a = 0; a < 2; ++a)
#pragma unroll
        for (int b = 0; b < 2; ++b)
#pragma unroll
            for (int m = 0; m < 4; ++m)
#pragma unroll
                for (int n = 0; n < 2; ++n) acc[a][b][m][n] = (f32x4){0.f, 0.f, 0.f, 0.f};
    bf16x8 At[4][2], B0[2][2], B1[2][2];
    const char* cA = (const char*)g.A + (size_t)cur.pm * tstep; const char* cB = (const char*)g.Bt + (size_t)cur.pn * tstep;
    S.a_ready(cur);
    if constexpr (SP2) {
        PG8_STAGE(PG8_SB(0, 0), cB, voffB); PG8_STAGE(PG8_SB(0, 1), cB + hstep, voffB); PG8_STAGE(PG8_SA(0, 0), cA, voffA); PG8_STAGE(PG8_SA(0, 1), cA + hstep, voffA);
        if (wr == 1) PG8_BAR;
        PG8_WAIT_V(2); PG8_BAR;
        PG8_STAGE(PG8_SB(1, 0), cB + kstep, voffB); PG8_STAGE(PG8_SA(1, 0), cA + kstep, voffA); PG8_STAGE(PG8_SB(1, 1), cB + hstep + kstep, voffB);
        PG8_WAIT_V(6); PG8_BAR;
    } else {
        PG8_STAGE(PG8_SB(0, 0), cB, voffB); PG8_STAGE(PG8_SA(0, 0), cA, voffA); PG8_STAGE(PG8_SB(0, 1), cB + hstep, voffB); PG8_STAGE(PG8_SA(0, 1), cA + hstep, voffA);
        if (wr == 1) PG8_BAR;
        PG8_WAIT_V(4); PG8_BAR;
        PG8_STAGE(PG8_SB(1, 0), cB + kstep, voffB); PG8_STAGE(PG8_SA(1, 0), cA + kstep, voffA); PG8_STAGE(PG8_SB(1, 1), cB + hstep + kstep, voffB);
        PG8_WAIT_V(6); PG8_BAR;
    }
    for (;;) {
        const bool has_next = S.next(ui + 1, nxt);
        const char* nA = has_next ? (const char*)g.A + (size_t)nxt.pm * tstep : cA; const char* nB = has_next ? (const char*)g.Bt + (size_t)nxt.pn * tstep : cB;
        for (int t = 0; t < nt; t += 2) {
            const bool last = (t == nt - 2);
            const char* a1 = cA + (size_t)(t + 1) * kstep;
            const char* a2 = last ? nA : cA + (size_t)(t + 2) * kstep; const char* b2 = last ? nB : cB + (size_t)(t + 2) * kstep;
            const char* a3 = a2 + kstep; const char* b3 = b2 + kstep;
            if (last && has_next) S.a_ready(nxt);
            if constexpr (SP2) {
            PG8_LDB(B0, 0, 0); PG8_LDB(B1, 0, 1); PG8_SCHED; PG8_LDA(At, 0, 0); PG8_STAGE(PG8_SA(1, 1), a1 + hstep, voffA);
            PG8_WAIT_V(8); PG8_WAIT_L(0); PG8_BAR; PG8_MMA(0, 0, At, B0); PG8_MMA(0, 1, At, B1); PG8_BAR; PG8_SCHED;
            PG8_LDA(At, 0, 1); PG8_STAGE(PG8_SB(0, 0), b2, voffB); PG8_STAGE(PG8_SB(0, 1), b2 + hstep, voffB); PG8_STAGE(PG8_SA(0, 0), a2, voffA);
            PG8_WAIT_V(8); PG8_WAIT_L(0); PG8_BAR; PG8_MMA(1, 0, At, B0); PG8_MMA(1, 1, At, B1); PG8_BAR; PG8_SCHED;
            PG8_LDB(B0, 1, 0); PG8_LDB(B1, 1, 1); PG8_SCHED; PG8_LDA(At, 1, 0); PG8_STAGE(PG8_SA(0, 1), a2 + hstep, voffA);
            PG8_WAIT_V(8); PG8_WAIT_L(0); PG8_BAR; PG8_MMA(0, 0, At, B0); PG8_MMA(0, 1, At, B1); PG8_BAR; PG8_SCHED;
            PG8_LDA(At, 1, 1); PG8_STAGE(PG8_SB(1, 0), b3, voffB); PG8_STAGE(PG8_SB(1, 1), b3 + hstep, voffB); PG8_STAGE(PG8_SA(1, 0), a3, voffA);
            PG8_WAIT_V(8); PG8_WAIT_L(0); PG8_BAR; PG8_MMA(1, 0, At, B0); PG8_MMA(1, 1, At, B1); PG8_BAR; PG8_SCHED;
            } else {
            PG8_LDB(B0, 0, 0); PG8_SCHED; PG8_LDA(At, 0, 0); PG8_STAGE(PG8_SA(1, 1), a1 + hstep, voffA);
            PG8_WAIT_L(8); PG8_BAR; PG8_WAIT_L(0); PG8_MMA(0, 0, At, B0); PG8_BAR; PG8_SCHED;
            PG8_LDB(B1, 0, 1); PG8_STAGE(PG8_SB(0, 0), b2, voffB);
            PG8_BAR; PG8_WAIT_L(0); PG8_MMA(0, 1, At, B1); PG8_BAR;
            PG8_LDA(At, 0, 1); PG8_STAGE(PG8_SA(0, 0), a2, voffA);
            PG8_BAR; PG8_WAIT_L(0); PG8_MMA(1, 0, At, B0); PG8_BAR; PG8_SCHED;
            PG8_STAGE(PG8_SB(0, 1), b2 + hstep, voffB);
            PG8_WAIT_V(6); PG8_BAR; PG8_MMA(1, 1, At, B1); PG8_BAR;
            PG8_LDB(B0, 1, 0); PG8_SCHED; PG8_LDA(At, 1, 0); PG8_STAGE(PG8_SA(0, 1), a2 + hstep, voffA);
            PG8_WAIT_L(8); PG8_BAR; PG8_WAIT_L(0); PG8_MMA(0, 0, At, B0); PG8_BAR; PG8_SCHED;
            PG8_LDB(B1, 1, 1); PG8_STAGE(PG8_SB(1, 0), b3, voffB);
            PG8_BAR; PG8_WAIT_L(0); PG8_MMA(0, 1, At, B1); PG8_BAR;
            PG8_LDA(At, 1, 1); PG8_STAGE(PG8_SA(1, 0), a3, voffA);
            PG8_BAR; PG8_WAIT_L(0); PG8_MMA(1, 0, At, B0); PG8_BAR; PG8_SCHED;
            PG8_STAGE(PG8_SB(1, 1), b3 + hstep, voffB);
            PG8_WAIT_V(6); PG8_BAR; PG8_MMA(1, 1, At, B1); PG8_BAR;
            }
        }
        if constexpr (ALIGN_EPI) { if (wr == 0) PG8_BAR; }
        if constexpr (!Epi::AFTER_DRAIN) { E(acc, cur, wr, wc, fr, fq); S.done(cur); }
        if (!has_next) break;
#pragma unroll
        for (int a = 0; a < 2; ++a)
#pragma unroll
            for (int b = 0; b < 2; ++b)
#pragma unroll
                for (int m = 0; m < 4; ++m)
#pragma unroll
                    for (int n = 0; n < 2; ++n) acc[a][b][m][n] = (f32x4){0.f, 0.f, 0.f, 0.f};
        cur = nxt; cA = nA; cB = nB; ++ui;
        if constexpr (ALIGN_EPI) { if (wr == 1) PG8_BAR; }
    }
    PG8_WAIT_V(0);
    if constexpr (!ALIGN_EPI) { if (wr == 0) PG8_BAR; }
    PG8_BAR;
    if constexpr (Epi::AFTER_DRAIN) { E.fused(acc, cur, wr, wc, fr, fq, lds, wid, lane); S.done(cur); }
#undef PG8_SA
#undef PG8_SB
#undef PG8_STAGE
#undef PG8_LDA
#undef PG8_LDB
#undef PG8_MMA
#undef PG8_WAIT_V
#undef PG8_WAIT_L
#undef PG8_BAR
#undef PG8_SCHED
}
}
namespace pg8 {
struct EpiF32 {
    static constexpr bool PERM = false, AFTER_DRAIN = false;
    float* C; int ldc;
    __device__ __forceinline__ void operator()(const f32x4 (&acc)[2][2][4][2], const Unit& u, int wr, int wc, int fr, int fq) const {
        const int row0 = u.pm * BM + wr * 64 + fr, col0 = u.pn * BM + wc * 32 + 4 * fq;
#pragma unroll
        for (int ai = 0; ai < 2; ++ai)
#pragma unroll
            for (int m = 0; m < 4; ++m) { float* rowp = C + (size_t)(row0 + ai * HALF + m * 16) * ldc + col0;
#pragma unroll
                for (int bj = 0; bj < 2; ++bj)
#pragma unroll
                    for (int n = 0; n < 2; ++n) *(f32x4*)(rowp + bj * HALF + n * 16) = acc[ai][bj][m][n]; }
    }
};
__device__ __forceinline__ float bf_lo(unsigned w) { return __uint_as_float(w << 16); }
__device__ __forceinline__ float bf_hi(unsigned w) { return __uint_as_float(w & 0xffff0000u); }
__device__ __forceinline__ float sigmoidf_(float x) { return 1.0f / (1.0f + __expf(-x)); }
struct EpiMerge {
    static constexpr bool PERM = true, AFTER_DRAIN = false;
    bf16_t* Mg; const bf16_t* glog; int ldg; int SP;
    __device__ __forceinline__ void operator()(const f32x4 (&acc)[2][2][4][2], const Unit& u, int wr, int wc, int fr, int fq) const {
        const int b = u.pn >> 2, pn = u.pn & 3, pm = u.pm - b * SP;
        const int row0 = pm * BM + wr * 64 + fr, col0 = pn * BM + wc * 32 + 8 * fq;
#pragma unroll
        for (int ai = 0; ai < 2; ++ai)
#pragma unroll
            for (int m = 0; m < 4; ++m) { const size_t row = (size_t)(row0 + ai * HALF + m * 16);
#pragma unroll
                for (int bj = 0; bj < 2; ++bj) { const int col = col0 + bj * HALF;
                    const u32x4 g = *(const u32x4*)(glog + row * ldg + b * 1024 + col);
                    f32x4 v0 = acc[ai][bj][m][0], v1 = acc[ai][bj][m][1];
                    v0[0] *= sigmoidf_(bf_lo(g.x)); v0[1] *= sigmoidf_(bf_hi(g.x)); v0[2] *= sigmoidf_(bf_lo(g.y)); v0[3] *= sigmoidf_(bf_hi(g.y));
                    v1[0] *= sigmoidf_(bf_lo(g.z)); v1[1] *= sigmoidf_(bf_hi(g.z)); v1[2] *= sigmoidf_(bf_lo(g.w)); v1[3] *= sigmoidf_(bf_hi(g.w));
                    u32x4* dst = (u32x4*)(Mg + row * 1024 + col);
                    if (b != 0) { const u32x4 o = *dst;
                        v0[0] += bf_lo(o.x); v0[1] += bf_hi(o.x); v0[2] += bf_lo(o.y); v0[3] += bf_hi(o.y);
                        v1[0] += bf_lo(o.z); v1[1] += bf_hi(o.z); v1[2] += bf_lo(o.w); v1[3] += bf_hi(o.w); }
                    u32x4 w; w.x = cvt_pk_bf16(v0[0], v0[1]); w.y = cvt_pk_bf16(v0[2], v0[3]); w.z = cvt_pk_bf16(v1[0], v1[1]); w.w = cvt_pk_bf16(v1[2], v1[3]);
                    *dst = w; } }
    }
};
struct MergeOrder {
    int NP, SP, nwg, G, c;
    __host__ __device__ void init(int NP_, int SP_, int G_, int c_) { NP = NP_; SP = SP_; nwg = NP_ * 4; G = G_; c = c_; }
    __host__ __device__ bool next(int i, Unit& u) const {
        const int ti = i / 3, b = i - 3 * ti;
        const long L = (long)ti * G + c; if (L >= nwg) return false;
        int wgid = (int)L; { const int q = nwg / NXCD, r = nwg % NXCD, xcd = wgid % NXCD, off = wgid / NXCD; wgid = (xcd < r ? xcd * (q + 1) : r * (q + 1) + (xcd - r) * q) + off; }
        const int nN = 4, nig = WGM * nN, gid = wgid / nig, fm = gid * WGM, gsz = (NP - fm) < WGM ? (NP - fm) : WGM;
        const int pm = fm + ((wgid % nig) % gsz), pn = (wgid % nig) / gsz;
        u.pm = b * SP + pm; u.pn = b * 4 + pn; return true;
    }
    __device__ __forceinline__ void a_ready(const Unit&) const {}
    __device__ __forceinline__ void done(const Unit&) const {}
};
}
#include <hip/hip_bf16.h>
#include <cmath>
namespace attn_body {
using bf16=__hip_bfloat16;
using bf16x8=__attribute__((ext_vector_type(8)))short;
using s16x4=__attribute__((ext_vector_type(4)))short;
using f32x16=__attribute__((ext_vector_type(16)))float;
using u32x4=__attribute__((ext_vector_type(4)))unsigned;
constexpr int D=64;
constexpr int NW=8,QBLK=32,QB=QBLK*NW,KVBLK=64;
constexpr int ATTN_UNIT_ROWS=QB;
__device__ __forceinline__ int crow(int r,int hi){return (r&3)+8*(r>>2)+4*hi;}
#define SBAR() __builtin_amdgcn_sched_barrier(0)
constexpr int WIN=128;
__device__ __forceinline__ void wmask(f32x16&p0,f32x16&p1,int kd){
  const float NEG=-INFINITY;
  #pragma unroll
  for(int r=0;r<16;++r){const int d0=kd+(r&3)+8*(r>>2); if(d0>WIN||d0<-WIN)p0[r]=NEG; const int d1=d0+32; if(d1>WIN||d1<-WIN)p1[r]=NEG;}
}
struct AttnJob {
  const bf16* Q; const bf16* K; const bf16* V; bf16* O;
  int qp, kp, op;
  int nt, nt0, row1;
  int qpos0, kpos1;
  float sink2;
};
constexpr int NSLOT=3, SLOTB=8192;
constexpr int LDS_K=0, LDS_V=NSLOT*SLOTB, LDS_WS=2*NSLOT*SLOTB, LDS_OST=LDS_WS+NW*64*4, LDS_BYTES=LDS_OST+NW*4096;
constexpr float C2=0.125f*1.4426950408889634f;
__device__ __forceinline__ void glds16(const void*gsrc,unsigned lds_dst){unsigned keep;
  asm volatile("s_mov_b32 %0, m0\n\ts_mov_b32 m0, %2\n\ts_nop 0\n\tglobal_load_lds_dwordx4 %1, off\n\ts_mov_b32 m0, %0":"=&s"(keep):"v"(gsrc),"s"(lds_dst):"memory");}
__device__ __forceinline__ float max3f(float a,float b,float c){float r;asm("v_max3_f32 %0, %1, %2, %3":"=v"(r):"v"(a),"v"(b),"v"(c));return r;}
__device__ __forceinline__ float max2f(float a,float b){float r;asm("v_max_f32_e32 %0, %1, %2":"=v"(r):"v"(a),"v"(b));return r;}
__device__ __forceinline__ float fadd_s(float a,float b){float r;asm("v_add_f32_e32 %0, %1, %2":"=v"(r):"v"(a),"v"(b));return r;}
__device__ __forceinline__ float fsub_s(float a,float b){float r;asm("v_sub_f32_e32 %0, %1, %2":"=v"(r):"v"(a),"v"(b));return r;}
typedef float f32x2_t __attribute__((ext_vector_type(2))); typedef __bf16 bf16x2_t __attribute__((ext_vector_type(2)));
__device__ __forceinline__ unsigned cvtpk_s(float lo,float hi){f32x2_t v={lo,hi};bf16x2_t b=__builtin_convertvector(v,bf16x2_t);return __builtin_bit_cast(unsigned,b);}
#define WAIT_BAR(N) asm volatile("s_waitcnt vmcnt(" #N ") lgkmcnt(0)\n\ts_barrier":::"memory")

__device__ __forceinline__ void qkt(f32x16&p0,f32x16&p1,const char*Kslot,const bf16x8*qr,const f32x16&negm,int r32,int hi){
  const char*kb=Kslot+hi*1024+r32*16;
  #pragma unroll
  for(int d0=0;d0<4;++d0){
    const bf16x8 b0=*reinterpret_cast<const bf16x8*>(kb+d0*2048);
    const bf16x8 b1=*reinterpret_cast<const bf16x8*>(kb+d0*2048+512);
    if(d0==0){p0=__builtin_amdgcn_mfma_f32_32x32x16_bf16(b0,qr[0],negm,0,0,0);p1=__builtin_amdgcn_mfma_f32_32x32x16_bf16(b1,qr[0],negm,0,0,0);}
    else{p0=__builtin_amdgcn_mfma_f32_32x32x16_bf16(b0,qr[d0],p0,0,0,0);p1=__builtin_amdgcn_mfma_f32_32x32x16_bf16(b1,qr[d0],p1,0,0,0);}}
}
typedef __attribute__((address_space(3))) const char* lds_cptr;
typedef short v4i16_t __attribute__((ext_vector_type(4)));
__device__ __forceinline__ void kload8(bf16x8*kf,lds_cptr kp){
  kf[0]=*(const __attribute__((address_space(3))) bf16x8*)(kp);      kf[1]=*(const __attribute__((address_space(3))) bf16x8*)(kp+512);
  kf[2]=*(const __attribute__((address_space(3))) bf16x8*)(kp+2048); kf[3]=*(const __attribute__((address_space(3))) bf16x8*)(kp+2560);
  kf[4]=*(const __attribute__((address_space(3))) bf16x8*)(kp+4096); kf[5]=*(const __attribute__((address_space(3))) bf16x8*)(kp+4608);
  kf[6]=*(const __attribute__((address_space(3))) bf16x8*)(kp+6144); kf[7]=*(const __attribute__((address_space(3))) bf16x8*)(kp+6656);
}
__device__ __forceinline__ void kload2(bf16x8*kf,lds_cptr kp,int j){ kf[2*j]=*(const __attribute__((address_space(3))) bf16x8*)(kp+j*2048); kf[2*j+1]=*(const __attribute__((address_space(3))) bf16x8*)(kp+j*2048+512); }
__device__ __forceinline__ s16x4 vtr(lds_cptr p){ return __builtin_bit_cast(s16x4,__builtin_amdgcn_ds_read_tr16_b64_v4i16((__attribute__((address_space(3))) v4i16_t*)p)); }
__device__ __forceinline__ float rowmax(const f32x16&p0,const f32x16&p1){
  float a=max3f(p0[0],p0[1],p1[0]),b=max3f(p0[2],p0[3],p1[1]);a=max3f(a,p1[2],p1[3]);
  #pragma unroll
  for(int r=4;r<16;r+=4){a=max3f(a,p0[r],p0[r+1]);b=max3f(b,p0[r+2],p0[r+3]);a=max3f(a,p1[r],p1[r+1]);b=max3f(b,p1[r+2],p1[r+3]);}
  const float m=max2f(a,b);
  auto rr=__builtin_amdgcn_permlane32_swap(__float_as_uint(m),__float_as_uint(m),false,false);
  return max2f(__uint_as_float(rr[0]),__uint_as_float(rr[1]));
}
__device__ __forceinline__ void pv(f32x16*o,int vb,bf16x8 pa0,bf16x8 pa1,bf16x8 pa2,bf16x8 pa3){
  #pragma unroll
  for(int d0=0;d0<2;++d0){s16x4 lo[4],hi[4];
    #pragma unroll
    for(int ks=0;ks<4;++ks){
      asm volatile("ds_read_b64_tr_b16 %0,%1 offset:%c2":"=&v"(lo[ks]):"v"(vb),"i"(d0*4096+ks*1024):"memory");
      asm volatile("ds_read_b64_tr_b16 %0,%1 offset:%c2":"=&v"(hi[ks]):"v"(vb),"i"(d0*4096+ks*1024+512):"memory");}
    asm volatile("s_waitcnt lgkmcnt(0)":::"memory");SBAR();
    #define PK(k) (bf16x8){lo[k][0],lo[k][1],lo[k][2],lo[k][3],hi[k][0],hi[k][1],hi[k][2],hi[k][3]}
    o[d0]=__builtin_amdgcn_mfma_f32_32x32x16_bf16(pa0,PK(0),o[d0],0,0,0);
    o[d0]=__builtin_amdgcn_mfma_f32_32x32x16_bf16(pa1,PK(1),o[d0],0,0,0);
    o[d0]=__builtin_amdgcn_mfma_f32_32x32x16_bf16(pa2,PK(2),o[d0],0,0,0);
    o[d0]=__builtin_amdgcn_mfma_f32_32x32x16_bf16(pa3,PK(3),o[d0],0,0,0);
    #undef PK
  }
}

#ifndef ATTN_STORE16
#define ATTN_STORE16(p,v) (*(u32x4*)(p)=(v))
#endif
template<int THRL,int MODE> __device__ __forceinline__ void attn_unit(const AttnJob&J,char*shm){
  const int QP=J.qp,KP=J.kp,OP=J.op,NT0=J.nt0,ROW1=J.row1;
  const int tid=opq_tid(),lane=tid&63,r32=lane&31,hi=lane>>5; const int wid=__builtin_amdgcn_readfirstlane(tid>>6);
  const bf16*Qw=J.Q+(long)(wid*QBLK)*QP;
  const bf16*Kh=J.K,*Vh=J.V;
  const unsigned lds0=(unsigned)(uintptr_t)shm;
  float*wsf=(float*)(shm+LDS_WS)+wid*64;
  const bf16*ksrc=Kh+(long)lane*KP+wid*8;
  const bf16*vsrc=Vh+(long)(16*(wid&3)+(lane>>2))*KP+(wid>>2)*32+(lane&3)*8;
  const unsigned kdst=lds0+LDS_K+wid*1024, vdst=lds0+LDS_V+wid*1024;
  #define TROW(t) ((t)<NT0?(t)*KVBLK:ROW1+((t)-NT0)*KVBLK)
  #define DMA_K(t,slot) glds16(ksrc+(long)TROW(t)*KP,(unsigned)__builtin_amdgcn_readfirstlane(kdst+(slot)))
  #define DMA_V(t,slot) glds16(vsrc+(long)TROW(t)*KP,(unsigned)__builtin_amdgcn_readfirstlane(vdst+(slot)))
  const int vb0=(int)(lds0+LDS_V)+((lane>>4)&1)*32+(lane&3)*8+(4*hi+((lane&15)>>2))*64;
  const char*Kbase=shm+LDS_K; bf16x8 kf[8];
  const lds_cptr shm3=(lds_cptr)shm; const lds_cptr kp0=shm3+LDS_K+hi*1024+r32*16; const lds_cptr vp0=shm3+LDS_V+((lane>>4)&1)*32+(lane&3)*8+(4*hi+((lane&15)>>2))*64;
  const int NT=J.nt;
  DMA_K(0,0);DMA_V(0,0);DMA_K(1,SLOTB);
  bf16x8 qr[4];
  #pragma unroll
  for(int d0=0;d0<4;++d0)qr[d0]=*reinterpret_cast<const bf16x8*>(&Qw[(long)r32*QP+d0*16+hi*8]);
  float mhat=0.f,l_reg=0.f;f32x16 o[2];o[0]=f32x16{};o[1]=f32x16{};f32x16 negm=f32x16{};if constexpr(MODE==0)asm volatile("":"+v"(negm));
  const int kd0=J.kpos1+4*hi-(J.qpos0+wid*QBLK+r32);
  #define CMASK(P0,P1,t) do{ if constexpr(MODE==1){ if((t)>=NT0) wmask(P0,P1,kd0+((t)-NT0)*KVBLK); } }while(0)
  bool resc=false;
  #define START(P0,P1) do{ const float rm=rowmax(P0,P1); resc=false; \
    { const float dl=rm; mhat=fadd_s(mhat,dl); \
      _Pragma("unroll") for(int r=0;r<16;++r){P0[r]=fsub_s(P0[r],dl);P1[r]=fsub_s(P1[r],dl);} \
      if constexpr(MODE==0){ _Pragma("unroll") for(int r=0;r<16;++r)negm[r]=-mhat; asm volatile("":"+v"(negm)); } } \
    _Pragma("unroll") for(int r=0;r<16;++r)P0[r]=__builtin_amdgcn_exp2f(P0[r]); }while(0)
  #define RESC() do{ if(resc){ asm volatile("s_waitcnt lgkmcnt(0)":::"memory"); \
      _Pragma("unroll") for(int d_=0;d_<2;++d_) _Pragma("unroll") for(int r=0;r<16;++r)o[d_][r]*=wsf[crow(r,hi)]; } }while(0)
  f32x16 pA0,pA1,pB0,pB1;
  int sl_prev=0,sl_cur=0,sl_next=SLOTB;
  #define ROT() do{sl_prev=sl_cur;sl_cur=sl_next;sl_next=(sl_next==(NSLOT-1)*SLOTB)?0:sl_next+SLOTB;}while(0)
  DMA_K(2,2*SLOTB);
  WAIT_BAR(3);
  qkt(pA0,pA1,Kbase,qr,f32x16{},r32,hi);asm volatile("s_nop 15\n\ts_nop 7":"+v"(pA0),"+v"(pA1));CMASK(pA0,pA1,0);
  START(pA0,pA1);
  _Pragma("unroll") for(int r=0;r<16;++r)pA1[r]=__builtin_amdgcn_exp2f(pA1[r]);
  WAIT_BAR(0);
  DMA_K(3,0);DMA_V(1,SLOTB);
  ROT();
  kload8(kf,kp0+sl_cur);
  WAIT_BAR(2);
  s16x4 vlo[8],vhi[8]; u32x4 pw0,pw1,pw2,pw3;
  #define PKW(P,B) cvtpk_s(P[B],P[B+1])
  #define PAF(k) __builtin_bit_cast(bf16x8,pw##k)
  #define VFR(i) (bf16x8){vlo[i][0],vlo[i][1],vlo[i][2],vlo[i][3],vhi[i][0],vhi[i][1],vhi[i][2],vhi[i][3]}
  #define PIN(x) asm volatile("":"+v"(x))
  #define MX3(a,b,c) __builtin_fmaxf(__builtin_fmaxf((a),(b)),(c))
  #define GAPA(MF,A0,A1,A2,A3,W0,W1,PW) do{ MF; sacc+=A0; sacc+=A1; sacc+=A2; sacc+=A3; PIN(sacc); W0; W1; PIN(PW); SBAR(); }while(0)
  #define EX(v) __builtin_amdgcn_exp2f(MODE==1?(v)-mhat:(v))
  #define CINIT (MODE==1?f32x16{}:negm)
  #define GAPB(MF,X,B) do{ MF; X[B]=EX(X[B]); X[B+1]=EX(X[B+1]); X[B+2]=EX(X[B+2]); X[B+3]=EX(X[B+3]); PIN(X); SBAR(); }while(0)
  #define VRD(i) do{ vlo[i]=vtr(vp_+(((i)>>2)*4096+((i)&3)*1024)); vhi[i]=vtr(vp_+(((i)>>2)*4096+((i)&3)*1024+512)); }while(0)
  #define KRD(G,j) do{ if(G){ kload2(kf,kp0+sl_next,j); SBAR(); } }while(0)
  #define STEP(C0,C1,P0,P1,t,GK,GV,GL) do{ SBAR(); \
    const lds_cptr vp_=vp0+sl_prev; \
    VRD(0); SBAR(); float sacc=(P0[0]+P0[1]); \
    GAPA(C0=__builtin_amdgcn_mfma_f32_32x32x16_bf16(kf[0],qr[0],CINIT,0,0,0), P0[2],P0[3],P0[4],P0[5],     pw0[0]=PKW(P0,0), pw0[1]=PKW(P0,2), pw0); \
    VRD(4); SBAR(); GAPA(C1=__builtin_amdgcn_mfma_f32_32x32x16_bf16(kf[1],qr[0],CINIT,0,0,0), P0[6],P0[7],P0[8],P0[9],     pw0[2]=PKW(P0,4), pw0[3]=PKW(P0,6), pw0); \
    VRD(1); SBAR(); GAPA(C0=__builtin_amdgcn_mfma_f32_32x32x16_bf16(kf[2],qr[1],C0,0,0,0),   P0[10],P0[11],P0[12],P0[13], pw1[0]=PKW(P0,8), pw1[1]=PKW(P0,10), pw1); \
    VRD(5); SBAR(); GAPA(C1=__builtin_amdgcn_mfma_f32_32x32x16_bf16(kf[3],qr[1],C1,0,0,0),   P0[14],P0[15],P1[0],P1[1],   pw1[2]=PKW(P0,12),pw1[3]=PKW(P0,14), pw1); \
    VRD(2); SBAR(); GAPA(C0=__builtin_amdgcn_mfma_f32_32x32x16_bf16(kf[4],qr[2],C0,0,0,0),   P1[2],P1[3],P1[4],P1[5],     pw2[0]=PKW(P1,0), pw2[1]=PKW(P1,2), pw2); \
    VRD(6); SBAR(); GAPA(C1=__builtin_amdgcn_mfma_f32_32x32x16_bf16(kf[5],qr[2],C1,0,0,0),   P1[6],P1[7],P1[8],P1[9],     pw2[2]=PKW(P1,4), pw2[3]=PKW(P1,6), pw2); \
    VRD(3); SBAR(); GAPA(C0=__builtin_amdgcn_mfma_f32_32x32x16_bf16(kf[6],qr[3],C0,0,0,0),   P1[10],P1[11],P1[12],P1[13], pw3[0]=PKW(P1,8), pw3[1]=PKW(P1,10), pw3); \
    VRD(7); SBAR(); GAPA(C1=__builtin_amdgcn_mfma_f32_32x32x16_bf16(kf[7],qr[3],C1,0,0,0),   P1[14],P1[15],0.f,0.f,       pw3[2]=PKW(P1,12),pw3[3]=PKW(P1,14), pw3); \
    l_reg+=sacc; \
    if(GK){DMA_K((t)+3,sl_cur);} if(GV){DMA_V((t)+1,sl_next);} \
    CMASK(C0,C1,t); \
    { float a=MX3(C0[0],C0[1],C1[0]),b=MX3(C0[2],C0[3],C1[1]); a=MX3(a,C1[2],C1[3]); \
      _Pragma("unroll") for(int r=4;r<16;r+=4){a=MX3(a,C0[r],C0[r+1]);b=MX3(b,C0[r+2],C0[r+3]);a=MX3(a,C1[r],C1[r+1]);b=MX3(b,C1[r+2],C1[r+3]);} \
      float rm=__builtin_fmaxf(a,b); { auto rr=__builtin_amdgcn_permlane32_swap(__float_as_uint(rm),__float_as_uint(rm),false,false); rm=__builtin_fmaxf(__uint_as_float(rr[0]),__uint_as_float(rr[1])); } \
      if constexpr(MODE==1) rm-=mhat; \
      resc=false; \
      if(__builtin_expect(__any(rm>(float)THRL),0)){ const float dl=__builtin_fmaxf(rm,0.f); mhat+=dl; \
        if constexpr(MODE==0){ _Pragma("unroll") for(int r=0;r<16;++r){C0[r]-=dl;C1[r]-=dl;} \
        _Pragma("unroll") for(int r=0;r<16;++r)negm[r]=-mhat; asm volatile("":"+v"(negm)); } \
        const float f=__builtin_amdgcn_exp2f(-dl); l_reg*=f; if(hi==0)wsf[r32]=f; resc=true; } } \
    SBAR(); \
    GAPB(o[0]=__builtin_amdgcn_mfma_f32_32x32x16_bf16(PAF(0),VFR(0),o[0],0,0,0), C0,0); \
    GAPB(o[1]=__builtin_amdgcn_mfma_f32_32x32x16_bf16(PAF(0),VFR(4),o[1],0,0,0), C0,4); \
    KRD(GL,0); GAPB(o[0]=__builtin_amdgcn_mfma_f32_32x32x16_bf16(PAF(1),VFR(1),o[0],0,0,0), C0,8); \
    KRD(GL,1); GAPB(o[1]=__builtin_amdgcn_mfma_f32_32x32x16_bf16(PAF(1),VFR(5),o[1],0,0,0), C0,12); \
    KRD(GL,2); GAPB(o[0]=__builtin_amdgcn_mfma_f32_32x32x16_bf16(PAF(2),VFR(2),o[0],0,0,0), C1,0); \
    KRD(GL,3); GAPB(o[1]=__builtin_amdgcn_mfma_f32_32x32x16_bf16(PAF(2),VFR(6),o[1],0,0,0), C1,4); \
    GAPB(o[0]=__builtin_amdgcn_mfma_f32_32x32x16_bf16(PAF(3),VFR(3),o[0],0,0,0), C1,8); \
    GAPB(o[1]=__builtin_amdgcn_mfma_f32_32x32x16_bf16(PAF(3),VFR(7),o[1],0,0,0), C1,12); \
    }while(0)
  int t=1;
  for(;t+5<NT;t+=2){
    STEP(pB0,pB1,pA0,pA1,t,true,true,true);     WAIT_BAR(2); RESC(); ROT();
    STEP(pA0,pA1,pB0,pB1,t+1,true,true,true);   WAIT_BAR(2); RESC(); ROT();
  }
  #define ENDW(tt) do{ if((tt)+3<NT){WAIT_BAR(2);} else if((tt)+2<NT){WAIT_BAR(1);} else {WAIT_BAR(0);} }while(0)
  for(;t+1<NT;t+=2){
    STEP(pB0,pB1,pA0,pA1,t,(t+3<NT),(t+1<NT),(t+1<NT));       ENDW(t);   RESC(); ROT();
    STEP(pA0,pA1,pB0,pB1,t+1,(t+4<NT),(t+2<NT),(t+2<NT));     ENDW(t+1); RESC(); ROT();
  }
  STEP(pB0,pB1,pA0,pA1,NT-1,false,false,false); RESC();
  { float sacc=pB0[0]+pB0[1]; _Pragma("unroll") for(int r=2;r<16;++r)sacc+=pB0[r]; _Pragma("unroll") for(int r=0;r<16;++r)sacc+=pB1[r]; l_reg+=sacc;
    pw0=(u32x4){PKW(pB0,0),PKW(pB0,2),PKW(pB0,4),PKW(pB0,6)};pw1=(u32x4){PKW(pB0,8),PKW(pB0,10),PKW(pB0,12),PKW(pB0,14)};pw2=(u32x4){PKW(pB1,0),PKW(pB1,2),PKW(pB1,4),PKW(pB1,6)};pw3=(u32x4){PKW(pB1,8),PKW(pB1,10),PKW(pB1,12),PKW(pB1,14)};
    SBAR(); pv(o,vb0+sl_cur,PAF(0),PAF(1),PAF(2),PAF(3)); }
  #undef PKW
  #undef PAF
  #undef VFR
  #undef PIN
  #undef MX3
  #undef GAPA
  #undef GAPB
  #undef EX
  #undef CINIT
  #undef VRD
  #undef KRD
  #undef STEP
  #undef ENDW
  {auto rr=__builtin_amdgcn_permlane32_swap(__float_as_uint(l_reg),__float_as_uint(l_reg),false,false);l_reg=__uint_as_float(rr[0])+__uint_as_float(rr[1]);}
  l_reg+=__builtin_amdgcn_exp2f(J.sink2-mhat);
  if(hi==0)wsf[32+r32]=l_reg;asm volatile("s_waitcnt lgkmcnt(0)":::"memory");
  float rli[16];
  #pragma unroll
  for(int r=0;r<16;++r)rli[r]=__builtin_amdgcn_rcpf(wsf[32+crow(r,hi)]);
  bf16*Ow=J.O+(long)(wid*QBLK)*OP;
  { bf16*stg=(bf16*)(shm+LDS_OST)+wid*2048;
    #pragma unroll
    for(int r=0;r<16;++r){const int orow=crow(r,hi);
      #pragma unroll
      for(int d0=0;d0<2;++d0)stg[orow*64+d0*32+r32]=__float2bfloat16(o[d0][r]*rli[r]);}
    asm volatile("s_waitcnt lgkmcnt(0)":::"memory");
    #pragma unroll
    for(int i=0;i<4;++i){const int row=i*8+(lane>>3),ch=lane&7; const u32x4 v=*(const u32x4*)(stg+row*64+ch*8); ATTN_STORE16(Ow+(long)row*OP+ch*8,v);} }
  asm volatile("s_waitcnt lgkmcnt(0)\n\ts_barrier":::"memory");
  #undef TROW
  #undef DMA_K
  #undef DMA_V
  #undef CMASK
  #undef START
  #undef RESC
  #undef ROT
}
constexpr int ATTN_LDS_BYTES=LDS_BYTES;
#undef SBAR
#undef WAIT_BAR
}
#define GAS __attribute__((address_space(1)))
#define LAS __attribute__((address_space(3)))
typedef unsigned short bf16;
typedef unsigned v4u __attribute__((ext_vector_type(4)));
typedef float f32x4 __attribute__((ext_vector_type(4)));
typedef short bf16x8 __attribute__((ext_vector_type(8)));
typedef GAS unsigned gu32;
typedef GAS unsigned long long gu64;
#define RLX_AGENT __ATOMIC_RELAXED, __HIP_MEMORY_SCOPE_AGENT
#define LDS_WAIT() asm volatile("s_waitcnt lgkmcnt(0)" ::: "memory")
#define VM_WAIT() asm volatile("s_waitcnt vmcnt(0)" ::: "memory")
__device__ __forceinline__ unsigned long long rt() { return __builtin_amdgcn_s_memrealtime(); }
__device__ __forceinline__ unsigned f2bf(float f) { unsigned u = __builtin_bit_cast(unsigned, f); return (u + 0x7fffu + ((u >> 16) & 1u)) >> 16; }
__device__ __forceinline__ unsigned pk2(float lo, float hi) { return f2bf(lo) | (f2bf(hi) << 16); }

#define XB_TMO      128
#define XB_XCNT(j)  (256  + 64 * (j))
#define XB_XSUB(j)  (1280 + 64 * (j))
#define XB_XGEN(j)  (2304 + 64 * (j))
#define XB_TOP      3328
#define XB_TOPGEN   3392
#define XCD_BAR_WORDS 3456
#define XB_SPIN_CAP (1u << 18)

__device__ __forceinline__ unsigned xb_ld(unsigned* p)              { return __hip_atomic_load(p, __ATOMIC_RELAXED, __HIP_MEMORY_SCOPE_AGENT); }
__device__ __forceinline__ unsigned xb_add(unsigned* p, unsigned v) { return __hip_atomic_fetch_add(p, v, __ATOMIC_RELAXED, __HIP_MEMORY_SCOPE_AGENT); }
__device__ __forceinline__ unsigned xb_xcc_id() { return (unsigned)__builtin_amdgcn_s_getreg((3 << 11) | 20) & 0xFu; }
#define XB_SPIN(cond, bar) do { unsigned _sp = 0; while (cond) { __builtin_amdgcn_s_sleep(1); \
    if ((++_sp & 255u) == 0u) { if (xb_ld(&(bar)[XB_TMO])) break; if (_sp > XB_SPIN_CAP) { atomicAdd(&(bar)[XB_TMO], 1u); break; } } } } while (0)

struct XcdBarrier {
    unsigned* bar; unsigned x;
    volatile LAS unsigned* st;
};

__device__ __forceinline__ XcdBarrier xcd_barrier_post(unsigned* bar, volatile LAS unsigned* st) {
    XcdBarrier b; b.bar = bar; b.x = xb_xcc_id(); b.st = st;
    if (opq_tid() == 0) (void)xb_add(&bar[XB_XCNT(b.x)], 1u);
    return b;
}
__device__ __forceinline__ void xcd_barrier_complete(unsigned* bar, unsigned x, unsigned& nloc, unsigned& nx) {
    const unsigned G = gridDim.x * gridDim.y * gridDim.z;
    unsigned sum, cnt, mine, sp = 0u;
    for (;;) {
        sum = 0u; cnt = 0u; mine = 0u;
#pragma unroll
        for (unsigned j = 0; j < 16; ++j) { const unsigned c = xb_ld(&bar[XB_XCNT(j)]); sum += c; cnt += (c > 0u) ? 1u : 0u; mine = (j == x) ? c : mine; }
        if (sum == G) break;
        __builtin_amdgcn_s_sleep(1);
        if ((++sp & 255u) == 0u) { if (xb_ld(&bar[XB_TMO])) break; if (sp > XB_SPIN_CAP) { atomicAdd(&bar[XB_TMO], 1u); break; } }
    }
    nloc = mine > 0u ? mine : 1u; nx = cnt > 0u ? cnt : 1u;
}

__device__ __forceinline__ void xcd_barrier(const XcdBarrier& b) {
    asm volatile("s_waitcnt vmcnt(0)" ::: "memory");
    __syncthreads();
    if (opq_tid() == 0) {
        GAS unsigned* barg = (GAS unsigned*)b.bar; unsigned bxx = b.x; asm volatile("" : "+s"(barg), "+s"(bxx)); unsigned* bar = (unsigned*)barg;
        __builtin_amdgcn_s_waitcnt(0);
        unsigned nloc = b.st[0], nx = b.st[1];
        if (nloc == 0u) { xcd_barrier_complete(bar, bxx, nloc, nx); b.st[0] = nloc; b.st[1] = nx; }
        const unsigned old = xb_add(&bar[XB_XSUB(bxx)], 1u);
        const unsigned gen = old / nloc;
        if (old + 1u == (gen + 1u) * nloc) {
            __builtin_amdgcn_fence(__ATOMIC_RELEASE, "agent");
            asm volatile("s_waitcnt vmcnt(0)" ::: "memory");
            const unsigned og = xb_add(&bar[XB_TOP], 1u);
            const unsigned tg = og / nx;
            if (og + 1u == (tg + 1u) * nx) xb_add(&bar[XB_TOPGEN], 1u);
            else XB_SPIN(xb_ld(&bar[XB_TOPGEN]) == tg, bar);
            __builtin_amdgcn_fence(__ATOMIC_ACQUIRE, "agent");
            xb_add(&bar[XB_XGEN(bxx)], 1u);
            asm volatile("s_waitcnt vmcnt(0)" ::: "memory");
        } else {
            XB_SPIN(xb_ld(&bar[XB_XGEN(bxx)]) == gen, bar);
            __builtin_amdgcn_fence(__ATOMIC_ACQUIRE, "agent");
            asm volatile("s_waitcnt vmcnt(0)" ::: "memory");
        }
    }
    __syncthreads();
}
namespace cg = cooperative_groups;
constexpr int NWAVES = 8, NTHREADS = 512;
constexpr int R = 16640, NCTX = 256, SEQ = 16384, DM = 1024, INC = 6144, NL = 2, NEXP = 16384, SPAN = 65;
constexpr float ALPHA = 1.41421356237f, LN_EPS = 1e-6f, RMS_EPS = 1e-6f, LOG2E = 1.4426950408889634f;
constexpr float QSCALE = 0.125f * 1.4426950408889634f;
constexpr int C_QA = 0, C_KA = 512, C_VA = 640, C_QC = 768, C_KC = 1280, C_VC = 1408, C_XB = 1536, C_GB = 2048, C_GC = 2560, C_GL = 3072;
enum { I_X = 0, I_C, I_CTX, I_CCTX, I_WMOD, I_BMOD, I_WIN, I_QN, I_KN, I_CONVW, I_SINK, I_WBR, I_WOUT, I_LN1G, I_LN1B, I_WPQ, I_SK, I_UT, I_VT, I_LN2G, I_LN2B, N_IN };
constexpr size_t MiB = 1u << 20;
constexpr size_t WS_CTL = 0, CTL_ZERO_BYTES = 1 * MiB;
constexpr size_t WS_MODP = 1 * MiB;
constexpr size_t WS_MODV = WS_MODP + 1536 * 1024;
constexpr size_t WS_ROPE = WS_MODV + 128 * 1024;
constexpr size_t WS_WSM = 3 * MiB, WSM_L = 22 * MiB;
constexpr size_t OW_IN = 0, OW_BR = 12 * MiB, OW_OUT = 15 * MiB, OW_PQ = 17 * MiB, OW_SK = 21 * MiB;
constexpr size_t WS_U = WS_WSM + 2 * WSM_L, WS_V = WS_U + 32 * MiB;
constexpr size_t WS_X = WS_V + 32 * MiB;
constexpr size_t WS_G1 = WS_X + 65 * MiB;
constexpr size_t WS_YO = WS_G1, WS_PQ = WS_G1 + 65 * MiB, WS_IDX = WS_G1 + 130 * MiB, WS_WGT = WS_G1 + 139 * MiB;
constexpr size_t WS_HA = WS_G1 + 195 * MiB, WS_HB = WS_HA + 33 * MiB;
constexpr size_t WS_Y = WS_HB + 33 * MiB;
constexpr size_t WS_END = WS_Y + 49 * MiB;
static_assert(WS_END <= 512 * MiB, "d_ws map");
constexpr int CW_BAR = 4096;
constexpr int RING_BYTES = 131072, LDSCTL_OFF = RING_BYTES, MISC_OFF = LDSCTL_OFF + 320, LDS_BYTES = 147456;
typedef __bf16 bf16x2_t __attribute__((ext_vector_type(2)));
typedef unsigned u32x2 __attribute__((ext_vector_type(2)));

struct Args { const float* in[N_IN]; float* out; unsigned char* ws; int ph_lo, ph_hi, coop, pad; };

__device__ __forceinline__ float wave_sum(float v) {
#pragma unroll
    for (int o = 1; o < 64; o <<= 1) v += __shfl_xor(v, o);
    return v;
}
__device__ __forceinline__ float bflo(unsigned w) { return __uint_as_float(w << 16); }
__device__ __forceinline__ float bfhi(unsigned w) { return __uint_as_float(w & 0xffff0000u); }
__device__ __forceinline__ float bf1(bf16 h) { return __uint_as_float((unsigned)h << 16); }
__device__ __forceinline__ float dot2bf(unsigned w, unsigned x, float acc) { return __builtin_amdgcn_fdot2_f32_bf16(__builtin_bit_cast(bf16x2_t, w), __builtin_bit_cast(bf16x2_t, x), acc, false); }
typedef float f32x2 __attribute__((ext_vector_type(2)));
__device__ __forceinline__ unsigned fp8lo(unsigned w) { return __builtin_bit_cast(unsigned, __builtin_amdgcn_cvt_scalef32_pk_bf16_fp8((int)w, 1.0f, false)); }
__device__ __forceinline__ unsigned fp8hi(unsigned w) { return __builtin_bit_cast(unsigned, __builtin_amdgcn_cvt_scalef32_pk_bf16_fp8((int)w, 1.0f, true)); }
__device__ __forceinline__ float silu_f(float x) { return x / (1.0f + __expf(-x)); }
__device__ __forceinline__ float gelu_f(float v) {
    const float av = fabsf(v), t = __builtin_amdgcn_rcpf(av * 0.2316418882f + 1.0f);
    float q = t * 0.5307027145f + (-0.7265760135f); q = q * t + 0.7107068705f; q = q * t + (-0.142248368f); q = q * t + 0.127414796f; q = q * t;
    const float e = __builtin_amdgcn_exp2f((v * v) * (-0.72134752044f));
    const float m = v * (q * e);
    return v < 0.f ? m : v - m;
}
__device__ __forceinline__ float vmaxf(float a, float b) { float r; asm("v_max_f32_e32 %0, %1, %2" : "=v"(r) : "v"(a), "v"(b)); return r; }
__device__ __forceinline__ float vminf(float a, float b) { float r; asm("v_min_f32_e32 %0, %1, %2" : "=v"(r) : "v"(a), "v"(b)); return r; }

typedef const __attribute__((address_space(4))) unsigned long long* kargp_t;
__device__ __forceinline__ const float* ain(int k) { kargp_t p = (kargp_t)__builtin_amdgcn_kernarg_segment_ptr(); return (const float*)(const GAS float*)(*(volatile kargp_t)(p + k)); }
__device__ __forceinline__ float* aout() { kargp_t p = (kargp_t)__builtin_amdgcn_kernarg_segment_ptr(); return (float*)(GAS float*)(*(volatile kargp_t)(p + N_IN)); }
struct Frame {
    LAS unsigned char* lds; unsigned char* lds_g;
    int tid, lane, wave, G, bx, vcu, gw, NGW;
    const float* in[N_IN]; float* out; unsigned char* ws;
};
__device__ __forceinline__ void p0_transpose_item(const float* W, int K, int N, bf16* WT, LAS float* scr, int item, int lane) {
    const int nblk = N / 32, kb = item / nblk, nb = item % nblk, k0 = 64 * kb, n0 = 32 * nb;
#pragma unroll 8
    for (int i = 0; i < 32; ++i) { const int kk = 2 * i + (lane >> 5); scr[kk * 33 + (lane & 31)] = W[(size_t)(k0 + kk) * N + n0 + (lane & 31)]; }
    LDS_WAIT(); asm volatile("" ::: "memory");
    const int c = lane & 7;
#pragma unroll
    for (int j = 0; j < 4; ++j) { const int n = (lane >> 3) + 8 * j; const LAS float* s = scr + (8 * c) * 33 + n;
        v4u o; o.x = pk2(s[0 * 33], s[1 * 33]); o.y = pk2(s[2 * 33], s[3 * 33]); o.z = pk2(s[4 * 33], s[5 * 33]); o.w = pk2(s[6 * 33], s[7 * 33]);
        *(GAS v4u*)(WT + (size_t)(n0 + n) * K + k0 + 8 * c) = o; }
    LDS_WAIT(); asm volatile("" ::: "memory");
}
__device__ __forceinline__ void conv_item(const float* src, bf16* dst, size_t item, int lane) {
    const float* s = src + item * 2048; bf16* d = dst + item * 2048;
    f32x4 a[4][2];
#pragma unroll
    for (int j = 0; j < 4; ++j) { a[j][0] = *(const GAS f32x4*)(s + j * 512 + lane * 8); a[j][1] = *(const GAS f32x4*)(s + j * 512 + lane * 8 + 4); }
#pragma unroll
    for (int j = 0; j < 4; ++j) { v4u o; o.x = pk2(a[j][0].x, a[j][0].y); o.y = pk2(a[j][0].z, a[j][0].w); o.z = pk2(a[j][1].x, a[j][1].y); o.w = pk2(a[j][1].z, a[j][1].w);
        *(GAS v4u*)(d + j * 512 + lane * 8) = o; }
}
__device__ __forceinline__ void convert_uv(const Frame& F, const Args& A, int l) {
    const float* us = ain(I_UT) + (size_t)l * NEXP * DM; const float* vs = ain(I_VT) + (size_t)l * NEXP * DM;
    for (int it = F.gw; it < 2 * NEXP; it += F.NGW) {
        const bool isv = it >= NEXP; const int row = isv ? it - NEXP : it;
        const float* src = (isv ? vs : us) + (size_t)row * DM + 16 * F.lane; unsigned char* tab = F.ws + (isv ? WS_V : WS_U);
        f32x4 x[4]; float am = 0.f;
#pragma unroll
        for (int q = 0; q < 4; ++q) { x[q] = *(const GAS f32x4*)(src + 4 * q); am = fmaxf(am, fmaxf(fmaxf(fabsf(x[q].x), fabsf(x[q].y)), fmaxf(fabsf(x[q].z), fabsf(x[q].w)))); }
#pragma unroll
        for (int o = 1; o < 64; o <<= 1) am = fmaxf(am, __shfl_xor(am, o));
        const int E = (int)((__float_as_uint(am) >> 23) & 255u) - 127;
        const int se = am > 0.f ? 7 - E : 0;
        const int sec = se > 120 ? 120 : (se < -120 ? -120 : se);
        const float sc = __uint_as_float((unsigned)(127 + sec) << 23), isc = __uint_as_float((unsigned)(127 - sec) << 23);
        v4u o; unsigned* op = (unsigned*)&o;
#pragma unroll
        for (int q = 0; q < 4; ++q) { int w = __builtin_amdgcn_cvt_pk_fp8_f32(x[q].x * sc, x[q].y * sc, 0, false); w = __builtin_amdgcn_cvt_pk_fp8_f32(x[q].z * sc, x[q].w * sc, w, true); op[q] = (unsigned)w; }
        *(GAS v4u*)(tab + (size_t)row * DM + 16 * F.lane) = o;
        if (F.lane == 0) ((float*)(tab + 16 * MiB))[row] = isc;
    }
}
__device__ __forceinline__ void sincos_f(float a, float& s, float& c) {
    const float n = __builtin_rintf(a * 0.636619772367581343f);
    float r = __builtin_fmaf(n, -1.5703125f, a); r = __builtin_fmaf(n, -4.837512969970703125e-4f, r); r = __builtin_fmaf(n, -7.54978995489188216e-8f, r);
    const float r2 = r * r;
    float sp = 2.75573192e-6f; sp = __builtin_fmaf(sp, r2, -1.98412698e-4f); sp = __builtin_fmaf(sp, r2, 8.33333333e-3f); sp = __builtin_fmaf(sp, r2, -1.66666667e-1f); sp = __builtin_fmaf(sp * r2, r, r);
    float cp = -2.75573192e-7f; cp = __builtin_fmaf(cp, r2, 2.48015873e-5f); cp = __builtin_fmaf(cp, r2, -1.38888889e-3f); cp = __builtin_fmaf(cp, r2, 4.16666667e-2f); cp = __builtin_fmaf(cp, r2, -0.5f); cp = __builtin_fmaf(cp, r2, 1.0f);
    const int q = ((int)n) & 3;
    s = (q == 0) ? sp : (q == 1) ? cp : (q == 2) ? -sp : -cp;
    c = (q == 0) ? cp : (q == 1) ? -sp : (q == 2) ? -cp : sp;
}
__device__ __forceinline__ void p0_prologue(const Frame& F, const Args& A) {
    LAS float* scr = (LAS float*)(F.lds + F.wave * 16384);
    constexpr int I_MOD = 768, I_T = 5376, I_SKN = 128, I_RP = 64;
    constexpr int NIT = I_MOD + 2 * I_T + 2 * I_SKN + I_RP;
    for (int it = F.gw; it < NIT; it += F.NGW) {
        int r = it;
        if (r < I_MOD) {
            const int l = r / 384, jb = (r % 384) / 16, ks = r % 16;
            const float* W = ain(I_WMOD) + (size_t)l * DM * INC + (size_t)(ks * 64) * INC + jb * 256 + F.lane * 4;
            const float* cv = ain(I_C) + ks * 64; const float* xv = ain(I_CCTX) + ks * 64;
            f32x4 ac = {0.f, 0.f, 0.f, 0.f}, ax = {0.f, 0.f, 0.f, 0.f};
#pragma unroll 8
            for (int kk = 0; kk < 64; ++kk) { const f32x4 w = *(const GAS f32x4*)(W + (size_t)kk * INC); const float sc = silu_f(cv[kk]), sx = silu_f(xv[kk]); ac += w * sc; ax += w * sx; }
            float* P = (float*)(F.ws + WS_MODP) + ((size_t)(l * 16 + ks) * 2) * INC + jb * 256 + F.lane * 4;
            *(GAS f32x4*)P = ac; *(GAS f32x4*)(P + INC) = ax;
            continue; }
        r -= I_MOD;
        if (r < 2 * I_T) {
            const int l = r / I_T; int q = r % I_T; bf16* wsm = (bf16*)(F.ws + WS_WSM + (size_t)l * WSM_L);
            if (q < 3072) { p0_transpose_item(ain(I_WIN) + (size_t)l * DM * INC, DM, INC, (bf16*)((unsigned char*)wsm + OW_IN), scr, q, F.lane); continue; } q -= 3072;
            if (q < 768) { const int b = q / 256; p0_transpose_item(ain(I_WBR) + ((size_t)l * 3 + b) * 512 * DM, 512, DM, (bf16*)((unsigned char*)wsm + OW_BR) + (size_t)b * DM * 512, scr, q % 256, F.lane); continue; } q -= 768;
            if (q < 512) { p0_transpose_item(ain(I_WOUT) + (size_t)l * DM * DM, DM, DM, (bf16*)((unsigned char*)wsm + OW_OUT), scr, q, F.lane); continue; } q -= 512;
            p0_transpose_item(ain(I_WPQ) + (size_t)l * DM * 2048, DM, 2048, (bf16*)((unsigned char*)wsm + OW_PQ), scr, q, F.lane); continue; }
        r -= 2 * I_T;
        if (r < 2 * I_SKN) { const int l = r / I_SKN; conv_item(ain(I_SK) + (size_t)l * 262144, (bf16*)(F.ws + WS_WSM + (size_t)l * WSM_L + OW_SK), r % I_SKN, F.lane); continue; }
        r -= 2 * I_SKN;
        {
            const int e = r * 64 + F.lane, pos = e >> 4, i = e & 15;
            const float invf = __builtin_amdgcn_exp2f(-(float)i * (13.287712379549449f / 16.0f));
            const float ang = (float)pos * invf; float s, c; sincos_f(ang, s, c);
            float* T = (float*)(F.ws + WS_ROPE) + 2 * e; T[0] = c; T[1] = s; }
    }
    convert_uv(F, A, 0);
}
__device__ __forceinline__ void p1_mod_h0(const Frame& F, const Args& A, bf16* H) {
    LAS float* ml = (LAS float*)F.lds;
    const float* MP = (const float*)(F.ws + WS_MODP);
    for (int o = F.tid; o < 4096; o += NTHREADS) { const int v = o >> 11, j = o & 2047; float s = ain(I_BMOD)[j];
#pragma unroll
        for (int ks = 0; ks < 16; ++ks) s += MP[((size_t)ks * 2 + v) * INC + j];
        ml[o] = s; }
    for (int o = F.bx * NTHREADS + F.tid; o < NL * 2 * INC; o += F.G * NTHREADS) { const int l = o / (2 * INC), v = (o / INC) & 1, j = o % INC; float s = ain(I_BMOD)[l * INC + j];
#pragma unroll
        for (int ks = 0; ks < 16; ++ks) s += MP[((size_t)(l * 16 + ks) * 2 + v) * INC + j];
        ((float*)(F.ws + WS_MODV))[o] = s; }
    __syncthreads();
    for (int r = F.gw; r < R; r += F.NGW) {
        const int v = r < NCTX ? 1 : 0; const float* src = r < NCTX ? ain(I_CTX) + (size_t)r * DM : ain(I_X) + (size_t)(r - NCTX) * DM;
#pragma unroll
        for (int j = 0; j < 4; ++j) { const int c = 4 * F.lane + 256 * j; const f32x4 x = *(const GAS f32x4*)(src + c);
            const f32x4 sh = *(const LAS f32x4*)(ml + v * 2048 + c), sc = *(const LAS f32x4*)(ml + v * 2048 + 1024 + c);
            const f32x4 h = x * (sc + 1.0f) + sh; u32x2 w; w.x = pk2(h.x, h.y); w.y = pk2(h.z, h.w); *(GAS u32x2*)(H + (size_t)r * DM + c) = w; }
    }
}
__device__ __forceinline__ void post1_phase(const Frame& F, const Args& A, int l, bool wr) {
    bf16* G1 = (bf16*)(F.ws + WS_G1); bf16* Y1 = (bf16*)(F.ws + WS_Y) + (size_t)R * 512;
    const float* rope = (const float*)(F.ws + WS_ROPE);
    const float* qn = ain(I_QN) + l * 64; const float* kn = ain(I_KN) + l * 64; const float* cw = ain(I_CONVW) + l * 3 * 512;
    const int j = F.lane & 7, ja = j >> 2, jb = (j >> 1) & 1, ji = (j & 1) * 8;
    for (int r = F.gw; r < R; r += F.NGW) {
        bf16* row = G1 + (size_t)r * INC;
        float cs[8], sn[8];
        if (r >= NCTX) { const int t = r - NCTX, pos = ja ? (t & 63) : (t >> 6); const float* tp = rope + (pos * 16 + ji) * 2;
#pragma unroll
            for (int q = 0; q < 4; ++q) { const f32x4 v = *(const GAS f32x4*)(tp + 4 * q); cs[2 * q] = v.x; sn[2 * q] = v.y; cs[2 * q + 1] = v.z; sn[2 * q + 1] = v.w; } }
        else {
#pragma unroll
            for (int k = 0; k < 8; ++k) { cs[k] = 1.f; sn[k] = 0.f; } }
#pragma unroll
        for (int p = 0; p < 3; ++p) {
            const int hs = p * 8 + (F.lane >> 3); const bool live = hs < 20; const int hh = live ? hs : 19;
            const int base = (hh < 8 ? C_QA + 64 * hh : hh < 10 ? C_KA + 64 * (hh - 8) : hh < 18 ? C_QC + 64 * (hh - 10) : C_KC + 64 * (hh - 18)) + 8 * j;
            const v4u xv = *(const GAS v4u*)(row + base);
            float e[8] = {bflo(xv.x), bfhi(xv.x), bflo(xv.y), bfhi(xv.y), bflo(xv.z), bfhi(xv.z), bflo(xv.w), bfhi(xv.w)};
            if (p < 2) {
                float ss = 0.f;
#pragma unroll
                for (int k = 0; k < 8; ++k) ss += e[k] * e[k];
                ss += __shfl_xor(ss, 1); ss += __shfl_xor(ss, 2); ss += __shfl_xor(ss, 4);
                if (hh < 10) { const float rs = __builtin_amdgcn_rsqf(ss * (1.0f / 64.0f) + RMS_EPS); const float* gn = (hh < 8 ? qn : kn) + 8 * j;
                    const f32x4 g0 = *(const GAS f32x4*)gn, g1 = *(const GAS f32x4*)(gn + 4);
                    e[0] *= rs * g0.x; e[1] *= rs * g0.y; e[2] *= rs * g0.z; e[3] *= rs * g0.w; e[4] *= rs * g1.x; e[5] *= rs * g1.y; e[6] *= rs * g1.z; e[7] *= rs * g1.w; }
            }
            const float qs = (hh < 8 || (hh >= 10 && hh < 18)) ? QSCALE : 1.0f;
            float o[8];
#pragma unroll
            for (int k = 0; k < 8; ++k) { const float pe = __shfl_xor(e[k], 2); o[k] = (jb ? e[k] * cs[k] + pe * sn[k] : e[k] * cs[k] - pe * sn[k]) * qs; }
            if (live && wr) { v4u w; w.x = pk2(o[0], o[1]); w.y = pk2(o[2], o[3]); w.z = pk2(o[4], o[5]); w.w = pk2(o[6], o[7]); *(GAS v4u*)(row + base) = w; }
        }
        const int lo = r < NCTX ? 0 : NCTX, hi = r < NCTX ? NCTX - 1 : R - 1, ch = 8 * F.lane;
        float acc[8];
#pragma unroll
        for (int k = 0; k < 8; ++k) acc[k] = 0.f;
#pragma unroll
        for (int d = 0; d < 3; ++d) { const int rr = r - 1 + d;
            if (rr >= lo && rr <= hi) { const bf16* nr = G1 + (size_t)rr * INC;
                const v4u xb = *(const GAS v4u*)(nr + C_XB + ch), gc = *(const GAS v4u*)(nr + C_GC + ch);
                const f32x4 w0 = *(const GAS f32x4*)(cw + d * 512 + ch), w1 = *(const GAS f32x4*)(cw + d * 512 + ch + 4);
                acc[0] += w0.x * bflo(xb.x) * bflo(gc.x); acc[1] += w0.y * bfhi(xb.x) * bfhi(gc.x); acc[2] += w0.z * bflo(xb.y) * bflo(gc.y); acc[3] += w0.w * bfhi(xb.y) * bfhi(gc.y);
                acc[4] += w1.x * bflo(xb.z) * bflo(gc.z); acc[5] += w1.y * bfhi(xb.z) * bfhi(gc.z); acc[6] += w1.z * bflo(xb.w) * bflo(gc.w); acc[7] += w1.w * bfhi(xb.w) * bfhi(gc.w); } }
        const v4u gb = *(const GAS v4u*)(row + C_GB + ch);
        v4u o; o.x = pk2(acc[0] * bflo(gb.x), acc[1] * bfhi(gb.x)); o.y = pk2(acc[2] * bflo(gb.y), acc[3] * bfhi(gb.y)); o.z = pk2(acc[4] * bflo(gb.z), acc[5] * bfhi(gb.z)); o.w = pk2(acc[6] * bflo(gb.w), acc[7] * bfhi(gb.w));
        if (wr) *(GAS v4u*)(Y1 + (size_t)r * 512 + ch) = o;
    }
}
__device__ __forceinline__ void ln1_phase(const Frame& F, const Args& A, int l, int row0, bf16* H2) {
    const float* YO = (const float*)(F.ws + WS_YO); float* X = (float*)(F.ws + WS_X); const float* MV = (const float*)(F.ws + WS_MODV) + (size_t)l * 2 * INC;
    const float* lg = ain(I_LN1G) + l * DM; const float* lb = ain(I_LN1B) + l * DM;
    for (int r = row0 + F.gw; r < R; r += F.NGW) {
        const float* mv = MV + (r < NCTX ? INC : 0);
        const float* xin = l == 0 ? (r < NCTX ? ain(I_CTX) + (size_t)r * DM : ain(I_X) + (size_t)(r - NCTX) * DM) : X + (size_t)r * DM;
        f32x4 v[4]; float s = 0.f;
#pragma unroll
        for (int j = 0; j < 4; ++j) { const int c = 4 * F.lane + 256 * j; const f32x4 x = *(const GAS f32x4*)(xin + c), y = *(const GAS f32x4*)(YO + (size_t)r * DM + c), g = *(const GAS f32x4*)(mv + 2048 + c);
            v[j] = x * ALPHA + g * y; s += (v[j].x + v[j].y) + (v[j].z + v[j].w); }
        const float mean = wave_sum(s) * (1.f / DM); float s2 = 0.f;
#pragma unroll
        for (int j = 0; j < 4; ++j) { v[j] = v[j] - mean; s2 += (v[j].x * v[j].x + v[j].y * v[j].y) + (v[j].z * v[j].z + v[j].w * v[j].w); }
        const float rstd = 1.f / sqrtf(wave_sum(s2) * (1.f / DM) + LN_EPS);
#pragma unroll
        for (int j = 0; j < 4; ++j) { const int c = 4 * F.lane + 256 * j; const f32x4 gg = *(const GAS f32x4*)(lg + c), bb = *(const GAS f32x4*)(lb + c);
            const f32x4 x1 = v[j] * rstd * gg + bb; *(GAS f32x4*)(X + (size_t)r * DM + c) = x1;
            const f32x4 sh = *(const GAS f32x4*)(mv + 3072 + c), sc = *(const GAS f32x4*)(mv + 4096 + c);
            const f32x4 h = x1 * (sc + 1.0f) + sh; u32x2 w; w.x = pk2(h.x, h.y); w.y = pk2(h.z, h.w); *(GAS u32x2*)(H2 + (size_t)r * DM + c) = w; }
    }
}
typedef float f32x16 __attribute__((ext_vector_type(16)));
__device__ __forceinline__ void ins16(float (&L)[16], float x) {
#pragma unroll
    for (int j = 0; j < 16; ++j) { const float h = vmaxf(L[j], x); x = vminf(L[j], x); L[j] = h; }
}
__device__ __forceinline__ void bitonic16_desc(float (&T)[16]) {
#pragma unroll
    for (int s = 8; s >= 1; s >>= 1)
#pragma unroll
        for (int i = 0; i < 16; ++i) if ((i & s) == 0) { const float h = vmaxf(T[i], T[i + s]), lo = vminf(T[i], T[i + s]); T[i] = h; T[i + s] = lo; }
}
__device__ __forceinline__ void subkey_top16(const bf16* qrow  , const bf16* keys  , int r32, int hi, float (&S)[16]) {
    bf16x8 qf[8];
#pragma unroll
    for (int ks = 0; ks < 8; ++ks) qf[ks] = *(const GAS bf16x8*)(qrow + ks * 16 + hi * 8);
    float L[16];
#pragma unroll
    for (int j = 0; j < 16; ++j) L[j] = -INFINITY;
#pragma unroll 1
    for (int nb = 0; nb < 4; ++nb) { f32x16 acc = f32x16{};
#pragma unroll
        for (int ks = 0; ks < 8; ++ks) { const bf16x8 kf = *(const GAS bf16x8*)(keys + (size_t)(nb * 32 + r32) * 128 + ks * 16 + hi * 8);
            acc = __builtin_amdgcn_mfma_f32_32x32x16_bf16(kf, qf[ks], acc, 0, 0, 0); }
#pragma unroll
        for (int rg = 0; rg < 16; ++rg) { const unsigned n = (unsigned)(nb * 32 + (rg & 3) + 8 * (rg >> 2) + 4 * hi);
            ins16(L, __uint_as_float((__float_as_uint(acc[rg]) & ~127u) | n)); } }
#pragma unroll
    for (int j = 0; j < 16; ++j) { const float other = __shfl_xor(L[15 - j], 32); S[j] = vmaxf(L[j], other); }
    bitonic16_desc(S);
}
__device__ __forceinline__ void scores_phase(const Frame& F, const Args& A, int l, int row0) {
    const bf16* PQ = (const bf16*)(F.ws + WS_PQ); const bf16* SK = (const bf16*)(F.ws + WS_WSM + (size_t)l * WSM_L + OW_SK);
    int* IDX = (int*)(F.ws + WS_IDX); float* WGT = (float*)(F.ws + WS_WGT);
    const int r32 = F.lane & 31, hi = F.lane >> 5;
    LAS unsigned* myl = (LAS unsigned*)(F.lds + F.wave * 2048 + F.lane * 32);
    const int nitems = ((R - row0) / 32) * 8;
    for (int it = F.gw; it < nitems; it += F.NGW) {
        const int h = it & 7, rb = row0 + (it >> 3) * 32, row = rb + r32;
        float S1[16], S2[16];
        subkey_top16(PQ + (size_t)row * 2048 + h * 256, SK + (size_t)(h * 2) * 16384, r32, hi, S1);
        subkey_top16(PQ + (size_t)row * 2048 + h * 256 + 128, SK + (size_t)(h * 2 + 1) * 16384, r32, hi, S2);
#pragma unroll
        for (int q = 0; q < 4; ++q) {
            myl[q] = (__float_as_uint(S1[4 * q]) & 127u) | ((__float_as_uint(S1[4 * q + 1]) & 127u) << 8) | ((__float_as_uint(S1[4 * q + 2]) & 127u) << 16) | ((__float_as_uint(S1[4 * q + 3]) & 127u) << 24);
            myl[4 + q] = (__float_as_uint(S2[4 * q]) & 127u) | ((__float_as_uint(S2[4 * q + 1]) & 127u) << 8) | ((__float_as_uint(S2[4 * q + 2]) & 127u) << 16) | ((__float_as_uint(S2[4 * q + 3]) & 127u) << 24); }
        float T[16];
#pragma unroll
        for (int j = 0; j < 16; ++j) T[j] = -INFINITY;
#pragma unroll
        for (int a = 0; a < 16; ++a)
#pragma unroll
            for (int b = 0; b < 16; ++b) if ((a + 1) * (b + 1) <= 16) ins16(T, __uint_as_float((__float_as_uint(S1[a] + S2[b]) & ~255u) | (unsigned)(a * 16 + b)));
        const float m = T[0]; float e[16], sum = 0.f;
#pragma unroll
        for (int j = 0; j < 16; ++j) { e[j] = __expf(T[j] - m); sum += e[j]; }
        const float inv = 1.0f / sum;
        LDS_WAIT();
        if (hi == 0) {
            const LAS unsigned char* lb = (const LAS unsigned char*)myl;
            int ex[16];
#pragma unroll
            for (int j = 0; j < 16; ++j) { const unsigned pid = __float_as_uint(T[j]) & 255u; ex[j] = (int)lb[pid >> 4] * 128 + (int)lb[16 + (pid & 15u)]; }
            int* ip = IDX + (size_t)row * 128 + h * 16; float* wp = WGT + (size_t)row * 128 + h * 16;
#pragma unroll
            for (int q = 0; q < 4; ++q) { *(GAS v4u*)(ip + 4 * q) = (v4u){(unsigned)ex[4 * q], (unsigned)ex[4 * q + 1], (unsigned)ex[4 * q + 2], (unsigned)ex[4 * q + 3]};
                *(GAS f32x4*)(wp + 4 * q) = (f32x4){e[4 * q] * inv, e[4 * q + 1] * inv, e[4 * q + 2] * inv, e[4 * q + 3] * inv}; }
        }
        LDS_WAIT();
    }
}
template <bool LAST> __device__ __forceinline__ void peer_phase(const Frame& F, const Args& A, int l, int row0, const bf16* H2, bf16* Hn) {
    const unsigned char* U = F.ws + WS_U; const unsigned char* V = F.ws + WS_V; const float* SU = (const float*)(F.ws + WS_U + 16 * MiB); const float* SV = (const float*)(F.ws + WS_V + 16 * MiB);
    const int* IDX = (const int*)(F.ws + WS_IDX); const float* WGT = (const float*)(F.ws + WS_WGT);
    float* X = (float*)(F.ws + WS_X); const float* MVl = (const float*)(F.ws + WS_MODV) + (size_t)l * 2 * INC; const float* MVn = (const float*)(F.ws + WS_MODV) + (size_t)(LAST ? l : l + 1) * 2 * INC;
    const float* lg = ain(I_LN2G) + l * DM; const float* lb = ain(I_LN2B) + l * DM;
    const int lane = F.lane, c0 = 16 * lane;
    LAS int* idxL = (LAS int*)(F.lds + F.wave * 2048); LAS float* wL = (LAS float*)(F.lds + F.wave * 2048 + 512); LAS float* aL = (LAS float*)(F.lds + F.wave * 2048 + 1024);
    const int jx = (lane >> 3) & 7;
    for (int r = row0 + F.gw; r < R; r += F.NGW) {
        idxL[lane] = IDX[(size_t)r * 128 + lane]; idxL[64 + lane] = IDX[(size_t)r * 128 + 64 + lane];
        wL[lane] = WGT[(size_t)r * 128 + lane]; wL[64 + lane] = WGT[(size_t)r * 128 + 64 + lane];
        const v4u h0 = *(const GAS v4u*)(H2 + (size_t)r * DM + c0), h1 = *(const GAS v4u*)(H2 + (size_t)r * DM + c0 + 8);
        v4u A[8], B[8]; float f[16];
#pragma unroll
        for (int k = 0; k < 16; ++k) f[k] = 0.f;
#define PEER_LOAD(T, buf, g) do { _Pragma("unroll") for (int e = 0; e < 8; ++e) buf[e] = *(const GAS v4u*)(T + (size_t)idxL[(g) * 8 + e] * DM + c0); } while (0)
#define PEER_COMPU(buf, g) do { float p[8]; \
            _Pragma("unroll") for (int e = 0; e < 8; ++e) { const v4u u = buf[e]; \
                float a0 = dot2bf(fp8lo(u.x), h0.x, 0.f), a1 = dot2bf(fp8hi(u.x), h0.y, 0.f); a0 = dot2bf(fp8lo(u.y), h0.z, a0); a1 = dot2bf(fp8hi(u.y), h0.w, a1); \
                a0 = dot2bf(fp8lo(u.z), h1.x, a0); a1 = dot2bf(fp8hi(u.z), h1.y, a1); a0 = dot2bf(fp8lo(u.w), h1.z, a0); a1 = dot2bf(fp8hi(u.w), h1.w, a1); p[e] = a0 + a1; } \
            { const bool up = (lane & 32) != 0; _Pragma("unroll") for (int i = 0; i < 4; ++i) { const float a = p[i], b = p[i + 4]; p[i] = (up ? b : a) + __shfl_xor(up ? a : b, 32); } } \
            { const bool up = (lane & 16) != 0; _Pragma("unroll") for (int i = 0; i < 2; ++i) { const float a = p[i], b = p[i + 2]; p[i] = (up ? b : a) + __shfl_xor(up ? a : b, 16); } } \
            { const bool up = (lane & 8) != 0; const float a = p[0], b = p[1]; p[0] = (up ? b : a) + __shfl_xor(up ? a : b, 8); } \
            float t = p[0]; t += __shfl_xor(t, 4); t += __shfl_xor(t, 2); t += __shfl_xor(t, 1); \
            const int ej = idxL[(g) * 8 + jx]; const float av = gelu_f(t * SU[ej]) * wL[(g) * 8 + jx] * SV[ej];       \
            if ((lane & 7) == 0) aL[(g) * 8 + jx] = av; } while (0)
#define PEER_COMPV(buf, g) do { _Pragma("unroll") for (int e = 0; e < 8; ++e) { const float ae = aL[(g) * 8 + e]; const unsigned vv[4] = {buf[e].x, buf[e].y, buf[e].z, buf[e].w}; \
            _Pragma("unroll") for (int q = 0; q < 4; ++q) { const f32x2 lo = __builtin_amdgcn_cvt_pk_f32_fp8((int)vv[q], false), hi = __builtin_amdgcn_cvt_pk_f32_fp8((int)vv[q], true); \
                f[4 * q] += ae * lo.x; f[4 * q + 1] += ae * lo.y; f[4 * q + 2] += ae * hi.x; f[4 * q + 3] += ae * hi.y; } } } while (0)
        PEER_LOAD(U, A, 0);
#pragma unroll 1
        for (int c = 0; c < 16; c += 2) {
            PEER_LOAD(U, B, c + 1);
            PEER_COMPU(A, c);
            if (c + 2 < 16) PEER_LOAD(U, A, c + 2); else PEER_LOAD(V, A, 0);
            PEER_COMPU(B, c + 1);
        }
#pragma unroll 1
        for (int c = 0; c < 16; c += 2) {
            PEER_LOAD(V, B, c + 1);
            PEER_COMPV(A, c);
            if (c + 2 < 16) PEER_LOAD(V, A, c + 2);
            PEER_COMPV(B, c + 1);
        }
#undef PEER_LOAD
#undef PEER_COMPU
#undef PEER_COMPV
        const float* mv = MVl + (r < NCTX ? INC : 0);
        float v[16]; float s = 0.f;
#pragma unroll
        for (int q = 0; q < 4; ++q) { const int c = c0 + 4 * q; const f32x4 x = *(const GAS f32x4*)(X + (size_t)r * DM + c), g2 = *(const GAS f32x4*)(mv + 5120 + c);
#pragma unroll
            for (int k = 0; k < 4; ++k) { const float t = x[k] * ALPHA + g2[k] * f[q * 4 + k]; v[q * 4 + k] = t; s += t; } }
        const float mean = wave_sum(s) * (1.f / DM); float s2 = 0.f;
#pragma unroll
        for (int k = 0; k < 16; ++k) { v[k] -= mean; s2 += v[k] * v[k]; }
        const float rstd = 1.f / sqrtf(wave_sum(s2) * (1.f / DM) + LN_EPS);
        const float* mn = MVn + (r < NCTX ? INC : 0);
#pragma unroll
        for (int q = 0; q < 4; ++q) { const int c = c0 + 4 * q; const f32x4 gg = *(const GAS f32x4*)(lg + c), bb = *(const GAS f32x4*)(lb + c);
            f32x4 x2;
#pragma unroll
            for (int k = 0; k < 4; ++k) x2[k] = v[q * 4 + k] * rstd * gg[k] + bb[k];
            if (LAST) { *(GAS f32x4*)(aout() + (size_t)(r - NCTX) * DM + c) = x2; }
            else { *(GAS f32x4*)(X + (size_t)r * DM + c) = x2;
                const f32x4 sh = *(const GAS f32x4*)(mn + c), sc = *(const GAS f32x4*)(mn + 1024 + c); const f32x4 hh = x2 * (sc + 1.0f) + sh;
                u32x2 w; w.x = pk2(hh.x, hh.y); w.y = pk2(hh.z, hh.w); *(GAS u32x2*)(Hn + (size_t)r * DM + c) = w; } }
    }
}
__device__ __forceinline__ void attn_phase(const Frame& F, const Args& A, int l) {
    using attn_body::AttnJob; typedef attn_body::bf16 abf;
    abf* G1 = (abf*)(F.ws + WS_G1); abf* Y0 = (abf*)(F.ws + WS_Y); abf* Y2 = Y0 + (size_t)2 * R * 512;
    char* shm = (char*)F.lds_g;
    const float* sink = ain(I_SINK) + l * 8;
#define OPAQUE_S(x) asm volatile("" : "+s"(x))
#pragma unroll 1
    for (int i = 0; i < 2; ++i) {
        int vc = F.vcu; OPAQUE_S(vc);
        const int u = 2 * vc + i, kvh = u >> 8, hq = kvh * 4 + ((u >> 6) & 3), qb = u & 63; const size_t row = NCTX + 256 * qb;
        AttnJob J; J.Q = G1 + row * INC + C_QA + hq * 64; J.K = G1 + C_KA + kvh * 64; J.V = G1 + C_VA + kvh * 64; J.O = Y0 + row * 512 + hq * 64;
        J.qp = INC; J.kp = INC; J.op = 512; J.nt = R / 64; J.nt0 = R / 64; J.row1 = 0; J.qpos0 = 0; J.kpos1 = 0; J.sink2 = -INFINITY;
        attn_body::attn_unit<8, 0>(J, shm);
    }
#ifndef AT_ONLYA
#pragma unroll 1
    for (int i = 0; i < 2; ++i) {
        int vc = F.vcu; OPAQUE_S(vc);
        const int u = 2 * vc + i, kvh = u >> 8, hq = kvh * 4 + ((u >> 6) & 3), qb = u & 63; const size_t row = NCTX + 256 * qb;
        const int q0 = 256 * qb, lo = q0 - 128 < 0 ? 0 : q0 - 128, hi = q0 + 384 > SEQ ? SEQ : q0 + 384;
        AttnJob J; J.Q = G1 + row * INC + C_QC + hq * 64; J.K = G1 + C_KC + kvh * 64; J.V = G1 + C_VC + kvh * 64; J.O = Y2 + row * 512 + hq * 64;
        J.qp = INC; J.kp = INC; J.op = 512; J.nt0 = NCTX / 64; J.nt = NCTX / 64 + (hi - lo) / 64; J.row1 = NCTX + lo; J.qpos0 = q0; J.kpos1 = lo; J.sink2 = sink[hq] * LOG2E;
        attn_body::attn_unit<8, 1>(J, shm);
    }
    int vx = F.vcu; OPAQUE_S(vx);
    if (l == 0 && vx < 16) {
        const int hq = vx & 7, kvh = hq >> 2; const bool isc = vx >= 8;
        AttnJob J; J.Q = G1 + (isc ? C_QC : C_QA) + hq * 64; J.K = G1 + (isc ? C_KC : C_KA) + kvh * 64; J.V = G1 + (isc ? C_VC : C_VA) + kvh * 64; J.O = (isc ? Y2 : Y0) + hq * 64;
        J.qp = INC; J.kp = INC; J.op = 512; J.nt = NCTX / 64; J.nt0 = NCTX / 64; J.row1 = 0; J.qpos0 = 0; J.kpos1 = 0; J.sink2 = isc ? sink[hq] * LOG2E : -INFINITY;
        attn_body::attn_unit<8, 0>(J, shm);
    }
#endif
}
constexpr int N_PHASES = 2 + 9 * NL;
__global__ void __launch_bounds__(NTHREADS, 2) mk_fwd(Args A) {
    extern __shared__ __attribute__((aligned(16))) unsigned char lds[];
    Frame F0;
    F0.lds = (LAS unsigned char*)lds; F0.lds_g = lds;
    F0.tid = threadIdx.x; F0.lane = F0.tid & 63; F0.wave = __builtin_amdgcn_readfirstlane(F0.tid >> 6);
    F0.G = gridDim.x; F0.bx = blockIdx.x; F0.vcu = (F0.G % 8 == 0) ? (F0.bx % 8) * (F0.G / 8) + F0.bx / 8 : F0.bx;
    F0.gw = F0.bx * NWAVES + F0.wave; F0.NGW = F0.G * NWAVES; F0.ws = A.ws;
    volatile LAS unsigned* MISC = (volatile LAS unsigned*)(F0.lds + MISC_OFF);
    for (int u = F0.tid; u < (LDS_BYTES - LDSCTL_OFF) / 4; u += NTHREADS) ((LAS unsigned*)(F0.lds + LDSCTL_OFF))[u] = 0u;
    __syncthreads();
    const int lo = A.ph_lo, hi = A.ph_hi;
    XcdBarrier bar; bar.bar = (unsigned*)(A.ws + WS_CTL) + CW_BAR; bar.x = 0; bar.st = nullptr;
    if (hi - lo > 1) bar = xcd_barrier_post((unsigned*)(A.ws + WS_CTL) + CW_BAR, MISC + 8);
#ifndef MK_ONLY
#define MK_ONLY -1
#endif
#ifndef MK_REP
#define MK_REP 0
#endif
#ifndef MK_MASK
#define MK_MASK 0x7ff
#endif
#define ON(k) ((MK_ONLY < 0 || MK_ONLY == (k)) && ((MK_MASK >> (k)) & 1))
#pragma unroll 1
    for (int ph2 = 2 * lo; ph2 < 2 * hi; ++ph2) {
        const int ph = ph2 >> 1;
        if ((ph2 & 1) && !((MK_REP >> ph) & 1)) continue;
        const int l = ph < 2 ? 0 : (ph - 2) / 9, kind = ph < 2 ? ph : 2 + (ph - 2) % 9;
        Frame F;
        F.lds = (LAS unsigned char*)lds; F.lds_g = lds;
        F.tid = opq_tid(); F.lane = F.tid & 63; F.wave = __builtin_amdgcn_readfirstlane(F.tid >> 6);
        { int bx = blockIdx.x, g = gridDim.x; asm volatile("" : "+s"(bx), "+s"(g)); F.bx = bx; F.G = g; }
        F.vcu = (F.G % 8 == 0) ? (F.bx % 8) * (F.G / 8) + F.bx / 8 : F.bx; F.gw = F.bx * NWAVES + F.wave; F.NGW = F.G * NWAVES;
        { GAS unsigned char* wsg = (GAS unsigned char*)A.ws; asm volatile("" : "+s"(wsg)); F.ws = (unsigned char*)wsg; }
        bf16* HA = (bf16*)(F.ws + WS_HA); bf16* HB = (bf16*)(F.ws + WS_HB);
        bf16* Hin = (l & 1) ? HB : HA; bf16* Hmg = (l & 1) ? HA : HB;
        const int row0 = (l == NL - 1) ? NCTX : 0;
        const int Mr = R - row0, NPr = Mr / 256;
        unsigned char* wsm = F.ws + WS_WSM + (size_t)l * WSM_L;
        switch (kind) {
        case 0: if (ON(0)) { p0_prologue(F, A); } break;
        case 1: if (ON(1)) { p1_mod_h0(F, A, HA); } break;
        case 2: if (ON(2)) {
            pg8::Gemm g{(const pg8::bf16_t*)Hin, (const pg8::bf16_t*)(wsm + OW_IN), R, INC, DM}; pg8::StaticOrder S; S.init(R, INC, F.G, F.bx);
            pg8::EpiBf16<0> E{(pg8::bf16_t*)(F.ws + WS_G1), INC, nullptr, 0, 0, 1.f};
            pg8::gemm_phase<pg8::EpiBf16<0>, pg8::StaticOrder, true, true>(F.lds, g, S, E);
            if (l > 0) convert_uv(F, A, l);
        } break;
        case 3: if (ON(3)) { post1_phase(F, A, l, !(ph2 & 1) || F.G == 12345); } break;
        case 4: if (ON(4)) { attn_phase(F, A, l); } break;
        case 5: if (ON(5)) {
            pg8::Gemm g{(const pg8::bf16_t*)(F.ws + WS_Y) + (size_t)row0 * 512, (const pg8::bf16_t*)(wsm + OW_BR), 3 * R, 3072, 512}; pg8::MergeOrder S; S.init(NPr, SPAN, F.G, F.bx);
            pg8::EpiMerge E{(pg8::bf16_t*)Hmg + (size_t)row0 * DM, (const pg8::bf16_t*)(F.ws + WS_G1) + (size_t)row0 * INC + C_GL, INC, SPAN};
            pg8::gemm_phase<pg8::EpiMerge, pg8::MergeOrder, true, true>(F.lds, g, S, E);
        } break;
        case 6: if (ON(6)) {
            pg8::Gemm g{(const pg8::bf16_t*)Hmg + (size_t)row0 * DM, (const pg8::bf16_t*)(wsm + OW_OUT), Mr, DM, DM}; pg8::StaticOrder S; S.init(Mr, DM, F.G, F.bx);
            pg8::EpiF32 E{(float*)(F.ws + WS_YO) + (size_t)row0 * DM, DM};
            pg8::gemm_phase<pg8::EpiF32, pg8::StaticOrder, true, true>(F.lds, g, S, E);
        } break;
        case 7: if (ON(7)) { ln1_phase(F, A, l, row0, Hin); } break;
        case 8: if (ON(8)) {
            pg8::Gemm g{(const pg8::bf16_t*)Hin + (size_t)row0 * DM, (const pg8::bf16_t*)(wsm + OW_PQ), Mr, 2048, DM}; pg8::StaticOrder S; S.init(Mr, 2048, F.G, F.bx);
            pg8::EpiBf16<0> E{(pg8::bf16_t*)(F.ws + WS_PQ) + (size_t)row0 * 2048, 2048, nullptr, 0, 0, 1.f};
            pg8::gemm_phase<pg8::EpiBf16<0>, pg8::StaticOrder, true, true>(F.lds, g, S, E);
        } break;
        case 9: if (ON(9)) { scores_phase(F, A, l, row0); } break;
        default: if (ON(10)) { if (l == NL - 1) peer_phase<true>(F, A, l, row0, Hin, Hmg); else peer_phase<false>(F, A, l, row0, Hin, Hmg); } break;
        }
#if defined(MK_XBAR)
        if (ph == 5 && !(ph2 & 1)) { for (int q = 0; q < MK_XBAR; ++q) xcd_barrier(bar); }
#endif
        const bool more = (ph2 & 1) ? (ph + 1 < hi) : ((ph + 1 < hi) || ((MK_REP >> ph) & 1));
        if (more) { if (A.coop && ph2 == 2 * lo) { cg::this_grid().sync(); } else { xcd_barrier(bar); } }
    }
#undef ON
}
#ifndef MK_MULTI
#define MK_MULTI 0
#endif
extern "C" void kernel_launch(void* const* d_in, const int* in_sizes, int n_in, void* d_out, int out_size, void* d_ws, size_t ws_size, hipStream_t stream) {
    static int grid = 0;
    if (grid == 0) {
        if (n_in != N_IN || out_size != SEQ * DM || ws_size < WS_END) { fprintf(stderr, "kernel_launch: unexpected shapes (n_in %d, out %d, ws %zu)\n", n_in, out_size, ws_size); grid = -1; return; }
        int dev = 0, cus = 0, per_cu = 0;
        if (hipGetDevice(&dev) != hipSuccess || hipDeviceGetAttribute(&cus, hipDeviceAttributeMultiprocessorCount, dev) != hipSuccess) { grid = -1; return; }
        if (hipFuncSetAttribute((const void*)mk_fwd, hipFuncAttributeMaxDynamicSharedMemorySize, LDS_BYTES) != hipSuccess) { grid = -1; return; }
        if (hipOccupancyMaxActiveBlocksPerMultiprocessor(&per_cu, (const void*)mk_fwd, NTHREADS, LDS_BYTES) != hipSuccess || per_cu < 1) { fprintf(stderr, "kernel_launch: occupancy query says %d\n", per_cu); }
        (void)hipGetLastError();
        grid = cus;
    }
    if (grid < 0) return;
    (void)hipMemsetAsync((char*)d_ws + WS_CTL, 0, CTL_ZERO_BYTES, stream);
    Args a{};
    for (int i = 0; i < N_IN; ++i) a.in[i] = (const float*)d_in[i];
    a.out = (float*)d_out; a.ws = (unsigned char*)d_ws;
#if MK_MULTI
    for (int p = 0; p < N_PHASES; ++p) { a.ph_lo = p; a.ph_hi = p + 1; a.coop = 0; hipLaunchKernelGGL(mk_fwd, dim3(grid), dim3(NTHREADS), LDS_BYTES, stream, a); }
#else
    a.ph_lo = 0; a.ph_hi = N_PHASES; a.coop = 1;
    void* args[] = {&a};
    hipError_t e = hipLaunchCooperativeKernel((void*)mk_fwd, dim3(grid), dim3(NTHREADS), args, LDS_BYTES, stream);
    if (e != hipSuccess) fprintf(stderr, "kernel_launch: cooperative launch failed: %s (grid %d)\n", hipGetErrorString(e), grid);
#endif
}
```

```cpp
#include <hip/hip_runtime.h>
#include <hip/hip_bf16.h>
#include <hip/hip_cooperative_groups.h>
#include <cstdio>
#include <cstdint>
#include <cmath>
__device__ __forceinline__ int opq_tid() { int t = threadIdx.x; asm volatile("" : "+v"(t)); return t; }
namespace pg8 {
#define PG8_LAS __attribute__((address_space(3)))
typedef unsigned short bf16_t;
typedef short bf16x8 __attribute__((ext_vector_type(8)));
typedef float f32x4 __attribute__((ext_vector_type(4)));
typedef unsigned u32x4 __attribute__((ext_vector_type(4)));
constexpr int BM = 256, BK = 64, HALF = 128, HTB = HALF * BK * 2  , STAGE_BYTES = 8 * HTB, NXCD = 8, WGM = 8;

__host__ __device__ __forceinline__ int lds_byte(int r, int c) { const int st = (r >> 4) * 2 + (c >> 5), rr = r & 15, cc = c & 31, ob = rr * 64 + cc * 2; return st * 1024 + (ob ^ (((ob >> 9) & 1) << 5)); }
__host__ __device__ __forceinline__ void stage_rc(int b, int& R, int& C) { const int st = b / 1024, sb = b % 1024, swz = sb ^ (((sb >> 9) & 1) << 5); R = (st >> 1) * 16 + swz / 64; C = (st & 1) * 32 + (swz % 64) / 2; }
__host__ __device__ __forceinline__ int perm32(int rho) { const int n = rho >> 4, i = rho & 15; return 8 * (i >> 2) + 4 * n + (i & 3); }

struct Unit { int pm, pn; };
struct Gemm { const bf16_t* A; const bf16_t* Bt; int M, N, K; };

struct StaticOrder {
    int nM, nN, nwg, G, c;
    __host__ __device__ void init(int M, int N, int G_, int c_) { nM = M / BM; nN = N / BM; nwg = nM * nN; G = G_; c = c_; }
    __host__ __device__ bool next(int i, Unit& u) const {
        const long L = (long)i * G + c; if (L >= nwg) return false;
        int wgid = (int)L; { const int q = nwg / NXCD, r = nwg % NXCD, xcd = wgid % NXCD, off = wgid / NXCD; wgid = (xcd < r ? xcd * (q + 1) : r * (q + 1) + (xcd - r) * q) + off; }
        const int nig = WGM * nN, gid = wgid / nig, fm = gid * WGM, gsz = (nM - fm) < WGM ? (nM - fm) : WGM;
        u.pm = fm + ((wgid % nig) % gsz); u.pn = (wgid % nig) / gsz; return true;
    }
    __device__ __forceinline__ void a_ready(const Unit&) const {}
    __device__ __forceinline__ void done(const Unit&) const {}
};

__device__ __forceinline__ unsigned cvt_pk_bf16(float lo, float hi) { unsigned r; asm volatile("v_cvt_pk_bf16_f32 %0, %1, %2" : "=v"(r) : "v"(lo), "v"(hi)); return r; }
typedef float f32x2 __attribute__((ext_vector_type(2)));
__device__ __forceinline__ f32x2 gelu_pk(f32x2 v) {
    const f32x2 av = __builtin_elementwise_abs(v), d = av * 0.2316418882f + 1.0f;
    f32x2 t; t.x = __builtin_amdgcn_rcpf(d.x); t.y = __builtin_amdgcn_rcpf(d.y);
    f32x2 q = t * 0.5307027145f + (-0.7265760135f); q = q * t + 0.7107068705f; q = q * t + (-0.142248368f); q = q * t + 0.127414796f; q = q * t;
    const f32x2 s = (v * v) * (-0.72134752044f);
    f32x2 e; e.x = __builtin_amdgcn_exp2f(s.x); e.y = __builtin_amdgcn_exp2f(s.y);
    const f32x2 m = v * (q * e), r = v - m;
    f32x2 o; o.x = v.x < 0.f ? m.x : r.x; o.y = v.y < 0.f ? m.y : r.y; return o;
}

template <int ACT  > struct EpiBf16 {
    static constexpr bool PERM = true, AFTER_DRAIN = false; static_assert(ACT == 0 || ACT == 1, "EpiBf16: ACT is 0 (none) or 1 (gelu_pk)");
    bf16_t* O; int ldc; const float* bias; int split_cols; size_t split_stride; float scale0;
    __device__ __forceinline__ void operator()(const f32x4 (&acc)[2][2][4][2], const Unit& u, int wr, int wc, int fr, int fq) const {
        const int row0 = u.pm * BM + wr * 64 + fr; int colt = u.pn * BM; bf16_t* base = O;
        float sc = 1.f; if (split_cols) { const int t = colt / split_cols; base += (size_t)t * split_stride; colt -= t * split_cols; if (t == 0) sc = scale0; }
        const int col0 = colt + wc * 32 + 8 * fq, bcol0 = u.pn * BM + wc * 32 + 8 * fq;
        f32x4 bv[2][2];
#pragma unroll
        for (int bj = 0; bj < 2; ++bj)
#pragma unroll
            for (int n = 0; n < 2; ++n) bv[bj][n] = bias ? *(const f32x4*)(bias + bcol0 + bj * HALF + 4 * n) : (f32x4){0.f, 0.f, 0.f, 0.f};
#pragma unroll
        for (int ai = 0; ai < 2; ++ai)
#pragma unroll
            for (int m = 0; m < 4; ++m) { bf16_t* rowp = base + (size_t)(row0 + ai * HALF + m * 16) * ldc + col0;
#pragma unroll
                for (int bj = 0; bj < 2; ++bj) { f32x4 v0 = acc[ai][bj][m][0] + bv[bj][0], v1 = acc[ai][bj][m][1] + bv[bj][1];
                    if (ACT == 1) { f32x2 a = gelu_pk((f32x2){v0[0], v0[1]}), b = gelu_pk((f32x2){v0[2], v0[3]}), c = gelu_pk((f32x2){v1[0], v1[1]}), d = gelu_pk((f32x2){v1[2], v1[3]});
                        v0 = (f32x4){a.x, a.y, b.x, b.y}; v1 = (f32x4){c.x, c.y, d.x, d.y}; }
                    v0 = v0 * sc; v1 = v1 * sc; u32x4 w; w.x = cvt_pk_bf16(v0[0], v0[1]); w.y = cvt_pk_bf16(v0[2], v0[3]); w.z = cvt_pk_bf16(v1[0], v1[1]); w.w = cvt_pk_bf16(v1[2], v1[3]);
                    *(u32x4*)(rowp + bj * HALF) = w; } }
    }
};

struct PanelStats {
    unsigned* xbuf;
    unsigned* cnt;
    unsigned* tmo;
    int ntn; float eps;
    unsigned code;
    __device__ __forceinline__ bool run(const f32x4 (&v)[2][2][4][2], const Unit& u, int wr, int wc, int fr, int fq, PG8_LAS unsigned char* lds, int wid, int lane) const {
        typedef float f32x2v __attribute__((ext_vector_type(2)));
        PG8_LAS f32x2v* P = (PG8_LAS f32x2v*)lds;
        PG8_LAS f32x2v* S = (PG8_LAS f32x2v*)(lds + 8192);
        PG8_LAS unsigned* flag = (PG8_LAS unsigned*)(lds + 8192 + 2048);
#pragma unroll
        for (int ai = 0; ai < 2; ++ai)
#pragma unroll
            for (int m = 0; m < 4; ++m) {
                float s = 0.f;
#pragma unroll
                for (int bj = 0; bj < 2; ++bj)
#pragma unroll
                    for (int n = 0; n < 2; ++n) { const f32x4 x = v[ai][bj][m][n]; s += (x[0] + x[1]) + (x[2] + x[3]); }
                s += __shfl_xor(s, 16); s += __shfl_xor(s, 32);
                const float mw = s * (1.0f / 64.0f); float q = 0.f;
#pragma unroll
                for (int bj = 0; bj < 2; ++bj)
#pragma unroll
                    for (int n = 0; n < 2; ++n) { const f32x4 d = v[ai][bj][m][n] - mw; q += (d[0] * d[0] + d[1] * d[1]) + (d[2] * d[2] + d[3] * d[3]); }
                q += __shfl_xor(q, 16); q += __shfl_xor(q, 32);
                if (fq == 0) P[(ai * HALF + wr * 64 + m * 16 + fr) * 4 + wc] = (f32x2v){mw, q};
            }
        asm volatile("s_waitcnt lgkmcnt(0)" ::: "memory"); __builtin_amdgcn_s_barrier(); asm volatile("" ::: "memory");
#if defined(BROKEN_EXCHANGE_NO_WAIT)
#warning BROKEN CONTROL BUILD: the row-statistics exchange does not wait; results are wrong by design
        if (blockIdx.x >= 64) { const long long t0_ = clock64(); while (clock64() - t0_ < 60000) __builtin_amdgcn_s_sleep(8); }
#endif
        const int row = wid * 32 + (lane & 31);
        if (lane < 32) {
            const f32x2v a = P[row * 4 + 0], b = P[row * 4 + 1], c = P[row * 4 + 2], d = P[row * 4 + 3];
            const float mt = (a.x + b.x + c.x + d.x) * 0.25f;
            const float da = a.x - mt, db = b.x - mt, dc = c.x - mt, dd = d.x - mt;
            const float m2 = (a.y + b.y) + (c.y + d.y) + 64.0f * ((da * da + db * db) + (dc * dc + dd * dd));
            unsigned long long* slot = (unsigned long long*)xbuf + ((size_t)(u.pm * BM + row) * 4 + u.pn);
            __hip_atomic_store(slot, ((unsigned long long)__float_as_uint(m2) << 32) | __float_as_uint(mt), __ATOMIC_RELAXED, __HIP_MEMORY_SCOPE_AGENT);
        }
        asm volatile("s_waitcnt vmcnt(0)" ::: "memory");
        if (lane == 0) __hip_atomic_fetch_add(cnt + 64 * u.pm, 1u, __ATOMIC_RELAXED, __HIP_MEMORY_SCOPE_AGENT);
        if (wid == 0) {
            bool dead = false; const unsigned long long t0 = __builtin_amdgcn_s_memrealtime(); const unsigned want = 8u * (unsigned)ntn;
            for (;;) {
#if defined(BROKEN_EXCHANGE_NO_WAIT)
                break;
#endif
                if ((unsigned)__builtin_amdgcn_readfirstlane(__hip_atomic_load(cnt + 64 * u.pm, __ATOMIC_RELAXED, __HIP_MEMORY_SCOPE_AGENT)) >= want) break;
                if (__builtin_amdgcn_s_memrealtime() - t0 > 2000000ull) {
                    if (lane == 0) { unsigned expect = 0u; __hip_atomic_compare_exchange_strong(tmo + 1, &expect, code | (unsigned)(u.pm & 0xff), __ATOMIC_RELAXED, __ATOMIC_RELAXED, __HIP_MEMORY_SCOPE_AGENT);
                                     __hip_atomic_store(tmo, 1u, __ATOMIC_RELAXED, __HIP_MEMORY_SCOPE_AGENT); }
                    dead = true; break; }
                __builtin_amdgcn_s_sleep(2);
            }
            __builtin_amdgcn_fence(__ATOMIC_ACQUIRE, "agent");
            if (lane == 0) flag[0] = dead ? 1u : 0u;
        }
        asm volatile("s_waitcnt vmcnt(0) lgkmcnt(0)" ::: "memory"); __builtin_amdgcn_s_barrier(); asm volatile("" ::: "memory");
        const bool bad = flag[0] != 0u;
        if (lane < 32) {
            const unsigned long long* slot = (const unsigned long long*)xbuf + (size_t)(u.pm * BM + row) * 4; float mt[4], m2[4]; float ms = 0.f;
#pragma unroll
            for (int t = 0; t < 4; ++t) { if (t < ntn) { const unsigned long long w = __hip_atomic_load(slot + t, __ATOMIC_RELAXED, __HIP_MEMORY_SCOPE_AGENT); mt[t] = __uint_as_float((unsigned)w); m2[t] = __uint_as_float((unsigned)(w >> 32)); } else { mt[t] = 0.f; m2[t] = 0.f; } ms += mt[t]; }
            const float mean = ms / (float)ntn; float q = 0.f;
#pragma unroll
            for (int t = 0; t < 4; ++t) if (t < ntn) { const float dm = mt[t] - mean; q += m2[t] + 256.0f * dm * dm; }
            S[row] = (f32x2v){mean, 1.0f / sqrtf(q / (256.0f * (float)ntn) + eps)};
        }
        asm volatile("s_waitcnt lgkmcnt(0)" ::: "memory"); __builtin_amdgcn_s_barrier(); asm volatile("" ::: "memory");
        return bad;
    }
};
struct EpiLnRes {
    static constexpr bool PERM = false, AFTER_DRAIN = true;
    const float* base; float* out; int ldc; const float* bias; PanelStats st; unsigned poison;
    __device__ __forceinline__ void fused(f32x4 (&acc)[2][2][4][2], const Unit& u, int wr, int wc, int fr, int fq, PG8_LAS unsigned char* lds, int wid, int lane) const {
        typedef float f32x2v __attribute__((ext_vector_type(2)));
        const PG8_LAS f32x2v* S = (const PG8_LAS f32x2v*)(lds + 8192);
        const int col0 = u.pn * BM + wc * 32 + 4 * fq;
#pragma unroll
        for (int bj = 0; bj < 2; ++bj)
#pragma unroll
            for (int n = 0; n < 2; ++n) { const f32x4 bv = bias ? *(const f32x4*)(bias + col0 + bj * HALF + n * 16) : (f32x4){0.f, 0.f, 0.f, 0.f};
#pragma unroll
                for (int ai = 0; ai < 2; ++ai)
#pragma unroll
                    for (int m = 0; m < 4; ++m) acc[ai][bj][m][n] += bv; }
        f32x4 pre[4][2][2];
#pragma unroll
        for (int m = 0; m < 4; ++m) { const size_t off = (size_t)(u.pm * BM + wr * 64 + m * 16 + fr) * ldc + col0;
#pragma unroll
            for (int bj = 0; bj < 2; ++bj)
#pragma unroll
                for (int n = 0; n < 2; ++n) pre[m][bj][n] = *(const f32x4*)(base + off + bj * HALF + n * 16); }
        const bool bad = st.run(acc, u, wr, wc, fr, fq, lds, wid, lane) || poison != 0u;
        const float qnan = __builtin_nanf("");
#pragma unroll
        for (int ai = 0; ai < 2; ++ai)
#pragma unroll
            for (int m = 0; m < 4; ++m) { const int r = ai * HALF + wr * 64 + m * 16 + fr; const f32x2v sr = S[r]; const size_t off = (size_t)(u.pm * BM + r) * ldc + col0;
#pragma unroll
                for (int bj = 0; bj < 2; ++bj)
#pragma unroll
                    for (int n = 0; n < 2; ++n) { const f32x4 bs = ai == 0 ? pre[m][bj][n] : *(const f32x4*)(base + off + bj * HALF + n * 16); f32x4 o = bs + (acc[ai][bj][m][n] - sr.x) * sr.y;
                        if (bad) o = (f32x4){qnan, qnan, qnan, qnan}; *(f32x4*)(out + off + bj * HALF + n * 16) = o; }
                if (m & 1) asm volatile("" ::: "memory"); }
    }
};
struct EpiLnResLn {
    static constexpr bool PERM = false, AFTER_DRAIN = true;
    const float* base; float* out; bf16_t* xn; int ldc; const float* bias; PanelStats st1, st2; unsigned poison;
    __device__ __forceinline__ void fused(f32x4 (&acc)[2][2][4][2], const Unit& u, int wr, int wc, int fr, int fq, PG8_LAS unsigned char* lds, int wid, int lane) const {
        typedef float f32x2v __attribute__((ext_vector_type(2))); typedef unsigned u32x2v __attribute__((ext_vector_type(2)));
        const PG8_LAS f32x2v* S = (const PG8_LAS f32x2v*)(lds + 8192);
        const int col0 = u.pn * BM + wc * 32 + 4 * fq;
#pragma unroll
        for (int bj = 0; bj < 2; ++bj)
#pragma unroll
            for (int n = 0; n < 2; ++n) { const f32x4 bv = bias ? *(const f32x4*)(bias + col0 + bj * HALF + n * 16) : (f32x4){0.f, 0.f, 0.f, 0.f};
#pragma unroll
                for (int ai = 0; ai < 2; ++ai)
#pragma unroll
                    for (int m = 0; m < 4; ++m) acc[ai][bj][m][n] += bv; }
        bool bad = st1.run(acc, u, wr, wc, fr, fq, lds, wid, lane) || poison != 0u;
        const float qnan = __builtin_nanf("");
#pragma unroll
        for (int ai = 0; ai < 2; ++ai)
#pragma unroll
            for (int m = 0; m < 4; ++m) { const int r = ai * HALF + wr * 64 + m * 16 + fr; const f32x2v sr = S[r]; const size_t off = (size_t)(u.pm * BM + r) * ldc + col0;
#pragma unroll
                for (int bj = 0; bj < 2; ++bj)
#pragma unroll
                    for (int n = 0; n < 2; ++n) { const f32x4 bs = *(const f32x4*)(base + off + bj * HALF + n * 16); acc[ai][bj][m][n] = bs + (acc[ai][bj][m][n] - sr.x) * sr.y; }
                asm volatile("" : "+v"(acc[ai][0][m][0]), "+v"(acc[ai][0][m][1]), "+v"(acc[ai][1][m][0]), "+v"(acc[ai][1][m][1]));
                if (m & 1) asm volatile("" ::: "memory"); }
        const bool bad1 = bad;
        bad = st2.run(acc, u, wr, wc, fr, fq, lds, wid, lane) || bad;
#pragma unroll
        for (int ai = 0; ai < 2; ++ai)
#pragma unroll
            for (int m = 0; m < 4; ++m) { const int r = ai * HALF + wr * 64 + m * 16 + fr; const f32x2v sr = S[r]; const size_t off = (size_t)(u.pm * BM + r) * ldc + col0;
#pragma unroll
                for (int bj = 0; bj < 2; ++bj)
#pragma unroll
                    for (int n = 0; n < 2; ++n) { const f32x4 x1 = acc[ai][bj][m][n]; *(f32x4*)(out + off + bj * HALF + n * 16) = bad1 ? (f32x4){qnan, qnan, qnan, qnan} : x1;
                        const f32x4 o = (x1 - sr.x) * sr.y; u32x2v w; w.x = cvt_pk_bf16(o[0], o[1]); w.y = cvt_pk_bf16(o[2], o[3]);
                        if (bad) { w.x = 0x7fc07fc0u; w.y = 0x7fc07fc0u; } *(u32x2v*)(xn + off + bj * HALF + n * 16) = w; }
                asm volatile("" ::: "memory"); }
    }
};

template <class Epi, class Sched, bool ALIGN_EPI = false, bool SP2 = false>
__device__ __forceinline__ void gemm_phase(PG8_LAS unsigned char* lds, const Gemm g, const Sched& S, const Epi& E) {
    const int tid = opq_tid(), wid = __builtin_amdgcn_readfirstlane(tid >> 6), lane = tid & 63, wr = wid >> 2, wc = wid & 3, fr = lane & 15, fq = lane >> 4;
    const int K = g.K, nt = K / BK;
    unsigned voffA[2], voffB[2];
#pragma unroll
    for (int i = 0; i < 2; ++i) { int R, C; stage_rc(tid * 16 + i * 8192, R, C); const int Rb = Epi::PERM ? ((R & ~31) + perm32(R & 31)) : R;
        voffA[i] = (unsigned)(R * K + C) * 2u; voffB[i] = (unsigned)(Rb * K + C) * 2u; }
    const size_t kstep = (size_t)(BK * 2);
    const size_t hstep = (size_t)HALF * K * 2;
    const size_t tstep = 2 * hstep;
    const unsigned ldsw = (unsigned)wid * 1024u;
    const int aoff = lds_byte(wr * 64 + fr, fq * 8), boff = lds_byte(wc * 32 + fr, fq * 8);
#define PG8_SA(b, h) (((b) * 2 + (h)) * HTB)
#define PG8_SB(b, h) ((4 + (b) * 2 + (h)) * HTB)
#define PG8_STAGE(bufoff, gbase, voff) do { _Pragma("unroll") for (int _i = 0; _i < 2; ++_i) \
        __builtin_amdgcn_global_load_lds((const unsigned*)((const char*)(gbase) + (voff)[_i]), (PG8_LAS unsigned*)(lds + (bufoff) + ldsw + _i * 8192), 16, 0, 0); } while (0)
#define PG8_LDA(dst, b, h) do { _Pragma("unroll") for (int m = 0; m < 4; ++m) _Pragma("unroll") for (int k = 0; k < 2; ++k) dst[m][k] = *(const PG8_LAS bf16x8*)(lds + PG8_SA(b, h) + aoff + m * 2048 + k * 1024); } while (0)
#define PG8_LDB(dst, b, h) do { _Pragma("unroll") for (int n = 0; n < 2; ++n) _Pragma("unroll") for (int k = 0; k < 2; ++k) dst[n][k] = *(const PG8_LAS bf16x8*)(lds + PG8_SB(b, h) + boff + n * 2048 + k * 1024); } while (0)
#define PG8_MMA(ai, bj, At, Bt) do { __builtin_amdgcn_s_setprio(1); _Pragma("unroll") for (int m = 0; m < 4; ++m) _Pragma("unroll") for (int n = 0; n < 2; ++n) _Pragma("unroll") for (int k = 0; k < 2; ++k) \
        acc[ai][bj][m][n] = __builtin_amdgcn_mfma_f32_16x16x32_bf16(Bt[n][k], At[m][k], acc[ai][bj][m][n], 0, 0, 0); __builtin_amdgcn_s_setprio(0); } while (0)
#define PG8_WAIT_V(n) asm volatile("s_waitcnt vmcnt(" #n ")" ::: "memory")
#define PG8_WAIT_L(n) asm volatile("s_waitcnt lgkmcnt(" #n ")" ::: "memory")
#define PG8_BAR __builtin_amdgcn_s_barrier()
#define PG8_SCHED __builtin_amdgcn_sched_barrier(0)
    Unit cur, nxt; int ui = 0;
    if (!S.next(0, cur)) return;
    f32x4 acc[2][2][4][2];
#pragma unroll
    for (int a = 0; a < 2; ++a)
#pragma unroll
        for (int b = 0; b < 2; ++b)
#pragma unroll
            for (int m = 0; m < 4; ++m)
#pragma unroll
                for (int n = 0; n < 2; ++n) acc[a][b][m][n] = (f32x4){0.f, 0.f, 0.f, 0.f};
    bf16x8 At[4][2], B0[2][2], B1[2][2];
    const char* cA = (const char*)g.A + (size_t)cur.pm * tstep; const char* cB = (const char*)g.Bt + (size_t)cur.pn * tstep;
    S.a_ready(cur);
    if constexpr (SP2) {
        PG8_STAGE(PG8_SB(0, 0), cB, voffB); PG8_STAGE(PG8_SB(0, 1), cB + hstep, voffB); PG8_STAGE(PG8_SA(0, 0), cA, voffA); PG8_STAGE(PG8_SA(0, 1), cA + hstep, voffA);
        if (wr == 1) PG8_BAR;
        PG8_WAIT_V(2); PG8_BAR;
        PG8_STAGE(PG8_SB(1, 0), cB + kstep, voffB); PG8_STAGE(PG8_SA(1, 0), cA + kstep, voffA); PG8_STAGE(PG8_SB(1, 1), cB + hstep + kstep, voffB);
        PG8_WAIT_V(6); PG8_BAR;
    } else {
        PG8_STAGE(PG8_SB(0, 0), cB, voffB); PG8_STAGE(PG8_SA(0, 0), cA, voffA); PG8_STAGE(PG8_SB(0, 1), cB + hstep, voffB); PG8_STAGE(PG8_SA(0, 1), cA + hstep, voffA);
        if (wr == 1) PG8_BAR;
        PG8_WAIT_V(4); PG8_BAR;
        PG8_STAGE(PG8_SB(1, 0), cB + kstep, voffB); PG8_STAGE(PG8_SA(1, 0), cA + kstep, voffA); PG8_STAGE(PG8_SB(1, 1), cB + hstep + kstep, voffB);
        PG8_WAIT_V(6); PG8_BAR;
    }
    for (;;) {
        const bool has_next = S.next(ui + 1, nxt);
        const char* nA = has_next ? (const char*)g.A + (size_t)nxt.pm * tstep : cA; const char* nB = has_next ? (const char*)g.Bt + (size_t)nxt.pn * tstep : cB;
        for (int t = 0; t < nt; t += 2) {
            const bool last = (t == nt - 2);
            const char* a1 = cA + (size_t)(t + 1) * kstep;
            const char* a2 = last ? nA : cA + (size_t)(t + 2) * kstep; const char* b2 = last ? nB : cB + (size_t)(t + 2) * kstep;
            const char* a3 = a2 + kstep; const char* b3 = b2 + kstep;
            if (last && has_next) S.a_ready(nxt);
            if constexpr (SP2) {
            PG8_LDB(B0, 0, 0); PG8_LDB(B1, 0, 1); PG8_SCHED; PG8_LDA(At, 0, 0); PG8_STAGE(PG8_SA(1, 1), a1 + hstep, voffA);
            PG8_WAIT_V(8); PG8_WAIT_L(0); PG8_BAR; PG8_MMA(0, 0, At, B0); PG8_MMA(0, 1, At, B1); PG8_BAR; PG8_SCHED;
            PG8_LDA(At, 0, 1); PG8_STAGE(PG8_SB(0, 0), b2, voffB); PG8_STAGE(PG8_SB(0, 1), b2 + hstep, voffB); PG8_STAGE(PG8_SA(0, 0), a2, voffA);
            PG8_WAIT_V(8); PG8_WAIT_L(0); PG8_BAR; PG8_MMA(1, 0, At, B0); PG8_MMA(1, 1, At, B1); PG8_BAR; PG8_SCHED;
            PG8_LDB(B0, 1, 0); PG8_LDB(B1, 1, 1); PG8_SCHED; PG8_LDA(At, 1, 0); PG8_STAGE(PG8_SA(0, 1), a2 + hstep, voffA);
            PG8_WAIT_V(8); PG8_WAIT_L(0); PG8_BAR; PG8_MMA(0, 0, At, B0); PG8_MMA(0, 1, At, B1); PG8_BAR; PG8_SCHED;
            PG8_LDA(At, 1, 1); PG8_STAGE(PG8_SB(1, 0), b3, voffB); PG8_STAGE(PG8_SB(1, 1), b3 + hstep, voffB); PG8_STAGE(PG8_SA(1, 0), a3, voffA);
            PG8_WAIT_V(8); PG8_WAIT_L(0); PG8_BAR; PG8_MMA(1, 0, At, B0); PG8_MMA(1, 1, At, B1); PG8_BAR; PG8_SCHED;
            } else {
            PG8_LDB(B0, 0, 0); PG8_SCHED; PG8_LDA(At, 0, 0); PG8_STAGE(PG8_SA(1, 1), a1 + hstep, voffA);
            PG8_WAIT_L(8); PG8_BAR; PG8_WAIT_L(0); PG8_MMA(0, 0, At, B0); PG8_BAR; PG8_SCHED;
            PG8_LDB(B1, 0, 1); PG8_STAGE(PG8_SB(0, 0), b2, voffB);
            PG8_BAR; PG8_WAIT_L(0); PG8_MMA(0, 1, At, B1); PG8_BAR;
            PG8_LDA(At, 0, 1); PG8_STAGE(PG8_SA(0, 0), a2, voffA);
            PG8_BAR; PG8_WAIT_L(0); PG8_MMA(1, 0, At, B0); PG8_BAR; PG8_SCHED;
            PG8_STAGE(PG8_SB(0, 1), b2 + hstep, voffB);
            PG8_WAIT_V(6); PG8_BAR; PG8_MMA(1, 1, At, B1); PG8_BAR;
            PG8_LDB(B0, 1, 0); PG8_SCHED; PG8_LDA(At, 1, 0); PG8_STAGE(PG8_SA(0, 1), a2 + hstep, voffA);
            PG8_WAIT_L(8); PG8_BAR; PG8_WAIT_L(0); PG8_MMA(0, 0, At, B0); PG8_BAR; PG8_SCHED;
            PG8_LDB(B1, 1, 1); PG8_STAGE(PG8_SB(1, 0), b3, voffB);
            PG8_BAR; PG8_WAIT_L(0); PG8_MMA(0, 1, At, B1); PG8_BAR;
            PG8_LDA(At, 1, 1); PG8_STAGE(PG8_SA(1, 0), a3, voffA);
            PG8_BAR; PG8_WAIT_L(0); PG8_MMA(1, 0, At, B0); PG8_BAR; PG8_SCHED;
            PG8_STAGE(PG8_SB(1, 1), b3 + hstep, voffB);
            PG8_WAIT_V(6); PG8_BAR; PG8_MMA(1, 1, At, B1); PG8_BAR;
            }
        }
        if constexpr (ALIGN_EPI) { if (wr == 0) PG8_BAR; }
        if constexpr (!Epi::AFTER_DRAIN) { E(acc, cur, wr, wc, fr, fq); S.done(cur); }
        if (!has_next) break;
#pragma unroll
        for (int a = 0; a < 2; ++a)
#pragma unroll
            for (int b = 0; b < 2; ++b)
#pragma unroll
                for (int m = 0; m < 4; ++m)
#pragma unroll
                    for (int n = 0; n < 2; ++n) acc[a][b][m][n] = (f32x4){0.f, 0.f, 0.f, 0.f};
        cur = nxt; cA = nA; cB = nB; ++ui;
        if constexpr (ALIGN_EPI) { if (wr == 1) PG8_BAR; }
    }
    PG8_WAIT_V(0);
    if constexpr (!ALIGN_EPI) { if (wr == 0) PG8_BAR; }
    PG8_BAR;
    if constexpr (Epi::AFTER_DRAIN) { E.fused(acc, cur, wr, wc, fr, fq, lds, wid, lane); S.done(cur); }
#undef PG8_SA
#undef PG8_SB
#undef PG8_STAGE
#undef PG8_LDA
#undef PG8_LDB
#undef PG8_MMA
#undef PG8_WAIT_V
#undef PG8_WAIT_L
#undef PG8_BAR
#undef PG8_SCHED
}
}
namespace pg8 {
struct EpiF32 {
    static constexpr bool PERM = false, AFTER_DRAIN = false;
    float* C; int ldc;
    __device__ __forceinline__ void operator()(const f32x4 (&acc)[2][2][4][2], const Unit& u, int wr, int wc, int fr, int fq) const {
        const int row0 = u.pm * BM + wr * 64 + fr, col0 = u.pn * BM + wc * 32 + 4 * fq;
#pragma unroll
        for (int ai = 0; ai < 2; ++ai)
#pragma unroll
            for (int m = 0; m < 4; ++m) { float* rowp = C + (size_t)(row0 + ai * HALF + m * 16) * ldc + col0;
#pragma unroll
                for (int bj = 0; bj < 2; ++bj)
#pragma unroll
                    for (int n = 0; n < 2; ++n) *(f32x4*)(rowp + bj * HALF + n * 16) = acc[ai][bj][m][n]; }
    }
};
__device__ __forceinline__ float bf_lo(unsigned w) { return __uint_as_float(w << 16); }
__device__ __forceinline__ float bf_hi(unsigned w) { return __uint_as_float(w & 0xffff0000u); }
__device__ __forceinline__ float sigmoidf_(float x) { return 1.0f / (1.0f + __expf(-x)); }
struct EpiMerge {
    static constexpr bool PERM = true, AFTER_DRAIN = false;
    bf16_t* Mg; const bf16_t* glog; int ldg; int SP;
    __device__ __forceinline__ void operator()(const f32x4 (&acc)[2][2][4][2], const Unit& u, int wr, int wc, int fr, int fq) const {
        const int b = u.pn >> 2, pn = u.pn & 3, pm = u.pm - b * SP;
        const int row0 = pm * BM + wr * 64 + fr, col0 = pn * BM + wc * 32 + 8 * fq;
#pragma unroll
        for (int ai = 0; ai < 2; ++ai)
#pragma unroll
            for (int m = 0; m < 4; ++m) { const size_t row = (size_t)(row0 + ai * HALF + m * 16);
#pragma unroll
                for (int bj = 0; bj < 2; ++bj) { const int col = col0 + bj * HALF;
                    const u32x4 g = *(const u32x4*)(glog + row * ldg + b * 1024 + col);
                    f32x4 v0 = acc[ai][bj][m][0], v1 = acc[ai][bj][m][1];
                    v0[0] *= sigmoidf_(bf_lo(g.x)); v0[1] *= sigmoidf_(bf_hi(g.x)); v0[2] *= sigmoidf_(bf_lo(g.y)); v0[3] *= sigmoidf_(bf_hi(g.y));
                    v1[0] *= sigmoidf_(bf_lo(g.z)); v1[1] *= sigmoidf_(bf_hi(g.z)); v1[2] *= sigmoidf_(bf_lo(g.w)); v1[3] *= sigmoidf_(bf_hi(g.w));
                    u32x4* dst = (u32x4*)(Mg + row * 1024 + col);
                    if (b != 0) { const u32x4 o = *dst;
                        v0[0] += bf_lo(o.x); v0[1] += bf_hi(o.x); v0[2] += bf_lo(o.y); v0[3] += bf_hi(o.y);
                        v1[0] += bf_lo(o.z); v1[1] += bf_hi(o.z); v1[2] += bf_lo(o.w); v1[3] += bf_hi(o.w); }
                    u32x4 w; w.x = cvt_pk_bf16(v0[0], v0[1]); w.y = cvt_pk_bf16(v0[2], v0[3]); w.z = cvt_pk_bf16(v1[0], v1[1]); w.w = cvt_pk_bf16(v1[2], v1[3]);
                    *dst = w; } }
    }
};
struct MergeOrder {
    int NP, SP, nwg, G, c;
    __host__ __device__ void init(int NP_, int SP_, int G_, int c_) { NP = NP_; SP = SP_; nwg = NP_ * 4; G = G_; c = c_; }
    __host__ __device__ bool next(int i, Unit& u) const {
        const int ti = i / 3, b = i - 3 * ti;
        const long L = (long)ti * G + c; if (L >= nwg) return false;
        int wgid = (int)L; { const int q = nwg / NXCD, r = nwg % NXCD, xcd = wgid % NXCD, off = wgid / NXCD; wgid = (xcd < r ? xcd * (q + 1) : r * (q + 1) + (xcd - r) * q) + off; }
        const int nN = 4, nig = WGM * nN, gid = wgid / nig, fm = gid * WGM, gsz = (NP - fm) < WGM ? (NP - fm) : WGM;
        const int pm = fm + ((wgid % nig) % gsz), pn = (wgid % nig) / gsz;
        u.pm = b * SP + pm; u.pn = b * 4 + pn; return true;
    }
    __device__ __forceinline__ void a_ready(const Unit&) const {}
    __device__ __forceinline__ void done(const Unit&) const {}
};
}
#include <hip/hip_bf16.h>
#include <cmath>
namespace attn_body {
using bf16=__hip_bfloat16;
using bf16x8=__attribute__((ext_vector_type(8)))short;
using s16x4=__attribute__((ext_vector_type(4)))short;
using f32x16=__attribute__((ext_vector_type(16)))float;
using u32x4=__attribute__((ext_vector_type(4)))unsigned;
constexpr int D=64;
constexpr int NW=8,QBLK=32,QB=QBLK*NW,KVBLK=64;
constexpr int ATTN_UNIT_ROWS=QB;
__device__ __forceinline__ int crow(int r,int hi){return (r&3)+8*(r>>2)+4*hi;}
#define SBAR() __builtin_amdgcn_sched_barrier(0)
constexpr int WIN=128;
__device__ __forceinline__ void wmask(f32x16&p0,f32x16&p1,int kd){
  const float NEG=-INFINITY;
  #pragma unroll
  for(int r=0;r<16;++r){const int d0=kd+(r&3)+8*(r>>2); if(d0>WIN||d0<-WIN)p0[r]=NEG; const int d1=d0+32; if(d1>WIN||d1<-WIN)p1[r]=NEG;}
}
struct AttnJob {
  const bf16* Q; const bf16* K; const bf16* V; bf16* O;
  int qp, kp, op;
  int nt, nt0, row1;
  int qpos0, kpos1;
  float sink2;
};
constexpr int NSLOT=3, SLOTB=8192;
constexpr int LDS_K=0, LDS_V=NSLOT*SLOTB, LDS_WS=2*NSLOT*SLOTB, LDS_OST=LDS_WS+NW*64*4, LDS_BYTES=LDS_OST+NW*4096;
constexpr float C2=0.125f*1.4426950408889634f;
__device__ __forceinline__ void glds16(const void*gsrc,unsigned lds_dst){unsigned keep;
  asm volatile("s_mov_b32 %0, m0\n\ts_mov_b32 m0, %2\n\ts_nop 0\n\tglobal_load_lds_dwordx4 %1, off\n\ts_mov_b32 m0, %0":"=&s"(keep):"v"(gsrc),"s"(lds_dst):"memory");}
__device__ __forceinline__ float max3f(float a,float b,float c){float r;asm("v_max3_f32 %0, %1, %2, %3":"=v"(r):"v"(a),"v"(b),"v"(c));return r;}
__device__ __forceinline__ float max2f(float a,float b){float r;asm("v_max_f32_e32 %0, %1, %2":"=v"(r):"v"(a),"v"(b));return r;}
__device__ __forceinline__ float fadd_s(float a,float b){float r;asm("v_add_f32_e32 %0, %1, %2":"=v"(r):"v"(a),"v"(b));return r;}
__device__ __forceinline__ float fsub_s(float a,float b){float r;asm("v_sub_f32_e32 %0, %1, %2":"=v"(r):"v"(a),"v"(b));return r;}
typedef float f32x2_t __attribute__((ext_vector_type(2))); typedef __bf16 bf16x2_t __attribute__((ext_vector_type(2)));
__device__ __forceinline__ unsigned cvtpk_s(float lo,float hi){f32x2_t v={lo,hi};bf16x2_t b=__builtin_convertvector(v,bf16x2_t);return __builtin_bit_cast(unsigned,b);}
#define WAIT_BAR(N) asm volatile("s_waitcnt vmcnt(" #N ") lgkmcnt(0)\n\ts_barrier":::"memory")

__device__ __forceinline__ void qkt(f32x16&p0,f32x16&p1,const char*Kslot,const bf16x8*qr,const f32x16&negm,int r32,int hi){
  const char*kb=Kslot+hi*1024+r32*16;
  #pragma unroll
  for(int d0=0;d0<4;++d0){
    const bf16x8 b0=*reinterpret_cast<const bf16x8*>(kb+d0*2048);
    const bf16x8 b1=*reinterpret_cast<const bf16x8*>(kb+d0*2048+512);
    if(d0==0){p0=__builtin_amdgcn_mfma_f32_32x32x16_bf16(b0,qr[0],negm,0,0,0);p1=__builtin_amdgcn_mfma_f32_32x32x16_bf16(b1,qr[0],negm,0,0,0);}
    else{p0=__builtin_amdgcn_mfma_f32_32x32x16_bf16(b0,qr[d0],p0,0,0,0);p1=__builtin_amdgcn_mfma_f32_32x32x16_bf16(b1,qr[d0],p1,0,0,0);}}
}
typedef __attribute__((address_space(3))) const char* lds_cptr;
typedef short v4i16_t __attribute__((ext_vector_type(4)));
__device__ __forceinline__ void kload8(bf16x8*kf,lds_cptr kp){
  kf[0]=*(const __attribute__((address_space(3))) bf16x8*)(kp);      kf[1]=*(const __attribute__((address_space(3))) bf16x8*)(kp+512);
  kf[2]=*(const __attribute__((address_space(3))) bf16x8*)(kp+2048); kf[3]=*(const __attribute__((address_space(3))) bf16x8*)(kp+2560);
  kf[4]=*(const __attribute__((address_space(3))) bf16x8*)(kp+4096); kf[5]=*(const __attribute__((address_space(3))) bf16x8*)(kp+4608);
  kf[6]=*(const __attribute__((address_space(3))) bf16x8*)(kp+6144); kf[7]=*(const __attribute__((address_space(3))) bf16x8*)(kp+6656);
}
__device__ __forceinline__ void kload2(bf16x8*kf,lds_cptr kp,int j){ kf[2*j]=*(const __attribute__((address_space(3))) bf16x8*)(kp+j*2048); kf[2*j+1]=*(const __attribute__((address_space(3))) bf16x8*)(kp+j*2048+512); }
__device__ __forceinline__ s16x4 vtr(lds_cptr p){ return __builtin_bit_cast(s16x4,__builtin_amdgcn_ds_read_tr16_b64_v4i16((__attribute__((address_space(3))) v4i16_t*)p)); }
__device__ __forceinline__ float rowmax(const f32x16&p0,const f32x16&p1){
  float a=max3f(p0[0],p0[1],p1[0]),b=max3f(p0[2],p0[3],p1[1]);a=max3f(a,p1[2],p1[3]);
  #pragma unroll
  for(int r=4;r<16;r+=4){a=max3f(a,p0[r],p0[r+1]);b=max3f(b,p0[r+2],p0[r+3]);a=max3f(a,p1[r],p1[r+1]);b=max3f(b,p1[r+2],p1[r+3]);}
  const float m=max2f(a,b);
  auto rr=__builtin_amdgcn_permlane32_swap(__float_as_uint(m),__float_as_uint(m),false,false);
  return max2f(__uint_as_float(rr[0]),__uint_as_float(rr[1]));
}
__device__ __forceinline__ void pv(f32x16*o,int vb,bf16x8 pa0,bf16x8 pa1,bf16x8 pa2,bf16x8 pa3){
  #pragma unroll
  for(int d0=0;d0<2;++d0){s16x4 lo[4],hi[4];
    #pragma unroll
    for(int ks=0;ks<4;++ks){
      asm volatile("ds_read_b64_tr_b16 %0,%1 offset:%c2":"=&v"(lo[ks]):"v"(vb),"i"(d0*4096+ks*1024):"memory");
      asm volatile("ds_read_b64_tr_b16 %0,%1 offset:%c2":"=&v"(hi[ks]):"v"(vb),"i"(d0*4096+ks*1024+512):"memory");}
    asm volatile("s_waitcnt lgkmcnt(0)":::"memory");SBAR();
    #define PK(k) (bf16x8){lo[k][0],lo[k][1],lo[k][2],lo[k][3],hi[k][0],hi[k][1],hi[k][2],hi[k][3]}
    o[d0]=__builtin_amdgcn_mfma_f32_32x32x16_bf16(pa0,PK(0),o[d0],0,0,0);
    o[d0]=__builtin_amdgcn_mfma_f32_32x32x16_bf16(pa1,PK(1),o[d0],0,0,0);
    o[d0]=__builtin_amdgcn_mfma_f32_32x32x16_bf16(pa2,PK(2),o[d0],0,0,0);
    o[d0]=__builtin_amdgcn_mfma_f32_32x32x16_bf16(pa3,PK(3),o[d0],0,0,0);
    #undef PK
  }
}

#ifndef ATTN_STORE16
#define ATTN_STORE16(p,v) (*(u32x4*)(p)=(v))
#endif
template<int THRL,int MODE> __device__ __forceinline__ void attn_unit(const AttnJob&J,char*shm){
  const int QP=J.qp,KP=J.kp,OP=J.op,NT0=J.nt0,ROW1=J.row1;
  const int tid=opq_tid(),lane=tid&63,r32=lane&31,hi=lane>>5; const int wid=__builtin_amdgcn_readfirstlane(tid>>6);
  const bf16*Qw=J.Q+(long)(wid*QBLK)*QP;
  const bf16*Kh=J.K,*Vh=J.V;
  const unsigned lds0=(unsigned)(uintptr_t)shm;
  float*wsf=(float*)(shm+LDS_WS)+wid*64;
  const bf16*ksrc=Kh+(long)lane*KP+wid*8;
  const bf16*vsrc=Vh+(long)(16*(wid&3)+(lane>>2))*KP+(wid>>2)*32+(lane&3)*8;
  const unsigned kdst=lds0+LDS_K+wid*1024, vdst=lds0+LDS_V+wid*1024;
  #define TROW(t) ((t)<NT0?(t)*KVBLK:ROW1+((t)-NT0)*KVBLK)
  #define DMA_K(t,slot) glds16(ksrc+(long)TROW(t)*KP,(unsigned)__builtin_amdgcn_readfirstlane(kdst+(slot)))
  #define DMA_V(t,slot) glds16(vsrc+(long)TROW(t)*KP,(unsigned)__builtin_amdgcn_readfirstlane(vdst+(slot)))
  const int vb0=(int)(lds0+LDS_V)+((lane>>4)&1)*32+(lane&3)*8+(4*hi+((lane&15)>>2))*64;
  const char*Kbase=shm+LDS_K; bf16x8 kf[8];
  const lds_cptr shm3=(lds_cptr)shm; const lds_cptr kp0=shm3+LDS_K+hi*1024+r32*16; const lds_cptr vp0=shm3+LDS_V+((lane>>4)&1)*32+(lane&3)*8+(4*hi+((lane&15)>>2))*64;
  const int NT=J.nt;
  DMA_K(0,0);DMA_V(0,0);DMA_K(1,SLOTB);
  bf16x8 qr[4];
  #pragma unroll
  for(int d0=0;d0<4;++d0)qr[d0]=*reinterpret_cast<const bf16x8*>(&Qw[(long)r32*QP+d0*16+hi*8]);
  float mhat=0.f,l_reg=0.f;f32x16 o[2];o[0]=f32x16{};o[1]=f32x16{};f32x16 negm=f32x16{};if constexpr(MODE==0)asm volatile("":"+v"(negm));
  const int kd0=J.kpos1+4*hi-(J.qpos0+wid*QBLK+r32);
  #define CMASK(P0,P1,t) do{ if constexpr(MODE==1){ if((t)>=NT0) wmask(P0,P1,kd0+((t)-NT0)*KVBLK); } }while(0)
  bool resc=false;
  #define START(P0,P1) do{ const float rm=rowmax(P0,P1); resc=false; \
    { const float dl=rm; mhat=fadd_s(mhat,dl); \
      _Pragma("unroll") for(int r=0;r<16;++r){P0[r]=fsub_s(P0[r],dl);P1[r]=fsub_s(P1[r],dl);} \
      if constexpr(MODE==0){ _Pragma("unroll") for(int r=0;r<16;++r)negm[r]=-mhat; asm volatile("":"+v"(negm)); } } \
    _Pragma("unroll") for(int r=0;r<16;++r)P0[r]=__builtin_amdgcn_exp2f(P0[r]); }while(0)
  #define RESC() do{ if(resc){ asm volatile("s_waitcnt lgkmcnt(0)":::"memory"); \
      _Pragma("unroll") for(int d_=0;d_<2;++d_) _Pragma("unroll") for(int r=0;r<16;++r)o[d_][r]*=wsf[crow(r,hi)]; } }while(0)
  f32x16 pA0,pA1,pB0,pB1;
  int sl_prev=0,sl_cur=0,sl_next=SLOTB;
  #define ROT() do{sl_prev=sl_cur;sl_cur=sl_next;sl_next=(sl_next==(NSLOT-1)*SLOTB)?0:sl_next+SLOTB;}while(0)
  DMA_K(2,2*SLOTB);
  WAIT_BAR(3);
  qkt(pA0,pA1,Kbase,qr,f32x16{},r32,hi);asm volatile("s_nop 15\n\ts_nop 7":"+v"(pA0),"+v"(pA1));CMASK(pA0,pA1,0);
  START(pA0,pA1);
  _Pragma("unroll") for(int r=0;r<16;++r)pA1[r]=__builtin_amdgcn_exp2f(pA1[r]);
  WAIT_BAR(0);
  DMA_K(3,0);DMA_V(1,SLOTB);
  ROT();
  kload8(kf,kp0+sl_cur);
  WAIT_BAR(2);
  s16x4 vlo[8],vhi[8]; u32x4 pw0,pw1,pw2,pw3;
  #define PKW(P,B) cvtpk_s(P[B],P[B+1])
  #define PAF(k) __builtin_bit_cast(bf16x8,pw##k)
  #define VFR(i) (bf16x8){vlo[i][0],vlo[i][1],vlo[i][2],vlo[i][3],vhi[i][0],vhi[i][1],vhi[i][2],vhi[i][3]}
  #define PIN(x) asm volatile("":"+v"(x))
  #define MX3(a,b,c) __builtin_fmaxf(__builtin_fmaxf((a),(b)),(c))
  #define GAPA(MF,A0,A1,A2,A3,W0,W1,PW) do{ MF; sacc+=A0; sacc+=A1; sacc+=A2; sacc+=A3; PIN(sacc); W0; W1; PIN(PW); SBAR(); }while(0)
  #define EX(v) __builtin_amdgcn_exp2f(MODE==1?(v)-mhat:(v))
  #define CINIT (MODE==1?f32x16{}:negm)
  #define GAPB(MF,X,B) do{ MF; X[B]=EX(X[B]); X[B+1]=EX(X[B+1]); X[B+2]=EX(X[B+2]); X[B+3]=EX(X[B+3]); PIN(X); SBAR(); }while(0)
  #define VRD(i) do{ vlo[i]=vtr(vp_+(((i)>>2)*4096+((i)&3)*1024)); vhi[i]=vtr(vp_+(((i)>>2)*4096+((i)&3)*1024+512)); }while(0)
  #define KRD(G,j) do{ if(G){ kload2(kf,kp0+sl_next,j); SBAR(); } }while(0)
  #define STEP(C0,C1,P0,P1,t,GK,GV,GL) do{ SBAR(); \
    const lds_cptr vp_=vp0+sl_prev; \
    VRD(0); SBAR(); float sacc=(P0[0]+P0[1]); \
    GAPA(C0=__builtin_amdgcn_mfma_f32_32x32x16_bf16(kf[0],qr[0],CINIT,0,0,0), P0[2],P0[3],P0[4],P0[5],     pw0[0]=PKW(P0,0), pw0[1]=PKW(P0,2), pw0); \
    VRD(4); SBAR(); GAPA(C1=__builtin_amdgcn_mfma_f32_32x32x16_bf16(kf[1],qr[0],CINIT,0,0,0), P0[6],P0[7],P0[8],P0[9],     pw0[2]=PKW(P0,4), pw0[3]=PKW(P0,6), pw0); \
    VRD(1); SBAR(); GAPA(C0=__builtin_amdgcn_mfma_f32_32x32x16_bf16(kf[2],qr[1],C0,0,0,0),   P0[10],P0[11],P0[12],P0[13], pw1[0]=PKW(P0,8), pw1[1]=PKW(P0,10), pw1); \
    VRD(5); SBAR(); GAPA(C1=__builtin_amdgcn_mfma_f32_32x32x16_bf16(kf[3],qr[1],C1,0,0,0),   P0[14],P0[15],P1[0],P1[1],   pw1[2]=PKW(P0,12),pw1[3]=PKW(P0,14), pw1); \
    VRD(2); SBAR(); GAPA(C0=__builtin_amdgcn_mfma_f32_32x32x16_bf16(kf[4],qr[2],C0,0,0,0),   P1[2],P1[3],P1[4],P1[5],     pw2[0]=PKW(P1,0), pw2[1]=PKW(P1,2), pw2); \
    VRD(6); SBAR(); GAPA(C1=__builtin_amdgcn_mfma_f32_32x32x16_bf16(kf[5],qr[2],C1,0,0,0),   P1[6],P1[7],P1[8],P1[9],     pw2[2]=PKW(P1,4), pw2[3]=PKW(P1,6), pw2); \
    VRD(3); SBAR(); GAPA(C0=__builtin_amdgcn_mfma_f32_32x32x16_bf16(kf[6],qr[3],C0,0,0,0),   P1[10],P1[11],P1[12],P1[13], pw3[0]=PKW(P1,8), pw3[1]=PKW(P1,10), pw3); \
    VRD(7); SBAR(); GAPA(C1=__builtin_amdgcn_mfma_f32_32x32x16_bf16(kf[7],qr[3],C1,0,0,0),   P1[14],P1[15],0.f,0.f,       pw3[2]=PKW(P1,12),pw3[3]=PKW(P1,14), pw3); \
    l_reg+=sacc; \
    if(GK){DMA_K((t)+3,sl_cur);} if(GV){DMA_V((t)+1,sl_next);} \
    CMASK(C0,C1,t); \
    { float a=MX3(C0[0],C0[1],C1[0]),b=MX3(C0[2],C0[3],C1[1]); a=MX3(a,C1[2],C1[3]); \
      _Pragma("unroll") for(int r=4;r<16;r+=4){a=MX3(a,C0[r],C0[r+1]);b=MX3(b,C0[r+2],C0[r+3]);a=MX3(a,C1[r],C1[r+1]);b=MX3(b,C1[r+2],C1[r+3]);} \
      float rm=__builtin_fmaxf(a,b); { auto rr=__builtin_amdgcn_permlane32_swap(__float_as_uint(rm),__float_as_uint(rm),false,false); rm=__builtin_fmaxf(__uint_as_float(rr[0]),__uint_as_float(rr[1])); } \
      if constexpr(MODE==1) rm-=mhat; \
      resc=false; \
      if(__builtin_expect(__any(rm>(float)THRL),0)){ const float dl=__builtin_fmaxf(rm,0.f); mhat+=dl; \
        if constexpr(MODE==0){ _Pragma("unroll") for(int r=0;r<16;++r){C0[r]-=dl;C1[r]-=dl;} \
        _Pragma("unroll") for(int r=0;r<16;++r)negm[r]=-mhat; asm volatile("":"+v"(negm)); } \
        const float f=__builtin_amdgcn_exp2f(-dl); l_reg*=f; if(hi==0)wsf[r32]=f; resc=true; } } \
    SBAR(); \
    GAPB(o[0]=__builtin_amdgcn_mfma_f32_32x32x16_bf16(PAF(0),VFR(0),o[0],0,0,0), C0,0); \
    GAPB(o[1]=__builtin_amdgcn_mfma_f32_32x32x16_bf16(PAF(0),VFR(4),o[1],0,0,0), C0,4); \
    KRD(GL,0); GAPB(o[0]=__builtin_amdgcn_mfma_f32_32x32x16_bf16(PAF(1),VFR(1),o[0],0,0,0), C0,8); \
    KRD(GL,1); GAPB(o[1]=__builtin_amdgcn_mfma_f32_32x32x16_bf16(PAF(1),VFR(5),o[1],0,0,0), C0,12); \
    KRD(GL,2); GAPB(o[0]=__builtin_amdgcn_mfma_f32_32x32x16_bf16(PAF(2),VFR(2),o[0],0,0,0), C1,0); \
    KRD(GL,3); GAPB(o[1]=__builtin_amdgcn_mfma_f32_32x32x16_bf16(PAF(2),VFR(6),o[1],0,0,0), C1,4); \
    GAPB(o[0]=__builtin_amdgcn_mfma_f32_32x32x16_bf16(PAF(3),VFR(3),o[0],0,0,0), C1,8); \
    GAPB(o[1]=__builtin_amdgcn_mfma_f32_32x32x16_bf16(PAF(3),VFR(7),o[1],0,0,0), C1,12); \
    }while(0)
  int t=1;
  for(;t+5<NT;t+=2){
    STEP(pB0,pB1,pA0,pA1,t,true,true,true);     WAIT_BAR(2); RESC(); ROT();
    STEP(pA0,pA1,pB0,pB1,t+1,true,true,true);   WAIT_BAR(2); RESC(); ROT();
  }
  #define ENDW(tt) do{ if((tt)+3<NT){WAIT_BAR(2);} else if((tt)+2<NT){WAIT_BAR(1);} else {WAIT_BAR(0);} }while(0)
  for(;t+1<NT;t+=2){
    STEP(pB0,pB1,pA0,pA1,t,(t+3<NT),(t+1<NT),(t+1<NT));       ENDW(t);   RESC(); ROT();
    STEP(pA0,pA1,pB0,pB1,t+1,(t+4<NT),(t+2<NT),(t+2<NT));     ENDW(t+1); RESC(); ROT();
  }
  STEP(pB0,pB1,pA0,pA1,NT-1,false,false,false); RESC();
  { float sacc=pB0[0]+pB0[1]; _Pragma("unroll") for(int r=2;r<16;++r)sacc+=pB0[r]; _Pragma("unroll") for(int r=0;r<16;++r)sacc+=pB1[r]; l_reg+=sacc;
    pw0=(u32x4){PKW(pB0,0),PKW(pB0,2),PKW(pB0,4),PKW(pB0,6)};pw1=(u32x4){PKW(pB0,8),PKW(pB0,10),PKW(pB0,12),PKW(pB0,14)};pw2=(u32x4){PKW(pB1,0),PKW(pB1,2),PKW(pB1,4),PKW(pB1,6)};pw3=(u32x4){PKW(pB1,8),PKW(pB1,10),PKW(pB1,12),PKW(pB1,14)};
    SBAR(); pv(o,vb0+sl_cur,PAF(0),PAF(1),PAF(2),PAF(3)); }
  #undef PKW
  #undef PAF
  #undef VFR
  #undef PIN
  #undef MX3
  #undef GAPA
  #undef GAPB
  #undef EX
  #undef CINIT
  #undef VRD
  #undef KRD
  #undef STEP
  #undef ENDW
  {auto rr=__builtin_amdgcn_permlane32_swap(__float_as_uint(l_reg),__float_as_uint(l_reg),false,false);l_reg=__uint_as_float(rr[0])+__uint_as_float(rr[1]);}
  l_reg+=__builtin_amdgcn_exp2f(J.sink2-mhat);
  if(hi==0)wsf[32+r32]=l_reg;asm volatile("s_waitcnt lgkmcnt(0)":::"memory");
  float rli[16];
  #pragma unroll
  for(int r=0;r<16;++r)rli[r]=__builtin_amdgcn_rcpf(wsf[32+crow(r,hi)]);
  bf16*Ow=J.O+(long)(wid*QBLK)*OP;
  { bf16*stg=(bf16*)(shm+LDS_OST)+wid*2048;
    #pragma unroll
    for(int r=0;r<16;++r){const int orow=crow(r,hi);
      #pragma unroll
      for(int d0=0;d0<2;++d0)stg[orow*64+d0*32+r32]=__float2bfloat16(o[d0][r]*rli[r]);}
    asm volatile("s_waitcnt lgkmcnt(0)":::"memory");
    #pragma unroll
    for(int i=0;i<4;++i){const int row=i*8+(lane>>3),ch=lane&7; const u32x4 v=*(const u32x4*)(stg+row*64+ch*8); ATTN_STORE16(Ow+(long)row*OP+ch*8,v);} }
  asm volatile("s_waitcnt lgkmcnt(0)\n\ts_barrier":::"memory");
  #undef TROW
  #undef DMA_K
  #undef DMA_V
  #undef CMASK
  #undef START
  #undef RESC
  #undef ROT
}
constexpr int ATTN_LDS_BYTES=LDS_BYTES;
#undef SBAR
#undef WAIT_BAR
}
#define GAS __attribute__((address_space(1)))
#define LAS __attribute__((address_space(3)))
typedef unsigned short bf16;
typedef unsigned v4u __attribute__((ext_vector_type(4)));
typedef float f32x4 __attribute__((ext_vector_type(4)));
typedef short bf16x8 __attribute__((ext_vector_type(8)));
typedef GAS unsigned gu32;
typedef GAS unsigned long long gu64;
#define RLX_AGENT __ATOMIC_RELAXED, __HIP_MEMORY_SCOPE_AGENT
#define LDS_WAIT() asm volatile("s_waitcnt lgkmcnt(0)" ::: "memory")
#define VM_WAIT() asm volatile("s_waitcnt vmcnt(0)" ::: "memory")
__device__ __forceinline__ unsigned long long rt() { return __builtin_amdgcn_s_memrealtime(); }
__device__ __forceinline__ unsigned f2bf(float f) { unsigned u = __builtin_bit_cast(unsigned, f); return (u + 0x7fffu + ((u >> 16) & 1u)) >> 16; }
__device__ __forceinline__ unsigned pk2(float lo, float hi) { return f2bf(lo) | (f2bf(hi) << 16); }

#define XB_TMO      128
#define XB_XCNT(j)  (256  + 64 * (j))
#define XB_XSUB(j)  (1280 + 64 * (j))
#define XB_XGEN(j)  (2304 + 64 * (j))
#define XB_TOP      3328
#define XB_TOPGEN   3392
#define XCD_BAR_WORDS 3456
#define XB_SPIN_CAP (1u << 18)

__device__ __forceinline__ unsigned xb_ld(unsigned* p)              { return __hip_atomic_load(p, __ATOMIC_RELAXED, __HIP_MEMORY_SCOPE_AGENT); }
__device__ __forceinline__ unsigned xb_add(unsigned* p, unsigned v) { return __hip_atomic_fetch_add(p, v, __ATOMIC_RELAXED, __HIP_MEMORY_SCOPE_AGENT); }
__device__ __forceinline__ unsigned xb_xcc_id() { return (unsigned)__builtin_amdgcn_s_getreg((3 << 11) | 20) & 0xFu; }
#define XB_SPIN(cond, bar) do { unsigned _sp = 0; while (cond) { __builtin_amdgcn_s_sleep(1); \
    if ((++_sp & 255u) == 0u) { if (xb_ld(&(bar)[XB_TMO])) break; if (_sp > XB_SPIN_CAP) { atomicAdd(&(bar)[XB_TMO], 1u); break; } } } } while (0)

struct XcdBarrier {
    unsigned* bar; unsigned x;
    volatile LAS unsigned* st;
};

__device__ __forceinline__ XcdBarrier xcd_barrier_post(unsigned* bar, volatile LAS unsigned* st) {
    XcdBarrier b; b.bar = bar; b.x = xb_xcc_id(); b.st = st;
    if (opq_tid() == 0) (void)xb_add(&bar[XB_XCNT(b.x)], 1u);
    return b;
}
__device__ __forceinline__ void xcd_barrier_complete(unsigned* bar, unsigned x, unsigned& nloc, unsigned& nx) {
    const unsigned G = gridDim.x * gridDim.y * gridDim.z;
    unsigned sum, cnt, mine, sp = 0u;
    for (;;) {
        sum = 0u; cnt = 0u; mine = 0u;
#pragma unroll
        for (unsigned j = 0; j < 16; ++j) { const unsigned c = xb_ld(&bar[XB_XCNT(j)]); sum += c; cnt += (c > 0u) ? 1u : 0u; mine = (j == x) ? c : mine; }
        if (sum == G) break;
        __builtin_amdgcn_s_sleep(1);
        if ((++sp & 255u) == 0u) { if (xb_ld(&bar[XB_TMO])) break; if (sp > XB_SPIN_CAP) { atomicAdd(&bar[XB_TMO], 1u); break; } }
    }
    nloc = mine > 0u ? mine : 1u; nx = cnt > 0u ? cnt : 1u;
}

__device__ __forceinline__ void xcd_barrier(const XcdBarrier& b) {
    asm volatile("s_waitcnt vmcnt(0)" ::: "memory");
    __syncthreads();
    if (opq_tid() == 0) {
        GAS unsigned* barg = (GAS unsigned*)b.bar; unsigned bxx = b.x; asm volatile("" : "+s"(barg), "+s"(bxx)); unsigned* bar = (unsigned*)barg;
        __builtin_amdgcn_s_waitcnt(0);
        unsigned nloc = b.st[0], nx = b.st[1];
        if (nloc == 0u) { xcd_barrier_complete(bar, bxx, nloc, nx); b.st[0] = nloc; b.st[1] = nx; }
        const unsigned old = xb_add(&bar[XB_XSUB(bxx)], 1u);
        const unsigned gen = old / nloc;
        if (old + 1u == (gen + 1u) * nloc) {
            __builtin_amdgcn_fence(__ATOMIC_RELEASE, "agent");
            asm volatile("s_waitcnt vmcnt(0)" ::: "memory");
            const unsigned og = xb_add(&bar[XB_TOP], 1u);
            const unsigned tg = og / nx;
            if (og + 1u == (tg + 1u) * nx) xb_add(&bar[XB_TOPGEN], 1u);
            else XB_SPIN(xb_ld(&bar[XB_TOPGEN]) == tg, bar);
            __builtin_amdgcn_fence(__ATOMIC_ACQUIRE, "agent");
            xb_add(&bar[XB_XGEN(bxx)], 1u);
            asm volatile("s_waitcnt vmcnt(0)" ::: "memory");
        } else {
            XB_SPIN(xb_ld(&bar[XB_XGEN(bxx)]) == gen, bar);
            __builtin_amdgcn_fence(__ATOMIC_ACQUIRE, "agent");
            asm volatile("s_waitcnt vmcnt(0)" ::: "memory");
        }
    }
    __syncthreads();
}
namespace cg = cooperative_groups;
constexpr int NWAVES = 8, NTHREADS = 512;
constexpr int R = 16640, NCTX = 256, SEQ = 16384, DM = 1024, INC = 6144, NL = 2, NEXP = 16384, SPAN = 65;
constexpr float ALPHA = 1.41421356237f, LN_EPS = 1e-6f, RMS_EPS = 1e-6f, LOG2E = 1.4426950408889634f;
constexpr float QSCALE = 0.125f * 1.4426950408889634f;
constexpr int C_QA = 0, C_KA = 512, C_VA = 640, C_QC = 768, C_KC = 1280, C_VC = 1408, C_XB = 1536, C_GB = 2048, C_GC = 2560, C_GL = 3072;
enum { I_X = 0, I_C, I_CTX, I_CCTX, I_WMOD, I_BMOD, I_WIN, I_QN, I_KN, I_CONVW, I_SINK, I_WBR, I_WOUT, I_LN1G, I_LN1B, I_WPQ, I_SK, I_UT, I_VT, I_LN2G, I_LN2B, N_IN };
constexpr size_t MiB = 1u << 20;
constexpr size_t WS_CTL = 0, CTL_ZERO_BYTES = 1 * MiB;
constexpr size_t WS_MODP = 1 * MiB;
constexpr size_t WS_MODV = WS_MODP + 1536 * 1024;
constexpr size_t WS_ROPE = WS_MODV + 128 * 1024;
constexpr size_t WS_WSM = 3 * MiB, WSM_L = 22 * MiB;
constexpr size_t OW_IN = 0, OW_BR = 12 * MiB, OW_OUT = 15 * MiB, OW_PQ = 17 * MiB, OW_SK = 21 * MiB;
constexpr size_t WS_U = WS_WSM + 2 * WSM_L, WS_V = WS_U + 32 * MiB;
constexpr size_t WS_X = WS_V + 32 * MiB;
constexpr size_t WS_G1 = WS_X + 65 * MiB;
constexpr size_t WS_YO = WS_G1, WS_PQ = WS_G1 + 65 * MiB, WS_IDX = WS_G1 + 130 * MiB, WS_WGT = WS_G1 + 139 * MiB;
constexpr size_t WS_HA = WS_G1 + 195 * MiB, WS_HB = WS_HA + 33 * MiB;
constexpr size_t WS_Y = WS_HB + 33 * MiB;
constexpr size_t WS_END = WS_Y + 49 * MiB;
static_assert(WS_END <= 512 * MiB, "d_ws map");
constexpr int CW_BAR = 4096;
constexpr int RING_BYTES = 131072, LDSCTL_OFF = RING_BYTES, MISC_OFF = LDSCTL_OFF + 320, LDS_BYTES = 147456;
typedef __bf16 bf16x2_t __attribute__((ext_vector_type(2)));
typedef unsigned u32x2 __attribute__((ext_vector_type(2)));

struct Args { const float* in[N_IN]; float* out; unsigned char* ws; int ph_lo, ph_hi, coop, pad; };

__device__ __forceinline__ float wave_sum(float v) {
#pragma unroll
    for (int o = 1; o < 64; o <<= 1) v += __shfl_xor(v, o);
    return v;
}
__device__ __forceinline__ float bflo(unsigned w) { return __uint_as_float(w << 16); }
__device__ __forceinline__ float bfhi(unsigned w) { return __uint_as_float(w & 0xffff0000u); }
__device__ __forceinline__ float bf1(bf16 h) { return __uint_as_float((unsigned)h << 16); }
__device__ __forceinline__ float dot2bf(unsigned w, unsigned x, float acc) { return __builtin_amdgcn_fdot2_f32_bf16(__builtin_bit_cast(bf16x2_t, w), __builtin_bit_cast(bf16x2_t, x), acc, false); }
typedef float f32x2 __attribute__((ext_vector_type(2)));
__device__ __forceinline__ unsigned fp8lo(unsigned w) { return __builtin_bit_cast(unsigned, __builtin_amdgcn_cvt_scalef32_pk_bf16_fp8((int)w, 1.0f, false)); }
__device__ __forceinline__ unsigned fp8hi(unsigned w) { return __builtin_bit_cast(unsigned, __builtin_amdgcn_cvt_scalef32_pk_bf16_fp8((int)w, 1.0f, true)); }
__device__ __forceinline__ float silu_f(float x) { return x / (1.0f + __expf(-x)); }
__device__ __forceinline__ float gelu_f(float v) {
    const float av = fabsf(v), t = __builtin_amdgcn_rcpf(av * 0.2316418882f + 1.0f);
    float q = t * 0.5307027145f + (-0.7265760135f); q = q * t + 0.7107068705f; q = q * t + (-0.142248368f); q = q * t + 0.127414796f; q = q * t;
    const float e = __builtin_amdgcn_exp2f((v * v) * (-0.72134752044f));
    const float m = v * (q * e);
    return v < 0.f ? m : v - m;
}
__device__ __forceinline__ float vmaxf(float a, float b) { float r; asm("v_max_f32_e32 %0, %1, %2" : "=v"(r) : "v"(a), "v"(b)); return r; }
__device__ __forceinline__ float vminf(float a, float b) { float r; asm("v_min_f32_e32 %0, %1, %2" : "=v"(r) : "v"(a), "v"(b)); return r; }

typedef const __attribute__((address_space(4))) unsigned long long* kargp_t;
__device__ __forceinline__ const float* ain(int k) { kargp_t p = (kargp_t)__builtin_amdgcn_kernarg_segment_ptr(); return (const float*)(const GAS float*)(*(volatile kargp_t)(p + k)); }
__device__ __forceinline__ float* aout() { kargp_t p = (kargp_t)__builtin_amdgcn_kernarg_segment_ptr(); return (float*)(GAS float*)(*(volatile kargp_t)(p + N_IN)); }
struct Frame {
    LAS unsigned char* lds; unsigned char* lds_g;
    int tid, lane, wave, G, bx, vcu, gw, NGW;
    const float* in[N_IN]; float* out; unsigned char* ws;
};
__device__ __forceinline__ void p0_transpose_item(const float* W, int K, int N, bf16* WT, LAS float* scr, int item, int lane) {
    const int nblk = N / 32, kb = item / nblk, nb = item % nblk, k0 = 64 * kb, n0 = 32 * nb;
#pragma unroll 8
    for (int i = 0; i < 32; ++i) { const int kk = 2 * i + (lane >> 5); scr[kk * 33 + (lane & 31)] = W[(size_t)(k0 + kk) * N + n0 + (lane & 31)]; }
    LDS_WAIT(); asm volatile("" ::: "memory");
    const int c = lane & 7;
#pragma unroll
    for (int j = 0; j < 4; ++j) { const int n = (lane >> 3) + 8 * j; const LAS float* s = scr + (8 * c) * 33 + n;
        v4u o; o.x = pk2(s[0 * 33], s[1 * 33]); o.y = pk2(s[2 * 33], s[3 * 33]); o.z = pk2(s[4 * 33], s[5 * 33]); o.w = pk2(s[6 * 33], s[7 * 33]);
        *(GAS v4u*)(WT + (size_t)(n0 + n) * K + k0 + 8 * c) = o; }
    LDS_WAIT(); asm volatile("" ::: "memory");
}
__device__ __forceinline__ void conv_item(const float* src, bf16* dst, size_t item, int lane) {
    const float* s = src + item * 2048; bf16* d = dst + item * 2048;
    f32x4 a[4][2];
#pragma unroll
    for (int j = 0; j < 4; ++j) { a[j][0] = *(const GAS f32x4*)(s + j * 512 + lane * 8); a[j][1] = *(const GAS f32x4*)(s + j * 512 + lane * 8 + 4); }
#pragma unroll
    for (int j = 0; j < 4; ++j) { v4u o; o.x = pk2(a[j][0].x, a[j][0].y); o.y = pk2(a[j][0].z, a[j][0].w); o.z = pk2(a[j][1].x, a[j][1].y); o.w = pk2(a[j][1].z, a[j][1].w);
        *(GAS v4u*)(d + j * 512 + lane * 8) = o; }
}
__device__ __forceinline__ void convert_uv(const Frame& F, const Args& A, int l) {
    const float* us = ain(I_UT) + (size_t)l * NEXP * DM; const float* vs = ain(I_VT) + (size_t)l * NEXP * DM;
    for (int it = F.gw; it < 2 * NEXP; it += F.NGW) {
        const bool isv = it >= NEXP; const int row = isv ? it - NEXP : it;
        const float* src = (isv ? vs : us) + (size_t)row * DM + 16 * F.lane; unsigned char* tab = F.ws + (isv ? WS_V : WS_U);
        f32x4 x[4]; float am = 0.f;
#pragma unroll
        for (int q = 0; q < 4; ++q) { x[q] = *(const GAS f32x4*)(src + 4 * q); am = fmaxf(am, fmaxf(fmaxf(fabsf(x[q].x), fabsf(x[q].y)), fmaxf(fabsf(x[q].z), fabsf(x[q].w)))); }
#pragma unroll
        for (int o = 1; o < 64; o <<= 1) am = fmaxf(am, __shfl_xor(am, o));
        const int E = (int)((__float_as_uint(am) >> 23) & 255u) - 127;
        const int se = am > 0.f ? 7 - E : 0;
        const int sec = se > 120 ? 120 : (se < -120 ? -120 : se);
        const float sc = __uint_as_float((unsigned)(127 + sec) << 23), isc = __uint_as_float((unsigned)(127 - sec) << 23);
        v4u o; unsigned* op = (unsigned*)&o;
#pragma unroll
        for (int q = 0; q < 4; ++q) { int w = __builtin_amdgcn_cvt_pk_fp8_f32(x[q].x * sc, x[q].y * sc, 0, false); w = __builtin_amdgcn_cvt_pk_fp8_f32(x[q].z * sc, x[q].w * sc, w, true); op[q] = (unsigned)w; }
        *(GAS v4u*)(tab + (size_t)row * DM + 16 * F.lane) = o;
        if (F.lane == 0) ((float*)(tab + 16 * MiB))[row] = isc;
    }
}
__device__ __forceinline__ void sincos_f(float a, float& s, float& c) {
    const float n = __builtin_rintf(a * 0.636619772367581343f);
    float r = __builtin_fmaf(n, -1.5703125f, a); r = __builtin_fmaf(n, -4.837512969970703125e-4f, r); r = __builtin_fmaf(n, -7.54978995489188216e-8f, r);
    const float r2 = r * r;
    float sp = 2.75573192e-6f; sp = __builtin_fmaf(sp, r2, -1.98412698e-4f); sp = __builtin_fmaf(sp, r2, 8.33333333e-3f); sp = __builtin_fmaf(sp, r2, -1.66666667e-1f); sp = __builtin_fmaf(sp * r2, r, r);
    float cp = -2.75573192e-7f; cp = __builtin_fmaf(cp, r2, 2.48015873e-5f); cp = __builtin_fmaf(cp, r2, -1.38888889e-3f); cp = __builtin_fmaf(cp, r2, 4.16666667e-2f); cp = __builtin_fmaf(cp, r2, -0.5f); cp = __builtin_fmaf(cp, r2, 1.0f);
    const int q = ((int)n) & 3;
    s = (q == 0) ? sp : (q == 1) ? cp : (q == 2) ? -sp : -cp;
    c = (q == 0) ? cp : (q == 1) ? -sp : (q == 2) ? -cp : sp;
}
__device__ __forceinline__ void p0_prologue(const Frame& F, const Args& A) {
    LAS float* scr = (LAS float*)(F.lds + F.wave * 16384);
    constexpr int I_MOD = 768, I_T = 5376, I_SKN = 128, I_RP = 64;
    constexpr int NIT = I_MOD + 2 * I_T + 2 * I_SKN + I_RP;
    for (int it = F.gw; it < NIT; it += F.NGW) {
        int r = it;
        if (r < I_MOD) {
            const int l = r / 384, jb = (r % 384) / 16, ks = r % 16;
            const float* W = ain(I_WMOD) + (size_t)l * DM * INC + (size_t)(ks * 64) * INC + jb * 256 + F.lane * 4;
            const float* cv = ain(I_C) + ks * 64; const float* xv = ain(I_CCTX) + ks * 64;
            f32x4 ac = {0.f, 0.f, 0.f, 0.f}, ax = {0.f, 0.f, 0.f, 0.f};
#pragma unroll 8
            for (int kk = 0; kk < 64; ++kk) { const f32x4 w = *(const GAS f32x4*)(W + (size_t)kk * INC); const float sc = silu_f(cv[kk]), sx = silu_f(xv[kk]); ac += w * sc; ax += w * sx; }
            float* P = (float*)(F.ws + WS_MODP) + ((size_t)(l * 16 + ks) * 2) * INC + jb * 256 + F.lane * 4;
            *(GAS f32x4*)P = ac; *(GAS f32x4*)(P + INC) = ax;
            continue; }
        r -= I_MOD;
        if (r < 2 * I_T) {
            const int l = r / I_T; int q = r % I_T; bf16* wsm = (bf16*)(F.ws + WS_WSM + (size_t)l * WSM_L);
            if (q < 3072) { p0_transpose_item(ain(I_WIN) + (size_t)l * DM * INC, DM, INC, (bf16*)((unsigned char*)wsm + OW_IN), scr, q, F.lane); continue; } q -= 3072;
            if (q < 768) { const int b = q / 256; p0_transpose_item(ain(I_WBR) + ((size_t)l * 3 + b) * 512 * DM, 512, DM, (bf16*)((unsigned char*)wsm + OW_BR) + (size_t)b * DM * 512, scr, q % 256, F.lane); continue; } q -= 768;
            if (q < 512) { p0_transpose_item(ain(I_WOUT) + (size_t)l * DM * DM, DM, DM, (bf16*)((unsigned char*)wsm + OW_OUT), scr, q, F.lane); continue; } q -= 512;
            p0_transpose_item(ain(I_WPQ) + (size_t)l * DM * 2048, DM, 2048, (bf16*)((unsigned char*)wsm + OW_PQ), scr, q, F.lane); continue; }
        r -= 2 * I_T;
        if (r < 2 * I_SKN) { const int l = r / I_SKN; conv_item(ain(I_SK) + (size_t)l * 262144, (bf16*)(F.ws + WS_WSM + (size_t)l * WSM_L + OW_SK), r % I_SKN, F.lane); continue; }
        r -= 2 * I_SKN;
        {
            const int e = r * 64 + F.lane, pos = e >> 4, i = e & 15;
            const float invf = __builtin_amdgcn_exp2f(-(float)i * (13.287712379549449f / 16.0f));
            const float ang = (float)pos * invf; float s, c; sincos_f(ang, s, c);
            float* T = (float*)(F.ws + WS_ROPE) + 2 * e; T[0] = c; T[1] = s; }
    }
    convert_uv(F, A, 0);
}
__device__ __forceinline__ void p1_mod_h0(const Frame& F, const Args& A, bf16* H) {
    LAS float* ml = (LAS float*)F.lds;
    const float* MP = (const float*)(F.ws + WS_MODP);
    for (int o = F.tid; o < 4096; o += NTHREADS) { const int v = o >> 11, j = o & 2047; float s = ain(I_BMOD)[j];
#pragma unroll
        for (int ks = 0; ks < 16; ++ks) s += MP[((size_t)ks * 2 + v) * INC + j];
        ml[o] = s; }
    for (int o = F.bx * NTHREADS + F.tid; o < NL * 2 * INC; o += F.G * NTHREADS) { const int l = o / (2 * INC), v = (o / INC) & 1, j = o % INC; float s = ain(I_BMOD)[l * INC + j];
#pragma unroll
        for (int ks = 0; ks < 16; ++ks) s += MP[((size_t)(l * 16 + ks) * 2 + v) * INC + j];
        ((float*)(F.ws + WS_MODV))[o] = s; }
    __syncthreads();
    for (int r = F.gw; r < R; r += F.NGW) {
        const int v = r < NCTX ? 1 : 0; const float* src = r < NCTX ? ain(I_CTX) + (size_t)r * DM : ain(I_X) + (size_t)(r - NCTX) * DM;
#pragma unroll
        for (int j = 0; j < 4; ++j) { const int c = 4 * F.lane + 256 * j; const f32x4 x = *(const GAS f32x4*)(src + c);
            const f32x4 sh = *(const LAS f32x4*)(ml + v * 2048 + c), sc = *(const LAS f32x4*)(ml + v * 2048 + 1024 + c);
            const f32x4 h = x * (sc + 1.0f) + sh; u32x2 w; w.x = pk2(h.x, h.y); w.y = pk2(h.z, h.w); *(GAS u32x2*)(H + (size_t)r * DM + c) = w; }
    }
}
__device__ __forceinline__ void post1_phase(const Frame& F, const Args& A, int l, bool wr) {
    bf16* G1 = (bf16*)(F.ws + WS_G1); bf16* Y1 = (bf16*)(F.ws + WS_Y) + (size_t)R * 512;
    const float* rope = (const float*)(F.ws + WS_ROPE);
    const float* qn = ain(I_QN) + l * 64; const float* kn = ain(I_KN) + l * 64; const float* cw = ain(I_CONVW) + l * 3 * 512;
    const int j = F.lane & 7, ja = j >> 2, jb = (j >> 1) & 1, ji = (j & 1) * 8;
    for (int r = F.gw; r < R; r += F.NGW) {
        bf16* row = G1 + (size_t)r * INC;
        float cs[8], sn[8];
        if (r >= NCTX) { const int t = r - NCTX, pos = ja ? (t & 63) : (t >> 6); const float* tp = rope + (pos * 16 + ji) * 2;
#pragma unroll
            for (int q = 0; q < 4; ++q) { const f32x4 v = *(const GAS f32x4*)(tp + 4 * q); cs[2 * q] = v.x; sn[2 * q] = v.y; cs[2 * q + 1] = v.z; sn[2 * q + 1] = v.w; } }
        else {
#pragma unroll
            for (int k = 0; k < 8; ++k) { cs[k] = 1.f; sn[k] = 0.f; } }
#pragma unroll
        for (int p = 0; p < 3; ++p) {
            const int hs = p * 8 + (F.lane >> 3); const bool live = hs < 20; const int hh = live ? hs : 19;
            const int base = (hh < 8 ? C_QA + 64 * hh : hh < 10 ? C_KA + 64 * (hh - 8) : hh < 18 ? C_QC + 64 * (hh - 10) : C_KC + 64 * (hh - 18)) + 8 * j;
            const v4u xv = *(const GAS v4u*)(row + base);
            float e[8] = {bflo(xv.x), bfhi(xv.x), bflo(xv.y), bfhi(xv.y), bflo(xv.z), bfhi(xv.z), bflo(xv.w), bfhi(xv.w)};
            if (p < 2) {
                float ss = 0.f;
#pragma unroll
                for (int k = 0; k < 8; ++k) ss += e[k] * e[k];
                ss += __shfl_xor(ss, 1); ss += __shfl_xor(ss, 2); ss += __shfl_xor(ss, 4);
                if (hh < 10) { const float rs = __builtin_amdgcn_rsqf(ss * (1.0f / 64.0f) + RMS_EPS); const float* gn = (hh < 8 ? qn : kn) + 8 * j;
                    const f32x4 g0 = *(const GAS f32x4*)gn, g1 = *(const GAS f32x4*)(gn + 4);
                    e[0] *= rs * g0.x; e[1] *= rs * g0.y; e[2] *= rs * g0.z; e[3] *= rs * g0.w; e[4] *= rs * g1.x; e[5] *= rs * g1.y; e[6] *= rs * g1.z; e[7] *= rs * g1.w; }
            }
            const float qs = (hh < 8 || (hh >= 10 && hh < 18)) ? QSCALE : 1.0f;
            float o[8];
#pragma unroll
            for (int k = 0; k < 8; ++k) { const float pe = __shfl_xor(e[k], 2); o[k] = (jb ? e[k] * cs[k] + pe * sn[k] : e[k] * cs[k] - pe * sn[k]) * qs; }
            if (live && wr) { v4u w; w.x = pk2(o[0], o[1]); w.y = pk2(o[2], o[3]); w.z = pk2(o[4], o[5]); w.w = pk2(o[6], o[7]); *(GAS v4u*)(row + base) = w; }
        }
        const int lo = r < NCTX ? 0 : NCTX, hi = r < NCTX ? NCTX - 1 : R - 1, ch = 8 * F.lane;
        float acc[8];
#pragma unroll
        for (int k = 0; k < 8; ++k) acc[k] = 0.f;
#pragma unroll
        for (int d = 0; d < 3; ++d) { const int rr = r - 1 + d;
            if (rr >= lo && rr <= hi) { const bf16* nr = G1 + (size_t)rr * INC;
                const v4u xb = *(const GAS v4u*)(nr + C_XB + ch), gc = *(const GAS v4u*)(nr + C_GC + ch);
                const f32x4 w0 = *(const GAS f32x4*)(cw + d * 512 + ch), w1 = *(const GAS f32x4*)(cw + d * 512 + ch + 4);
                acc[0] += w0.x * bflo(xb.x) * bflo(gc.x); acc[1] += w0.y * bfhi(xb.x) * bfhi(gc.x); acc[2] += w0.z * bflo(xb.y) * bflo(gc.y); acc[3] += w0.w * bfhi(xb.y) * bfhi(gc.y);
                acc[4] += w1.x * bflo(xb.z) * bflo(gc.z); acc[5] += w1.y * bfhi(xb.z) * bfhi(gc.z); acc[6] += w1.z * bflo(xb.w) * bflo(gc.w); acc[7] += w1.w * bfhi(xb.w) * bfhi(gc.w); } }
        const v4u gb = *(const GAS v4u*)(row + C_GB + ch);
        v4u o; o.x = pk2(acc[0] * bflo(gb.x), acc[1] * bfhi(gb.x)); o.y = pk2(acc[2] * bflo(gb.y), acc[3] * bfhi(gb.y)); o.z = pk2(acc[4] * bflo(gb.z), acc[5] * bfhi(gb.z)); o.w = pk2(acc[6] * bflo(gb.w), acc[7] * bfhi(gb.w));
        if (wr) *(GAS v4u*)(Y1 + (size_t)r * 512 + ch) = o;
    }
}
__device__ __forceinline__ void ln1_phase(const Frame& F, const Args& A, int l, int row0, bf16* H2) {
    const float* YO = (const float*)(F.ws + WS_YO); float* X = (float*)(F.ws + WS_X); const float* MV = (const float*)(F.ws + WS_MODV) + (size_t)l * 2 * INC;
    const float* lg = ain(I_LN1G) + l * DM; const float* lb = ain(I_LN1B) + l * DM;
    for (int r = row0 + F.gw; r < R; r += F.NGW) {
        const float* mv = MV + (r < NCTX ? INC : 0);
        const float* xin = l == 0 ? (r < NCTX ? ain(I_CTX) + (size_t)r * DM : ain(I_X) + (size_t)(r - NCTX) * DM) : X + (size_t)r * DM;
        f32x4 v[4]; float s = 0.f;
#pragma unroll
        for (int j = 0; j < 4; ++j) { const int c = 4 * F.lane + 256 * j; const f32x4 x = *(const GAS f32x4*)(xin + c), y = *(const GAS f32x4*)(YO + (size_t)r * DM + c), g = *(const GAS f32x4*)(mv + 2048 + c);
            v[j] = x * ALPHA + g * y; s += (v[j].x + v[j].y) + (v[j].z + v[j].w); }
        const float mean = wave_sum(s) * (1.f / DM); float s2 = 0.f;
#pragma unroll
        for (int j = 0; j < 4; ++j) { v[j] = v[j] - mean; s2 += (v[j].x * v[j].x + v[j].y * v[j].y) + (v[j].z * v[j].z + v[j].w * v[j].w); }
        const float rstd = 1.f / sqrtf(wave_sum(s2) * (1.f / DM) + LN_EPS);
#pragma unroll
        for (int j = 0; j < 4; ++j) { const int c = 4 * F.lane + 256 * j; const f32x4 gg = *(const GAS f32x4*)(lg + c), bb = *(const GAS f32x4*)(lb + c);
            const f32x4 x1 = v[j] * rstd * gg + bb; *(GAS f32x4*)(X + (size_t)r * DM + c) = x1;
            const f32x4 sh = *(const GAS f32x4*)(mv + 3072 + c), sc = *(const GAS f32x4*)(mv + 4096 + c);
            const f32x4 h = x1 * (sc + 1.0f) + sh; u32x2 w; w.x = pk2(h.x, h.y); w.y = pk2(h.z, h.w); *(GAS u32x2*)(H2 + (size_t)r * DM + c) = w; }
    }
}
typedef float f32x16 __attribute__((ext_vector_type(16)));
__device__ __forceinline__ void ins16(float (&L)[16], float x) {
#pragma unroll
    for (int j = 0; j < 16; ++j) { const float h = vmaxf(L[j], x); x = vminf(L[j], x); L[j] = h; }
}
__device__ __forceinline__ void bitonic16_desc(float (&T)[16]) {
#pragma unroll
    for (int s = 8; s >= 1; s >>= 1)
#pragma unroll
        for (int i = 0; i < 16; ++i) if ((i & s) == 0) { const float h = vmaxf(T[i], T[i + s]), lo = vminf(T[i], T[i + s]); T[i] = h; T[i + s] = lo; }
}
__device__ __forceinline__ void subkey_top16(const bf16* qrow  , const bf16* keys  , int r32, int hi, float (&S)[16]) {
    bf16x8 qf[8];
#pragma unroll
    for (int ks = 0; ks < 8; ++ks) qf[ks] = *(const GAS bf16x8*)(qrow + ks * 16 + hi * 8);
    float L[16];
#pragma unroll
    for (int j = 0; j < 16; ++j) L[j] = -INFINITY;
#pragma unroll 1
    for (int nb = 0; nb < 4; ++nb) { f32x16 acc = f32x16{};
#pragma unroll
        for (int ks = 0; ks < 8; ++ks) { const bf16x8 kf = *(const GAS bf16x8*)(keys + (size_t)(nb * 32 + r32) * 128 + ks * 16 + hi * 8);
            acc = __builtin_amdgcn_mfma_f32_32x32x16_bf16(kf, qf[ks], acc, 0, 0, 0); }
#pragma unroll
        for (int rg = 0; rg < 16; ++rg) { const unsigned n = (unsigned)(nb * 32 + (rg & 3) + 8 * (rg >> 2) + 4 * hi);
            ins16(L, __uint_as_float((__float_as_uint(acc[rg]) & ~127u) | n)); } }
#pragma unroll
    for (int j = 0; j < 16; ++j) { const float other = __shfl_xor(L[15 - j], 32); S[j] = vmaxf(L[j], other); }
    bitonic16_desc(S);
}
__device__ __forceinline__ void scores_phase(const Frame& F, const Args& A, int l, int row0) {
    const bf16* PQ = (const bf16*)(F.ws + WS_PQ); const bf16* SK = (const bf16*)(F.ws + WS_WSM + (size_t)l * WSM_L + OW_SK);
    int* IDX = (int*)(F.ws + WS_IDX); float* WGT = (float*)(F.ws + WS_WGT);
    const int r32 = F.lane & 31, hi = F.lane >> 5;
    LAS unsigned* myl = (LAS unsigned*)(F.lds + F.wave * 2048 + F.lane * 32);
    const int nitems = ((R - row0) / 32) * 8;
    for (int it = F.gw; it < nitems; it += F.NGW) {
        const int h = it & 7, rb = row0 + (it >> 3) * 32, row = rb + r32;
        float S1[16], S2[16];
        subkey_top16(PQ + (size_t)row * 2048 + h * 256, SK + (size_t)(h * 2) * 16384, r32, hi, S1);
        subkey_top16(PQ + (size_t)row * 2048 + h * 256 + 128, SK + (size_t)(h * 2 + 1) * 16384, r32, hi, S2);
#pragma unroll
        for (int q = 0; q < 4; ++q) {
            myl[q] = (__float_as_uint(S1[4 * q]) & 127u) | ((__float_as_uint(S1[4 * q + 1]) & 127u) << 8) | ((__float_as_uint(S1[4 * q + 2]) & 127u) << 16) | ((__float_as_uint(S1[4 * q + 3]) & 127u) << 24);
            myl[4 + q] = (__float_as_uint(S2[4 * q]) & 127u) | ((__float_as_uint(S2[4 * q + 1]) & 127u) << 8) | ((__float_as_uint(S2[4 * q + 2]) & 127u) << 16) | ((__float_as_uint(S2[4 * q + 3]) & 127u) << 24); }
        float T[16];
#pragma unroll
        for (int j = 0; j < 16; ++j) T[j] = -INFINITY;
#pragma unroll
        for (int a = 0; a < 16; ++a)
#pragma unroll
            for (int b = 0; b < 16; ++b) if ((a + 1) * (b + 1) <= 16) ins16(T, __uint_as_float((__float_as_uint(S1[a] + S2[b]) & ~255u) | (unsigned)(a * 16 + b)));
        const float m = T[0]; float e[16], sum = 0.f;
#pragma unroll
        for (int j = 0; j < 16; ++j) { e[j] = __expf(T[j] - m); sum += e[j]; }
        const float inv = 1.0f / sum;
        LDS_WAIT();
        if (hi == 0) {
            const LAS unsigned char* lb = (const LAS unsigned char*)myl;
            int ex[16];
#pragma unroll
            for (int j = 0; j < 16; ++j) { const unsigned pid = __float_as_uint(T[j]) & 255u; ex[j] = (int)lb[pid >> 4] * 128 + (int)lb[16 + (pid & 15u)]; }
            int* ip = IDX + (size_t)row * 128 + h * 16; float* wp = WGT + (size_t)row * 128 + h * 16;
#pragma unroll
            for (int q = 0; q < 4; ++q) { *(GAS v4u*)(ip + 4 * q) = (v4u){(unsigned)ex[4 * q], (unsigned)ex[4 * q + 1], (unsigned)ex[4 * q + 2], (unsigned)ex[4 * q + 3]};
                *(GAS f32x4*)(wp + 4 * q) = (f32x4){e[4 * q] * inv, e[4 * q + 1] * inv, e[4 * q + 2] * inv, e[4 * q + 3] * inv}; }
        }
        LDS_WAIT();
    }
}
template <bool LAST, int RR> __device__ __forceinline__ void peer_sweep(const Frame& F, int l, const int (&rows)[RR], const bf16* H2, bf16* Hn) {
    const unsigned char* U = F.ws + WS_U; const unsigned char* V = F.ws + WS_V; const float* SU = (const float*)(F.ws + WS_U + 16 * MiB); const float* SV = (const float*)(F.ws + WS_V + 16 * MiB);
    const int* IDX = (const int*)(F.ws + WS_IDX); const float* WGT = (const float*)(F.ws + WS_WGT);
    float* X = (float*)(F.ws + WS_X); const float* MVl = (const float*)(F.ws + WS_MODV) + (size_t)l * 2 * INC; const float* MVn = (const float*)(F.ws + WS_MODV) + (size_t)(LAST ? l : l + 1) * 2 * INC;
    const float* lg = ain(I_LN2G) + l * DM; const float* lb = ain(I_LN2B) + l * DM;
    const int lane = F.lane, c0 = 16 * lane, jx = (lane >> 3) & 7;
    LAS unsigned char* wl = F.lds + F.wave * 6144;
#define IDXL(rr) ((LAS int*)(wl + (rr) * 1536))
#define WL(rr) ((LAS float*)(wl + (rr) * 1536 + 512))
#define AL(rr) ((LAS float*)(wl + (rr) * 1536 + 1024))
    v4u h0[RR], h1[RR]; float f[RR][16];
#pragma unroll
    for (int rr = 0; rr < RR; ++rr) {
        const size_t r = (size_t)rows[rr];
        const int i0 = IDX[r * 128 + lane], i1 = IDX[r * 128 + 64 + lane]; const float w0 = WGT[r * 128 + lane], w1 = WGT[r * 128 + 64 + lane];
        const int b0 = i0 >> 10, b1 = i1 >> 10; int d0 = 0, d1 = 0, base = 0;
#pragma unroll
        for (int b = 0; b < 16; ++b) { const unsigned long long m0 = __builtin_amdgcn_ballot_w64(b0 == b), m1 = __builtin_amdgcn_ballot_w64(b1 == b);
            const int n0 = __builtin_popcountll(m0), n1 = __builtin_popcountll(m1);
            const int r0 = base + (int)__builtin_amdgcn_mbcnt_hi((unsigned)(m0 >> 32), __builtin_amdgcn_mbcnt_lo((unsigned)m0, 0u));
            const int r1 = base + n0 + (int)__builtin_amdgcn_mbcnt_hi((unsigned)(m1 >> 32), __builtin_amdgcn_mbcnt_lo((unsigned)m1, 0u));
            d0 = (b0 == b) ? r0 : d0; d1 = (b1 == b) ? r1 : d1; base += n0 + n1; }
        IDXL(rr)[d0] = i0; WL(rr)[d0] = w0; IDXL(rr)[d1] = i1; WL(rr)[d1] = w1;
        h0[rr] = *(const GAS v4u*)(H2 + r * DM + c0); h1[rr] = *(const GAS v4u*)(H2 + r * DM + c0 + 8);
#pragma unroll
        for (int k = 0; k < 16; ++k) f[rr][k] = 0.f;
    }
    v4u A[8], B[8];
#define PEER_LOAD(T, buf, g, rr) do { __builtin_amdgcn_sched_barrier(0); _Pragma("unroll") for (int e = 0; e < 8; ++e) buf[e] = *(const GAS v4u*)(T + (size_t)IDXL(rr)[(g) * 8 + e] * DM + c0); __builtin_amdgcn_sched_barrier(0); } while (0)
#define PEER_COMPU(buf, g, rr) do { float p[8]; \
        _Pragma("unroll") for (int e = 0; e < 8; ++e) { const v4u u = buf[e]; \
            float a0 = dot2bf(fp8lo(u.x), h0[rr].x, 0.f), a1 = dot2bf(fp8hi(u.x), h0[rr].y, 0.f); a0 = dot2bf(fp8lo(u.y), h0[rr].z, a0); a1 = dot2bf(fp8hi(u.y), h0[rr].w, a1); \
            a0 = dot2bf(fp8lo(u.z), h1[rr].x, a0); a1 = dot2bf(fp8hi(u.z), h1[rr].y, a1); a0 = dot2bf(fp8lo(u.w), h1[rr].z, a0); a1 = dot2bf(fp8hi(u.w), h1[rr].w, a1); p[e] = a0 + a1; } \
        { const bool up = (lane & 32) != 0; _Pragma("unroll") for (int i = 0; i < 4; ++i) { const float a = p[i], b = p[i + 4]; p[i] = (up ? b : a) + __shfl_xor(up ? a : b, 32); } } \
        { const bool up = (lane & 16) != 0; _Pragma("unroll") for (int i = 0; i < 2; ++i) { const float a = p[i], b = p[i + 2]; p[i] = (up ? b : a) + __shfl_xor(up ? a : b, 16); } } \
        { const bool up = (lane & 8) != 0; const float a = p[0], b = p[1]; p[0] = (up ? b : a) + __shfl_xor(up ? a : b, 8); } \
        float t = p[0]; t += __shfl_xor(t, 4); t += __shfl_xor(t, 2); t += __shfl_xor(t, 1); \
        const int ej = IDXL(rr)[(g) * 8 + jx]; const float av = gelu_f(t * SU[ej]) * WL(rr)[(g) * 8 + jx] * SV[ej];       \
        if ((lane & 7) == 0) AL(rr)[(g) * 8 + jx] = av; } while (0)
#define PEER_COMPV(buf, g, rr) do { _Pragma("unroll") for (int e = 0; e < 8; ++e) { const float ae = AL(rr)[(g) * 8 + e]; const unsigned vv[4] = {buf[e].x, buf[e].y, buf[e].z, buf[e].w}; \
        _Pragma("unroll") for (int q = 0; q < 4; ++q) { const f32x2 lo = __builtin_amdgcn_cvt_pk_f32_fp8((int)vv[q], false), hi = __builtin_amdgcn_cvt_pk_f32_fp8((int)vv[q], true); \
            f[rr][4 * q] += ae * lo.x; f[rr][4 * q + 1] += ae * lo.y; f[rr][4 * q + 2] += ae * hi.x; f[rr][4 * q + 3] += ae * hi.y; } } } while (0)
    PEER_LOAD(U, A, 0, 0);
    if constexpr (RR == 1) {
#pragma unroll 1
        for (int g = 0; g < 16; g += 2) { PEER_LOAD(U, B, g + 1, 0); PEER_COMPU(A, g, 0); if (g + 2 < 16) PEER_LOAD(U, A, g + 2, 0); else PEER_LOAD(V, A, 0, 0); PEER_COMPU(B, g + 1, 0); }
#pragma unroll 1
        for (int g = 0; g < 16; g += 2) { PEER_LOAD(V, B, g + 1, 0); PEER_COMPV(A, g, 0); if (g + 2 < 16) PEER_LOAD(V, A, g + 2, 0); PEER_COMPV(B, g + 1, 0); }
    } else if constexpr (RR == 2) {
#pragma unroll 1
        for (int g = 0; g < 16; ++g) { PEER_LOAD(U, B, g, 1); PEER_COMPU(A, g, 0); if (g + 1 < 16) PEER_LOAD(U, A, g + 1, 0); else PEER_LOAD(V, A, 0, 0); PEER_COMPU(B, g, 1); }
#pragma unroll 1
        for (int g = 0; g < 16; ++g) { PEER_LOAD(V, B, g, 1); PEER_COMPV(A, g, 0); if (g + 1 < 16) PEER_LOAD(V, A, g + 1, 0); PEER_COMPV(B, g, 1); }
    } else {
        static_assert(RR == 4, "RR is 1, 2 or 4");
#pragma unroll 1
        for (int g = 0; g < 16; ++g) { PEER_LOAD(U, B, g, 1); PEER_COMPU(A, g, 0); PEER_LOAD(U, A, g, 2); PEER_COMPU(B, g, 1); PEER_LOAD(U, B, g, 3); PEER_COMPU(A, g, 2);
            if (g + 1 < 16) PEER_LOAD(U, A, g + 1, 0); else PEER_LOAD(V, A, 0, 0); PEER_COMPU(B, g, 3); }
#pragma unroll 1
        for (int g = 0; g < 16; ++g) { PEER_LOAD(V, B, g, 1); PEER_COMPV(A, g, 0); PEER_LOAD(V, A, g, 2); PEER_COMPV(B, g, 1); PEER_LOAD(V, B, g, 3); PEER_COMPV(A, g, 2);
            if (g + 1 < 16) PEER_LOAD(V, A, g + 1, 0); PEER_COMPV(B, g, 3); }
    }
#undef PEER_LOAD
#undef PEER_COMPU
#undef PEER_COMPV
#undef IDXL
#undef WL
#undef AL
#pragma unroll
    for (int rr = 0; rr < RR; ++rr) {
        const int r = rows[rr];
        const float* mv = MVl + (r < NCTX ? INC : 0);
        float v[16]; float s = 0.f;
#pragma unroll
        for (int q = 0; q < 4; ++q) { const int c = c0 + 4 * q; const f32x4 x = *(const GAS f32x4*)(X + (size_t)r * DM + c), g2 = *(const GAS f32x4*)(mv + 5120 + c);
#pragma unroll
            for (int k = 0; k < 4; ++k) { const float t = x[k] * ALPHA + g2[k] * f[rr][q * 4 + k]; v[q * 4 + k] = t; s += t; } }
        const float mean = wave_sum(s) * (1.f / DM); float s2 = 0.f;
#pragma unroll
        for (int k = 0; k < 16; ++k) { v[k] -= mean; s2 += v[k] * v[k]; }
        const float rstd = 1.f / sqrtf(wave_sum(s2) * (1.f / DM) + LN_EPS);
        const float* mn = MVn + (r < NCTX ? INC : 0);
#pragma unroll
        for (int q = 0; q < 4; ++q) { const int c = c0 + 4 * q; const f32x4 gg = *(const GAS f32x4*)(lg + c), bb = *(const GAS f32x4*)(lb + c);
            f32x4 x2;
#pragma unroll
            for (int k = 0; k < 4; ++k) x2[k] = v[q * 4 + k] * rstd * gg[k] + bb[k];
            if (LAST) { *(GAS f32x4*)(aout() + (size_t)(r - NCTX) * DM + c) = x2; }
            else { *(GAS f32x4*)(X + (size_t)r * DM + c) = x2;
                const f32x4 sh = *(const GAS f32x4*)(mn + c), sc = *(const GAS f32x4*)(mn + 1024 + c); const f32x4 hh = x2 * (sc + 1.0f) + sh;
                u32x2 w; w.x = pk2(hh.x, hh.y); w.y = pk2(hh.z, hh.w); *(GAS u32x2*)(Hn + (size_t)r * DM + c) = w; } }
    }
}
#ifndef PEER_RR
#define PEER_RR 2
#endif
template <bool LAST> __device__ __forceinline__ void peer_phase(const Frame& F, const Args& A, int l, int row0, const bf16* H2, bf16* Hn) {
#pragma unroll 1
    for (int sw = 0; sw < 8 / PEER_RR; ++sw) { int rows[PEER_RR];
#pragma unroll
        for (int k = 0; k < PEER_RR; ++k) rows[k] = row0 + F.gw * 8 + sw * PEER_RR + k;
        peer_sweep<LAST, PEER_RR>(F, l, rows, H2, Hn); }
    if (row0 + F.NGW * 8 < R) { const int r = row0 + F.NGW * 8 + F.bx; if (F.wave == 0 && r < R) { const int rows1[1] = {r}; peer_sweep<LAST, 1>(F, l, rows1, H2, Hn); } }
}
__device__ __forceinline__ void attn_phase(const Frame& F, const Args& A, int l) {
    using attn_body::AttnJob; typedef attn_body::bf16 abf;
    abf* G1 = (abf*)(F.ws + WS_G1); abf* Y0 = (abf*)(F.ws + WS_Y); abf* Y2 = Y0 + (size_t)2 * R * 512;
    char* shm = (char*)F.lds_g;
    const float* sink = ain(I_SINK) + l * 8;
#define OPAQUE_S(x) asm volatile("" : "+s"(x))
#pragma unroll 1
    for (int i = 0; i < 2; ++i) {
        int vc = F.vcu; OPAQUE_S(vc);
        const int u = 2 * vc + i, kvh = u >> 8, hq = kvh * 4 + ((u >> 6) & 3), qb = u & 63; const size_t row = NCTX + 256 * qb;
        AttnJob J; J.Q = G1 + row * INC + C_QA + hq * 64; J.K = G1 + C_KA + kvh * 64; J.V = G1 + C_VA + kvh * 64; J.O = Y0 + row * 512 + hq * 64;
        J.qp = INC; J.kp = INC; J.op = 512; J.nt = R / 64; J.nt0 = R / 64; J.row1 = 0; J.qpos0 = 0; J.kpos1 = 0; J.sink2 = -INFINITY;
        attn_body::attn_unit<8, 0>(J, shm);
    }
#ifndef AT_ONLYA
#pragma unroll 1
    for (int i = 0; i < 2; ++i) {
        int vc = F.vcu; OPAQUE_S(vc);
        const int u = 2 * vc + i, kvh = u >> 8, hq = kvh * 4 + ((u >> 6) & 3), qb = u & 63; const size_t row = NCTX + 256 * qb;
        const int q0 = 256 * qb, lo = q0 - 128 < 0 ? 0 : q0 - 128, hi = q0 + 384 > SEQ ? SEQ : q0 + 384;
        AttnJob J; J.Q = G1 + row * INC + C_QC + hq * 64; J.K = G1 + C_KC + kvh * 64; J.V = G1 + C_VC + kvh * 64; J.O = Y2 + row * 512 + hq * 64;
        J.qp = INC; J.kp = INC; J.op = 512; J.nt0 = NCTX / 64; J.nt = NCTX / 64 + (hi - lo) / 64; J.row1 = NCTX + lo; J.qpos0 = q0; J.kpos1 = lo; J.sink2 = sink[hq] * LOG2E;
        attn_body::attn_unit<8, 1>(J, shm);
    }
    int vx = F.vcu; OPAQUE_S(vx);
    if (l == 0 && vx < 16) {
        const int hq = vx & 7, kvh = hq >> 2; const bool isc = vx >= 8;
        AttnJob J; J.Q = G1 + (isc ? C_QC : C_QA) + hq * 64; J.K = G1 + (isc ? C_KC : C_KA) + kvh * 64; J.V = G1 + (isc ? C_VC : C_VA) + kvh * 64; J.O = (isc ? Y2 : Y0) + hq * 64;
        J.qp = INC; J.kp = INC; J.op = 512; J.nt = NCTX / 64; J.nt0 = NCTX / 64; J.row1 = 0; J.qpos0 = 0; J.kpos1 = 0; J.sink2 = isc ? sink[hq] * LOG2E : -INFINITY;
        attn_body::attn_unit<8, 0>(J, shm);
    }
#endif
}
constexpr int N_PHASES = 2 + 9 * NL;
__global__ void __launch_bounds__(NTHREADS, 2) mk_fwd(Args A) {
    extern __shared__ __attribute__((aligned(16))) unsigned char lds[];
    Frame F0;
    F0.lds = (LAS unsigned char*)lds; F0.lds_g = lds;
    F0.tid = threadIdx.x; F0.lane = F0.tid & 63; F0.wave = __builtin_amdgcn_readfirstlane(F0.tid >> 6);
    F0.G = gridDim.x; F0.bx = blockIdx.x; F0.vcu = (F0.G % 8 == 0) ? (F0.bx % 8) * (F0.G / 8) + F0.bx / 8 : F0.bx;
    F0.gw = F0.bx * NWAVES + F0.wave; F0.NGW = F0.G * NWAVES; F0.ws = A.ws;
    volatile LAS unsigned* MISC = (volatile LAS unsigned*)(F0.lds + MISC_OFF);
    for (int u = F0.tid; u < (LDS_BYTES - LDSCTL_OFF) / 4; u += NTHREADS) ((LAS unsigned*)(F0.lds + LDSCTL_OFF))[u] = 0u;
    __syncthreads();
    const int lo = A.ph_lo, hi = A.ph_hi;
    XcdBarrier bar; bar.bar = (unsigned*)(A.ws + WS_CTL) + CW_BAR; bar.x = 0; bar.st = nullptr;
    if (hi - lo > 1) bar = xcd_barrier_post((unsigned*)(A.ws + WS_CTL) + CW_BAR, MISC + 8);
#ifndef MK_ONLY
#define MK_ONLY -1
#endif
#ifndef MK_REP
#define MK_REP 0
#endif
#ifndef MK_MASK
#define MK_MASK 0x7ff
#endif
#define ON(k) ((MK_ONLY < 0 || MK_ONLY == (k)) && ((MK_MASK >> (k)) & 1))
#pragma unroll 1
    for (int ph2 = 2 * lo; ph2 < 2 * hi; ++ph2) {
        const int ph = ph2 >> 1;
        if ((ph2 & 1) && !((MK_REP >> ph) & 1)) continue;
        const int l = ph < 2 ? 0 : (ph - 2) / 9, kind = ph < 2 ? ph : 2 + (ph - 2) % 9;
        Frame F;
        F.lds = (LAS unsigned char*)lds; F.lds_g = lds;
        F.tid = opq_tid(); F.lane = F.tid & 63; F.wave = __builtin_amdgcn_readfirstlane(F.tid >> 6);
        { int bx = blockIdx.x, g = gridDim.x; asm volatile("" : "+s"(bx), "+s"(g)); F.bx = bx; F.G = g; }
        F.vcu = (F.G % 8 == 0) ? (F.bx % 8) * (F.G / 8) + F.bx / 8 : F.bx; F.gw = F.bx * NWAVES + F.wave; F.NGW = F.G * NWAVES;
        { GAS unsigned char* wsg = (GAS unsigned char*)A.ws; asm volatile("" : "+s"(wsg)); F.ws = (unsigned char*)wsg; }
        bf16* HA = (bf16*)(F.ws + WS_HA); bf16* HB = (bf16*)(F.ws + WS_HB);
        bf16* Hin = (l & 1) ? HB : HA; bf16* Hmg = (l & 1) ? HA : HB;
        const int row0 = (l == NL - 1) ? NCTX : 0;
        const int Mr = R - row0, NPr = Mr / 256;
        unsigned char* wsm = F.ws + WS_WSM + (size_t)l * WSM_L;
        switch (kind) {
        case 0: if (ON(0)) { p0_prologue(F, A); } break;
        case 1: if (ON(1)) { p1_mod_h0(F, A, HA); } break;
        case 2: if (ON(2)) {
            pg8::Gemm g{(const pg8::bf16_t*)Hin, (const pg8::bf16_t*)(wsm + OW_IN), R, INC, DM}; pg8::StaticOrder S; S.init(R, INC, F.G, F.bx);
            pg8::EpiBf16<0> E{(pg8::bf16_t*)(F.ws + WS_G1), INC, nullptr, 0, 0, 1.f};
            pg8::gemm_phase<pg8::EpiBf16<0>, pg8::StaticOrder, true, true>(F.lds, g, S, E);
            if (l > 0) convert_uv(F, A, l);
        } break;
        case 3: if (ON(3)) { post1_phase(F, A, l, !(ph2 & 1) || F.G == 12345); } break;
        case 4: if (ON(4)) { attn_phase(F, A, l); } break;
        case 5: if (ON(5)) {
            pg8::Gemm g{(const pg8::bf16_t*)(F.ws + WS_Y) + (size_t)row0 * 512, (const pg8::bf16_t*)(wsm + OW_BR), 3 * R, 3072, 512}; pg8::MergeOrder S; S.init(NPr, SPAN, F.G, F.bx);
            pg8::EpiMerge E{(pg8::bf16_t*)Hmg + (size_t)row0 * DM, (const pg8::bf16_t*)(F.ws + WS_G1) + (size_t)row0 * INC + C_GL, INC, SPAN};
            pg8::gemm_phase<pg8::EpiMerge, pg8::MergeOrder, true, true>(F.lds, g, S, E);
        } break;
        case 6: if (ON(6)) {
            pg8::Gemm g{(const pg8::bf16_t*)Hmg + (size_t)row0 * DM, (const pg8::bf16_t*)(wsm + OW_OUT), Mr, DM, DM}; pg8::StaticOrder S; S.init(Mr, DM, F.G, F.bx);
            pg8::EpiF32 E{(float*)(F.ws + WS_YO) + (size_t)row0 * DM, DM};
            pg8::gemm_phase<pg8::EpiF32, pg8::StaticOrder, true, true>(F.lds, g, S, E);
        } break;
        case 7: if (ON(7)) { ln1_phase(F, A, l, row0, Hin); } break;
        case 8: if (ON(8)) {
            pg8::Gemm g{(const pg8::bf16_t*)Hin + (size_t)row0 * DM, (const pg8::bf16_t*)(wsm + OW_PQ), Mr, 2048, DM}; pg8::StaticOrder S; S.init(Mr, 2048, F.G, F.bx);
            pg8::EpiBf16<0> E{(pg8::bf16_t*)(F.ws + WS_PQ) + (size_t)row0 * 2048, 2048, nullptr, 0, 0, 1.f};
            pg8::gemm_phase<pg8::EpiBf16<0>, pg8::StaticOrder, true, true>(F.lds, g, S, E);
        } break;
        case 9: if (ON(9)) { scores_phase(F, A, l, row0); } break;
        default: if (ON(10)) { if (l == NL - 1) peer_phase<true>(F, A, l, row0, Hin, Hmg); else peer_phase<false>(F, A, l, row0, Hin, Hmg); } break;
        }
#if defined(MK_XBAR)
        if (ph == 5 && !(ph2 & 1)) { for (int q = 0; q < MK_XBAR; ++q) xcd_barrier(bar); }
#endif
        const bool more = (ph2 & 1) ? (ph + 1 < hi) : ((ph + 1 < hi) || ((MK_REP >> ph) & 1));
        if (more) { if (A.coop && ph2 == 2 * lo) { cg::this_grid().sync(); } else { xcd_barrier(bar); } }
    }
#undef ON
}
#ifndef MK_MULTI
#define MK_MULTI 0
#endif
extern "C" void kernel_launch(void* const* d_in, const int* in_sizes, int n_in, void* d_out, int out_size, void* d_ws, size_t ws_size, hipStream_t stream) {
    static int grid = 0;
    if (grid == 0) {
        if (n_in != N_IN || out_size != SEQ * DM || ws_size < WS_END) { fprintf(stderr, "kernel_launch: unexpected shapes (n_in %d, out %d, ws %zu)\n", n_in, out_size, ws_size); grid = -1; return; }
        int dev = 0, cus = 0, per_cu = 0;
        if (hipGetDevice(&dev) != hipSuccess || hipDeviceGetAttribute(&cus, hipDeviceAttributeMultiprocessorCount, dev) != hipSuccess) { grid = -1; return; }
        if (hipFuncSetAttribute((const void*)mk_fwd, hipFuncAttributeMaxDynamicSharedMemorySize, LDS_BYTES) != hipSuccess) { grid = -1; return; }
        if (hipOccupancyMaxActiveBlocksPerMultiprocessor(&per_cu, (const void*)mk_fwd, NTHREADS, LDS_BYTES) != hipSuccess || per_cu < 1) { fprintf(stderr, "kernel_launch: occupancy query says %d\n", per_cu); }
        (void)hipGetLastError();
        grid = cus;
    }
    if (grid < 0) return;
    (void)hipMemsetAsync((char*)d_ws + WS_CTL, 0, CTL_ZERO_BYTES, stream);
    Args a{};
    for (int i = 0; i < N_IN; ++i) a.in[i] = (const float*)d_in[i];
    a.out = (float*)d_out; a.ws = (unsigned char*)d_ws;
#if MK_MULTI
    for (int p = 0; p < N_PHASES; ++p) { a.ph_lo = p; a.ph_hi = p + 1; a.coop = 0; hipLaunchKernelGGL(mk_fwd, dim3(grid), dim3(NTHREADS), LDS_BYTES, stream, a); }
#else
    a.ph_lo = 0; a.ph_hi = N_PHASES; a.coop = 1;
    void* args[] = {&a};
    hipError_t e = hipLaunchCooperativeKernel((void*)mk_fwd, dim3(grid), dim3(NTHREADS), args, LDS_BYTES, stream);
    if (e != hipSuccess) fprintf(stderr, "kernel_launch: cooperative launch failed: %s (grid %d)\n", hipGetErrorString(e), grid);
#endif
}
```
